# Optimizing an MI355X kernel written in HIP

```python
import jax, jax.numpy as jnp
from jax import lax
import numpy as np

D_MODEL = 1024
BATCH = 16
SEQ = 2048
DEPTH = 2

N_EVEN = (DEPTH + 1) // 2
N_ODD = DEPTH // 2

DN_HEADS = 4
DN_DK = 128
DN_DV = 128
DN_CHUNK = 64
CONV_WIDTH = 4
FOX_HEADS = 4
FOX_DH = 128
FOX_BLOCK = 128
EVEN_MIX = DN_HEADS * DN_DV + FOX_HEADS * FOX_DH
EVEN_SIZES = (2 * DN_HEADS * DN_DK + DN_HEADS * DN_DV,
              DN_HEADS * DN_DV,
              DN_HEADS,
              DN_HEADS,
              FOX_HEADS * FOX_DH, FOX_HEADS * FOX_DH, FOX_HEADS * FOX_DH,
              FOX_HEADS)
EVEN_IN = sum(EVEN_SIZES)

LRU_WIDTH = 512
LRU_BLOCKS = 4
LRU_C = 8.0
SGU_WIDTH = 512
SGU_GROUPS = 4
SGU_CHUNK = 128
ODD_MIX = LRU_WIDTH + SGU_WIDTH
ODD_SIZES = (LRU_WIDTH, LRU_WIDTH, SGU_WIDTH, SGU_WIDTH)
ODD_IN = sum(ODD_SIZES)

N_EXPERTS = 16
N_EXPERT_GROUPS = 4
EXPERTS_PER_GROUP = N_EXPERTS // N_EXPERT_GROUPS
TOP_K = 2
D_EXPERT = D_MODEL // 4

EPS = 1e-6

kernel_name = "hybrid_deltanet_fox_rglru_sgu_moe"


def split_cols(t, sizes):
    offs = np.cumsum(np.array(sizes))[:-1].tolist()
    return jnp.split(t, offs, axis=-1)


def rmsnorm(x, g):
    xf = x.astype(jnp.float32)
    y = xf * lax.rsqrt(jnp.mean(xf * xf, axis=-1, keepdims=True) + EPS)
    return (y * g.astype(jnp.float32)).astype(x.dtype)


def l2norm(x):
    xf = x.astype(jnp.float32)
    return xf * lax.rsqrt(jnp.sum(xf * xf, axis=-1, keepdims=True) + EPS)


def modulate(h, shift, scale):
    return h * (1 + scale[:, None, :]) + shift[:, None, :]


def causal_dwconv(x, w):
    k_w, ch = w.shape
    return lax.conv_general_dilated(x, w[:, None, :].astype(x.dtype), window_strides=(1,),
                                    padding=[(k_w - 1, 0)],
                                    dimension_numbers=('NWC', 'WIO', 'NWC'),
                                    feature_group_count=ch)


def gated_deltanet(q, k, v, log_decay, beta):
    f32 = jnp.float32
    b_, s_, h_, dk = q.shape
    dv = v.shape[-1]
    c_ = DN_CHUNK
    n_ = s_ // c_
    q = l2norm(q) * (dk ** -0.5)
    k = l2norm(k)
    v = v.astype(f32)

    def chunks(t):
        t = t.reshape((b_, n_, c_, h_) + t.shape[3:])
        return jnp.moveaxis(t, (1, 3), (0, 2))

    qc, kc, vc = chunks(q), chunks(k), chunks(v)
    gc = jnp.cumsum(chunks(log_decay.astype(f32)), axis=-1)
    bc = chunks(beta.astype(f32))
    idx = jnp.arange(c_)
    causal = idx[:, None] >= idx[None, :]
    strict = idx[:, None] > idx[None, :]
    decay = jnp.exp(jnp.where(causal, gc[..., :, None] - gc[..., None, :], -jnp.inf))
    kk = jnp.einsum('nbhcd,nbhsd->nbhcs', kc * bc[..., None], kc) * decay
    eye = jnp.eye(c_, dtype=f32)
    lower = eye + jnp.where(strict, kk, 0.0)
    t_inv = lax.linalg.triangular_solve(lower, jnp.broadcast_to(eye, lower.shape),
                                        left_side=True, lower=True)
    u = jnp.matmul(t_inv, vc * bc[..., None])
    w = jnp.matmul(t_inv, kc * (bc * jnp.exp(gc))[..., None])
    qk = jnp.einsum('nbhcd,nbhsd->nbhcs', qc, kc) * decay
    q_dec = qc * jnp.exp(gc)[..., None]
    k_dec = kc * jnp.exp(gc[..., -1:] - gc)[..., None]
    g_last = jnp.exp(gc[..., -1])

    def step(state, inp):
        u_i, w_i, qk_i, qd_i, kd_i, gl_i = inp
        v_new = u_i - jnp.matmul(w_i, state)
        o_i = jnp.matmul(qd_i, state) + jnp.matmul(qk_i, v_new)
        state = state * gl_i[..., None, None] + jnp.matmul(jnp.swapaxes(kd_i, -1, -2), v_new)
        return state, o_i

    s0 = jnp.zeros((b_, h_, dk, dv), f32)
    _, o = lax.scan(step, s0, (u, w, qk, q_dec, k_dec, g_last))
    return jnp.moveaxis(o, (0, 2), (1, 3)).reshape(b_, s_, h_, dv)


def forgetting_attention(q, k, v, log_f):
    f32 = jnp.float32
    s_ = q.shape[2]
    scale = q.shape[-1] ** -0.5
    cum = jnp.cumsum(log_f, axis=-1)
    outs = []
    for blk in range(s_ // FOX_BLOCK):
        q0 = blk * FOX_BLOCK
        q1 = q0 + FOX_BLOCK
        kb, vb = k[:, :, :q1], v[:, :, :q1]
        logits = (jnp.einsum('bhqd,bhkd->bhqk', q[:, :, q0:q1], kb).astype(f32) * scale
                  + cum[:, :, q0:q1, None] - cum[:, :, None, :q1])
        mask = (q0 + jnp.arange(FOX_BLOCK))[:, None] >= jnp.arange(q1)[None, :]
        p = jax.nn.softmax(jnp.where(mask, logits, -jnp.inf), axis=-1)
        outs.append(jnp.einsum('bhqk,bhkd->bhqd', p.astype(vb.dtype), vb))
    return jnp.concatenate(outs, axis=2)


def rg_lru(x, w_r, b_r, w_i, b_i, lam):
    f32 = jnp.float32
    b_, s_, wd = x.shape
    xh = x.reshape(b_, s_, LRU_BLOCKS, wd // LRU_BLOCKS)
    r = jax.nn.sigmoid(jnp.einsum('bshi,hij->bshj', xh, w_r).reshape(b_, s_, wd) + b_r)
    i = jax.nn.sigmoid(jnp.einsum('bshi,hij->bshj', xh, w_i).reshape(b_, s_, wd) + b_i)
    log_a = -LRU_C * r.astype(f32) * jax.nn.softplus(-lam.astype(f32))
    a = jnp.exp(log_a)
    b = jnp.sqrt(-jnp.expm1(2.0 * log_a)) * (i * x).astype(f32)

    def combine(left, right):
        a1, b1 = left
        a2, b2 = right
        return a1 * a2, a2 * b1 + b2

    _, h = lax.associative_scan(combine, (a, b), axis=1)
    return h.astype(x.dtype)


def chunked_sgu(u, v, g_norm, w_s, b_s):
    b_, s_, wd = u.shape
    n_ = s_ // SGU_CHUNK
    v = rmsnorm(v, g_norm).reshape(b_, n_, SGU_CHUNK, SGU_GROUPS, wd // SGU_GROUPS)
    tri = jnp.tril(jnp.ones((SGU_CHUNK, SGU_CHUNK), dtype=bool))
    w = jnp.where(tri, w_s, 0.0).astype(v.dtype)
    mixed = jnp.einsum('gts,bnsgd->bntgd', w, v) + b_s.T[None, None, :, :, None]
    return u * mixed.reshape(b_, s_, wd)


def even_mixer(h, w_in, conv_w, a_log, dt_bias, onorm_g, f_bias, qnorm_g, knorm_g, w_out):
    f32 = jnp.float32
    b_, s_, _ = h.shape
    proj = h @ w_in
    dn_qkv, dn_z, dn_a, dn_b, fq, fk, fv, ff = split_cols(proj, EVEN_SIZES)
    dn_qkv = jax.nn.silu(causal_dwconv(dn_qkv, conv_w))
    dq, dk, dv = split_cols(dn_qkv, (DN_HEADS * DN_DK, DN_HEADS * DN_DK, DN_HEADS * DN_DV))
    dq = dq.reshape(b_, s_, DN_HEADS, DN_DK)
    dk = dk.reshape(b_, s_, DN_HEADS, DN_DK)
    dv = dv.reshape(b_, s_, DN_HEADS, DN_DV)
    log_decay = -jnp.exp(a_log.astype(f32)) * jax.nn.softplus(dn_a.astype(f32) + dt_bias.astype(f32))
    beta = jax.nn.sigmoid(dn_b.astype(f32))
    o_dn = gated_deltanet(dq, dk, dv, log_decay, beta)
    o_dn = rmsnorm(o_dn, onorm_g) * jax.nn.silu(dn_z.reshape(b_, s_, DN_HEADS, DN_DV).astype(f32))
    o_dn = o_dn.reshape(b_, s_, DN_HEADS * DN_DV).astype(h.dtype)
    fq = rmsnorm(fq.reshape(b_, s_, FOX_HEADS, FOX_DH), qnorm_g).transpose(0, 2, 1, 3)
    fk = rmsnorm(fk.reshape(b_, s_, FOX_HEADS, FOX_DH), knorm_g).transpose(0, 2, 1, 3)
    fv = fv.reshape(b_, s_, FOX_HEADS, FOX_DH).transpose(0, 2, 1, 3)
    log_f = jax.nn.log_sigmoid(ff.astype(f32) + f_bias.astype(f32)).transpose(0, 2, 1)
    o_fox = forgetting_attention(fq, fk, fv, log_f)
    o_fox = o_fox.transpose(0, 2, 1, 3).reshape(b_, s_, FOX_HEADS * FOX_DH).astype(h.dtype)
    return jnp.concatenate([o_dn, o_fox], axis=-1) @ w_out


def odd_mixer(h, w_in, conv_w, conv_b, wr, br, wi, bi, lam, sgu_g, sgu_w, sgu_b, w_out):
    proj = h @ w_in
    lx, lg, su, sv = split_cols(proj, ODD_SIZES)
    lx = causal_dwconv(lx, conv_w) + conv_b
    o_lru = rg_lru(lx, wr, br, wi, bi, lam) * jax.nn.gelu(lg)
    o_sgu = chunked_sgu(jax.nn.gelu(su), jax.nn.gelu(sv), sgu_g, sgu_w, sgu_b)
    return jnp.concatenate([o_lru, o_sgu], axis=-1) @ w_out


def moe(h, router_w, router_b, w_gate, w_up, w_down):
    f32 = jnp.float32
    b_, s_, _ = h.shape
    probs = jax.nn.softmax(jnp.einsum('bsd,de->bse', h, router_w).astype(f32), axis=-1)
    sel = (probs + router_b.astype(f32)).reshape(b_, s_, N_EXPERT_GROUPS, EXPERTS_PER_GROUP)
    group_score = jnp.sum(lax.top_k(sel, TOP_K)[0], axis=-1)
    g_idx = jnp.argmax(group_score, axis=-1)
    in_group = jnp.sum(sel * jax.nn.one_hot(g_idx, N_EXPERT_GROUPS, dtype=f32)[..., None], axis=2)
    _, local = lax.top_k(in_group, TOP_K)
    e_idx = g_idx[..., None] * EXPERTS_PER_GROUP + local
    wts = jnp.take_along_axis(probs, e_idx, axis=-1)
    wts = wts / jnp.sum(wts, axis=-1, keepdims=True)
    gates = jnp.sum(jax.nn.one_hot(e_idx, N_EXPERTS, dtype=f32) * wts[..., None], axis=-2)
    act = (jax.nn.silu(jnp.einsum('bsd,edf->bsef', h, w_gate))
           * jnp.einsum('bsd,edf->bsef', h, w_up)) * gates.astype(h.dtype)[..., None]
    return jnp.einsum('bsef,efd->bsd', act, w_down)


def setup_inputs(seed: int = 0) -> dict:
    key = jax.random.key(seed)
    ks = list(jax.random.split(key, 40))
    f32 = jnp.float32
    d = D_MODEL

    def nrm(shape, scale):
        return jax.random.normal(ks.pop(), shape, f32) * scale

    def gain(shape):
        return 1.0 + nrm(shape, 0.02)

    x = nrm((BATCH, SEQ, d), 1.0)
    c = nrm((BATCH, d), 1.0)
    ada_w = nrm((DEPTH, d, 6 * d), 0.5 * d ** -0.5)
    ada_b = nrm((DEPTH, 6 * d), 0.02)
    norm1_g = gain((DEPTH, d))
    norm2_g = gain((DEPTH, d))
    ev_w_in = nrm((N_EVEN, d, EVEN_IN), d ** -0.5)
    ev_conv_w = nrm((N_EVEN, CONV_WIDTH, EVEN_SIZES[0]), CONV_WIDTH ** -0.5)
    ev_dn_a_log = jnp.log(jax.random.uniform(ks.pop(), (N_EVEN, DN_HEADS), f32, 1.0, 16.0))
    dt = jnp.exp(jax.random.uniform(ks.pop(), (N_EVEN, DN_HEADS), f32,
                                    float(np.log(1e-3)), float(np.log(1e-1))))
    ev_dn_dt_bias = dt + jnp.log(-jnp.expm1(-dt))
    ev_dn_onorm_g = gain((N_EVEN, DN_DV))
    ev_fox_f_bias = 2.0 + nrm((N_EVEN, FOX_HEADS), 0.5)
    ev_fox_qnorm_g = gain((N_EVEN, FOX_DH))
    ev_fox_knorm_g = gain((N_EVEN, FOX_DH))
    ev_w_out = nrm((N_EVEN, EVEN_MIX, d), EVEN_MIX ** -0.5)
    blk = LRU_WIDTH // LRU_BLOCKS
    od_w_in = nrm((N_ODD, d, ODD_IN), d ** -0.5)
    od_conv_w = nrm((N_ODD, CONV_WIDTH, LRU_WIDTH), CONV_WIDTH ** -0.5)
    od_conv_b = nrm((N_ODD, LRU_WIDTH), 0.02)
    od_lru_wr = nrm((N_ODD, LRU_BLOCKS, blk, blk), blk ** -0.5)
    od_lru_br = nrm((N_ODD, LRU_WIDTH), 0.02)
    od_lru_wi = nrm((N_ODD, LRU_BLOCKS, blk, blk), blk ** -0.5)
    od_lru_bi = nrm((N_ODD, LRU_WIDTH), 0.02)
    a0 = jax.random.uniform(ks.pop(), (N_ODD, LRU_WIDTH), f32, 0.9, 0.999) ** (1.0 / LRU_C)
    od_lru_lambda = jnp.log(a0) - jnp.log1p(-a0)
    od_sgu_norm_g = gain((N_ODD, SGU_WIDTH))
    od_sgu_w = nrm((N_ODD, SGU_GROUPS, SGU_CHUNK, SGU_CHUNK), SGU_CHUNK ** -0.5)
    od_sgu_b = 1.0 + nrm((N_ODD, SGU_GROUPS, SGU_CHUNK), 0.02)
    od_w_out = nrm((N_ODD, ODD_MIX, d), ODD_MIX ** -0.5)
    router_w = nrm((d, N_EXPERTS), d ** -0.5)
    router_b = nrm((N_EXPERTS,), 0.01)
    moe_w_gate = nrm((DEPTH, N_EXPERTS, d, D_EXPERT), d ** -0.5)
    moe_w_up = nrm((DEPTH, N_EXPERTS, d, D_EXPERT), d ** -0.5)
    moe_w_down = nrm((DEPTH, N_EXPERTS, D_EXPERT, d), D_EXPERT ** -0.5)
    return {"x": x, "c": c, "ada_w": ada_w, "ada_b": ada_b, "norm1_g": norm1_g, "norm2_g": norm2_g,
            "ev_w_in": ev_w_in, "ev_conv_w": ev_conv_w, "ev_dn_a_log": ev_dn_a_log,
            "ev_dn_dt_bias": ev_dn_dt_bias, "ev_dn_onorm_g": ev_dn_onorm_g, "ev_fox_f_bias": ev_fox_f_bias,
            "ev_fox_qnorm_g": ev_fox_qnorm_g, "ev_fox_knorm_g": ev_fox_knorm_g, "ev_w_out": ev_w_out,
            "od_w_in": od_w_in, "od_conv_w": od_conv_w, "od_conv_b": od_conv_b, "od_lru_wr": od_lru_wr,
            "od_lru_br": od_lru_br, "od_lru_wi": od_lru_wi, "od_lru_bi": od_lru_bi,
            "od_lru_lambda": od_lru_lambda, "od_sgu_norm_g": od_sgu_norm_g, "od_sgu_w": od_sgu_w,
            "od_sgu_b": od_sgu_b, "od_w_out": od_w_out, "router_w": router_w, "router_b": router_b,
            "moe_w_gate": moe_w_gate, "moe_w_up": moe_w_up, "moe_w_down": moe_w_down}


def reference(x, c, ada_w, ada_b, norm1_g, norm2_g,
              ev_w_in, ev_conv_w, ev_dn_a_log, ev_dn_dt_bias, ev_dn_onorm_g, ev_fox_f_bias,
              ev_fox_qnorm_g, ev_fox_knorm_g, ev_w_out,
              od_w_in, od_conv_w, od_conv_b, od_lru_wr, od_lru_br, od_lru_wi, od_lru_bi,
              od_lru_lambda, od_sgu_norm_g, od_sgu_w, od_sgu_b, od_w_out,
              router_w, router_b, moe_w_gate, moe_w_up, moe_w_down):
    c_act = jax.nn.silu(c)
    for layer in range(DEPTH):
        mod = c_act @ ada_w[layer] + ada_b[layer]
        sh1, sc1, gt1, sh2, sc2, gt2 = jnp.split(mod, 6, axis=-1)
        h = modulate(rmsnorm(x, norm1_g[layer]), sh1, sc1)
        i = layer // 2
        if layer % 2 == 0:
            y = even_mixer(h, ev_w_in[i], ev_conv_w[i], ev_dn_a_log[i], ev_dn_dt_bias[i],
                           ev_dn_onorm_g[i], ev_fox_f_bias[i], ev_fox_qnorm_g[i], ev_fox_knorm_g[i],
                           ev_w_out[i])
        else:
            y = odd_mixer(h, od_w_in[i], od_conv_w[i], od_conv_b[i], od_lru_wr[i], od_lru_br[i],
                          od_lru_wi[i], od_lru_bi[i], od_lru_lambda[i], od_sgu_norm_g[i],
                          od_sgu_w[i], od_sgu_b[i], od_w_out[i])
        x = x + gt1[:, None, :] * y
        h = modulate(rmsnorm(x, norm2_g[layer]), sh2, sc2)
        x = x + gt2[:, None, :] * moe(h, router_w, router_b, moe_w_gate[layer], moe_w_up[layer],
                                      moe_w_down[layer])
    return x
```

```cpp
#include <hip/hip_runtime.h>
#include <stdint.h>
#include <string.h>

typedef unsigned short bf16_t;
constexpr int B_ = 16, S_ = 2048, D_ = 1024, T_ = B_ * S_;
constexpr int EVN = 3600;

__device__ __forceinline__ float bf2f(bf16_t b) { return __uint_as_float(((unsigned)b) << 16); }
__device__ __forceinline__ bf16_t f2bf(float f) { unsigned u = __float_as_uint(f); u += 0x7FFFu + ((u >> 16) & 1u); return (bf16_t)(u >> 16); }
__device__ __forceinline__ float sigm(float x) { return 1.f / (1.f + __expf(-x)); }
__device__ __forceinline__ float siluf(float x) { return x * sigm(x); }
__device__ __forceinline__ float softplusf_(float x) { return x > 20.f ? x : log1pf(__expf(x)); }
__device__ __forceinline__ float geluf_(float x) { float u = 0.7978845608028654f * (x + 0.044715f * x * x * x); return 0.5f * x * (1.f + tanhf(u)); }
__device__ __forceinline__ float wave_sum(float v) { for (int o = 32; o > 0; o >>= 1) v += __shfl_xor(v, o); return v; }
__device__ __forceinline__ float wave_max(float v) { for (int o = 32; o > 0; o >>= 1) v = fmaxf(v, __shfl_xor(v, o)); return v; }

struct MapEv { __device__ int operator()(int j) const { if (j < 2048) return j; if (j < 2056) return 3584 + (j - 2048); if (j < 3592) return j - 8; return j; } };
struct MapId { __device__ int operator()(int j) const { return j; } };
struct MapEven { __device__ int operator()(int j) const { return 2 * j; } };
struct MapOdd { __device__ int operator()(int j) const { return 2 * j + 1; } };
template <class F>
__global__ __launch_bounds__(256) void k_tcvt(const float* __restrict__ src, int nsrc, int K, bf16_t* __restrict__ dst, size_t sstride, size_t dstride) {
    __shared__ float tile[64][65]; F rowmap;
    src += (size_t)blockIdx.z * sstride; dst += (size_t)blockIdx.z * dstride;
    const int j0 = blockIdx.x * 64, k0 = blockIdx.y * 64, tx = threadIdx.x & 63, ty = threadIdx.x >> 6;
    for (int kk = ty; kk < 64; kk += 4) tile[kk][tx] = (j0 + tx < nsrc) ? src[(size_t)(k0 + kk) * nsrc + j0 + tx] : 0.f;
    __syncthreads();
    for (int jj = ty; jj < 64; jj += 4) if (j0 + jj < nsrc) dst[(size_t)rowmap(j0 + jj) * K + k0 + tx] = f2bf(tile[tx][jj]);
}
__global__ void k_sguw(const float* __restrict__ w, bf16_t* __restrict__ dst) {
    int i = blockIdx.x * blockDim.x + threadIdx.x; if (i >= 4 * 128 * 128) return;
    int s = i & 127, t = (i >> 7) & 127; dst[i] = f2bf(s <= t ? w[i] : 0.f);
}
__global__ void k_zero_u32(unsigned* p, int n) { int i = blockIdx.x * blockDim.x + threadIdx.x; if (i < n) p[i] = 0u; }

__global__ __launch_bounds__(256) void k_mod(const float* __restrict__ c, const float* __restrict__ aw, const float* __restrict__ ab, float* __restrict__ mod) {
    __shared__ float ca[16][256];
    const int l = blockIdx.y, j = blockIdx.x * 256 + threadIdx.x;
    float acc[16];
#pragma unroll
    for (int b = 0; b < 16; ++b) acc[b] = 0.f;
    for (int k0 = 0; k0 < 1024; k0 += 256) {
        __syncthreads();
        for (int i = threadIdx.x; i < 16 * 256; i += 256) { int b = i >> 8, kk = i & 255; ca[b][kk] = siluf(c[b * 1024 + k0 + kk]); }
        __syncthreads();
        for (int kk = 0; kk < 256; ++kk) {
            const float w = aw[((size_t)l * 1024 + k0 + kk) * 6144 + j];
#pragma unroll
            for (int b = 0; b < 16; ++b) acc[b] += ca[b][kk] * w;
        }
    }
#pragma unroll
    for (int b = 0; b < 16; ++b) mod[((size_t)l * 16 + b) * 6144 + j] = acc[b] + ab[l * 6144 + j];
}

__global__ __launch_bounds__(256) void k_norm(const float* xin, const bf16_t* __restrict__ y, const float* __restrict__ gt2, float* xout,
                                             const float* __restrict__ g, const float* __restrict__ sc, const float* __restrict__ sh, bf16_t* __restrict__ hout) {
    const int lane = threadIdx.x & 63, wv = (blockIdx.x * 256 + threadIdx.x) >> 6, nw = gridDim.x * 4;
    for (int t = wv; t < T_; t += nw) {
        const int b = t >> 11;
        float v[16]; float ss = 0.f;
#pragma unroll
        for (int i = 0; i < 4; ++i) {
            const int col = i * 256 + lane * 4;
            float4 xv = *(const float4*)(xin + (size_t)t * 1024 + col);
            if (y) {
                const bf16_t* y0 = y + (size_t)(2 * t) * 1024 + col; const bf16_t* y1 = y0 + 1024;
                const float4 gv = *(const float4*)(gt2 + b * 6144 + col);
                xv.x += gv.x * (bf2f(y0[0]) + bf2f(y1[0])); xv.y += gv.y * (bf2f(y0[1]) + bf2f(y1[1]));
                xv.z += gv.z * (bf2f(y0[2]) + bf2f(y1[2])); xv.w += gv.w * (bf2f(y0[3]) + bf2f(y1[3]));
                *(float4*)(xout + (size_t)t * 1024 + col) = xv;
            }
            v[i * 4 + 0] = xv.x; v[i * 4 + 1] = xv.y; v[i * 4 + 2] = xv.z; v[i * 4 + 3] = xv.w;
            ss += xv.x * xv.x + xv.y * xv.y + xv.z * xv.z + xv.w * xv.w;
        }
        if (!hout) continue;
        ss = wave_sum(ss);
        const float rstd = rsqrtf(ss * (1.f / 1024.f) + 1e-6f);
#pragma unroll
        for (int i = 0; i < 4; ++i) {
            const int col = i * 256 + lane * 4;
#pragma unroll
            for (int q = 0; q < 4; ++q) {
                const float hv = v[i * 4 + q] * rstd * g[col + q] * (1.f + sc[b * 6144 + col + q]) + sh[b * 6144 + col + q];
                hout[(size_t)t * 1024 + col + q] = f2bf(hv);
            }
        }
    }
}

struct GemmArgs {
    const bf16_t* A; const bf16_t* Bt;
    bf16_t* O;
    const float* xin; float* xout; const float* gt;
    const int* cnt; const int* list; const float* gw;
    size_t wstride;
    int M, N, K, ldo;
};
static_assert(sizeof(GemmArgs) == 10 * 8 + 16, "no padding");
template <int MODE>
__global__ __launch_bounds__(256) void k_gemm(GemmArgs g) {
    __shared__ float As[32][68], Bs[32][68];
    __shared__ int rowp[64];
    const int tid = threadIdx.x, tx = tid & 15, ty = tid >> 4;
    int m0 = blockIdx.y * 64; const int n0 = blockIdx.x * 64;
    const bf16_t* Bt = g.Bt;
    int nvalid = 64;
    if (MODE >= 3) {
        int tile = blockIdx.y, e = 0, c = 0;
        for (; e < 16; ++e) { c = g.cnt[e]; int nt = (c + 63) >> 6; if (tile < nt) break; tile -= nt; }
        if (e == 16) return;
        nvalid = min(64, c - tile * 64);
        if (tid < 64) rowp[tid] = (tid < nvalid) ? g.list[e * T_ + tile * 64 + tid] : g.list[e * T_ + tile * 64];
        Bt += (size_t)e * g.wstride;
        __syncthreads();
    } else {
        if (tid < 64) rowp[tid] = m0 + tid;
        __syncthreads();
    }
    float acc[4][4];
#pragma unroll
    for (int i = 0; i < 4; ++i)
#pragma unroll
        for (int j = 0; j < 4; ++j) acc[i][j] = 0.f;
    const int lr = tid >> 2, lk = (tid & 3) * 8;
    const bf16_t* ap = g.A + (size_t)(MODE == 3 ? (rowp[lr] >> 1) : rowp[lr]) * g.K + lk;
    const int bn = n0 + lr;
    const bf16_t* bp = Bt + (size_t)(bn < g.N ? bn : 0) * g.K + lk;
    for (int k0 = 0; k0 < g.K; k0 += 32) {
        const uint4 av = *(const uint4*)(ap + k0), bv = *(const uint4*)(bp + k0);
        __syncthreads();
        const unsigned aw[4] = {av.x, av.y, av.z, av.w}, bw[4] = {bv.x, bv.y, bv.z, bv.w};
#pragma unroll
        for (int i = 0; i < 4; ++i) {
            As[lk + 2 * i][lr] = __uint_as_float(aw[i] << 16); As[lk + 2 * i + 1][lr] = __uint_as_float(aw[i] & 0xffff0000u);
            Bs[lk + 2 * i][lr] = __uint_as_float(bw[i] << 16); Bs[lk + 2 * i + 1][lr] = __uint_as_float(bw[i] & 0xffff0000u);
        }
        __syncthreads();
#pragma unroll 8
        for (int k = 0; k < 32; ++k) {
            const float4 a = *(const float4*)&As[k][ty * 4], b = *(const float4*)&Bs[k][tx * 4];
            const float aa[4] = {a.x, a.y, a.z, a.w}, bb[4] = {b.x, b.y, b.z, b.w};
#pragma unroll
            for (int i = 0; i < 4; ++i)
#pragma unroll
                for (int j = 0; j < 4; ++j) acc[i][j] += aa[i] * bb[j];
        }
    }
#pragma unroll
    for (int i = 0; i < 4; ++i) {
        const int r = ty * 4 + i; const int n = n0 + tx * 4;
        if (MODE == 0 || MODE == 2) {
            const int m = m0 + r;
#pragma unroll
            for (int j = 0; j < 4; ++j) if (n + j < g.N) { float v = acc[i][j]; if (MODE == 2 && n + j >= 512) v = geluf_(v); g.O[(size_t)m * g.ldo + n + j] = f2bf(v); }
        } else if (MODE == 1) {
            const int m = m0 + r, b = m >> 11;
#pragma unroll
            for (int j = 0; j < 4; ++j) g.xout[(size_t)m * 1024 + n + j] = g.xin[(size_t)m * 1024 + n + j] + g.gt[b * 6144 + n + j] * acc[i][j];
        } else if (MODE == 3) {
            if (r < nvalid) { const int p = rowp[r]; const float w = g.gw[p]; const int f0 = n >> 1;
                g.O[(size_t)p * 256 + f0] = f2bf(siluf(acc[i][0]) * acc[i][1] * w);
                g.O[(size_t)p * 256 + f0 + 1] = f2bf(siluf(acc[i][2]) * acc[i][3] * w); }
        } else if (MODE == 4) {
            if (r < nvalid) { const int p = rowp[r];
#pragma unroll
                for (int j = 0; j < 4; ++j) g.O[(size_t)p * 1024 + n + j] = f2bf(acc[i][j]); }
        }
    }
}

__global__ __launch_bounds__(256) void k_dnpre(const bf16_t* __restrict__ proj, const float* __restrict__ cw, const float* __restrict__ a_log, const float* __restrict__ dt_bias,
                                              bf16_t* __restrict__ qn, bf16_t* __restrict__ kn, bf16_t* __restrict__ vn, float* __restrict__ gdec, float* __restrict__ beta) {
    const int lane = threadIdx.x & 63, wv = (blockIdx.x * 256 + threadIdx.x) >> 6, nw = gridDim.x * 4;
    for (int it = wv; it < T_ * 12; it += nw) {
        const int t = it / 12, grp = it % 12, ten = grp >> 2, hd = grp & 3, s = t & 2047;
        const int c0 = ten * 512 + hd * 128 + lane * 2;
        float o0 = 0.f, o1 = 0.f;
#pragma unroll
        for (int j = 0; j < 4; ++j) {
            const int sp = s - 3 + j;
            if (sp >= 0) { const bf16_t* p = proj + (size_t)(t - 3 + j) * EVN + c0; o0 += cw[j * 1536 + c0] * bf2f(p[0]); o1 += cw[j * 1536 + c0 + 1] * bf2f(p[1]); }
        }
        o0 = siluf(o0); o1 = siluf(o1);
        if (ten < 2) {
            const float ss = wave_sum(o0 * o0 + o1 * o1);
            float r = rsqrtf(ss + 1e-6f); if (ten == 0) r *= 0.08838834764831845f;
            o0 *= r; o1 *= r;
        }
        bf16_t* dst = (ten == 0 ? qn : ten == 1 ? kn : vn) + (size_t)t * 512 + hd * 128 + lane * 2;
        dst[0] = f2bf(o0); dst[1] = f2bf(o1);
        if (ten == 2 && lane == 0) {
            const float a = bf2f(proj[(size_t)t * EVN + 3584 + hd]), bb = bf2f(proj[(size_t)t * EVN + 3588 + hd]);
            gdec[t * 4 + hd] = -__expf(a_log[hd]) * softplusf_(a + dt_bias[hd]);
            beta[t * 4 + hd] = sigm(bb);
        }
    }
}

__global__ __launch_bounds__(512) void k_dn_naive(const bf16_t* __restrict__ qn, const bf16_t* __restrict__ kn, const bf16_t* __restrict__ vn, const float* __restrict__ gdec,
                                                 const float* __restrict__ beta, const float* __restrict__ onorm_g, const bf16_t* __restrict__ proj, bf16_t* __restrict__ omix) {
    extern __shared__ __attribute__((aligned(16))) unsigned char smem[];
    float* qs = (float*)smem;
    float* ks = qs + 64 * 128;
    float* vs = ks + 64 * 128;
    float* os = vs + 64 * 128;
    float* red = os + 64 * 128;
    float* red2 = red + 512;
    float* ga = red2 + 512;
    float* gb = ga + 64;
    const int bh = blockIdx.x, b = bh >> 2, h = bh & 3, tid = threadIdx.x, j = tid & 127, r = tid >> 7;
    float Sreg[32];
#pragma unroll
    for (int i = 0; i < 32; ++i) Sreg[i] = 0.f;
    for (int c0 = 0; c0 < S_; c0 += 64) {
        __syncthreads();
        for (int i = tid; i < 64 * 128; i += 512) { const int rr = i >> 7, cc = i & 127; const size_t gi = (size_t)(b * S_ + c0 + rr) * 512 + h * 128 + cc;
            qs[i] = bf2f(qn[gi]); ks[i] = bf2f(kn[gi]); vs[i] = bf2f(vn[gi]); }
        if (tid < 64) { const int t = b * S_ + c0 + tid; ga[tid] = __expf(gdec[t * 4 + h]); gb[tid] = beta[t * 4 + h]; }
        __syncthreads();
        for (int s = 0; s < 64; ++s) {
            const float a = ga[s], be = gb[s];
            float part = 0.f;
#pragma unroll
            for (int i = 0; i < 32; ++i) part += ks[s * 128 + r * 32 + i] * Sreg[i];
            red[r * 128 + j] = part;
            __syncthreads();
            const float kS = red[j] + red[128 + j] + red[256 + j] + red[384 + j];
            const float vnew = be * (vs[s * 128 + j] - a * kS);
            float op = 0.f;
#pragma unroll
            for (int i = 0; i < 32; ++i) { Sreg[i] = a * Sreg[i] + ks[s * 128 + r * 32 + i] * vnew; op += qs[s * 128 + r * 32 + i] * Sreg[i]; }
            red2[r * 128 + j] = op;
            __syncthreads();
            if (r == 0) os[s * 128 + j] = red2[j] + red2[128 + j] + red2[256 + j] + red2[384 + j];
        }
        __syncthreads();
        { const int row = tid >> 3, sub = tid & 7; float ss = 0.f;
#pragma unroll
            for (int i = 0; i < 16; ++i) { const float v = os[row * 128 + sub * 16 + i]; ss += v * v; }
            ss += __shfl_xor(ss, 1); ss += __shfl_xor(ss, 2); ss += __shfl_xor(ss, 4);
            const float rstd = rsqrtf(ss * (1.f / 128.f) + 1e-6f);
            const int t = b * S_ + c0 + row;
#pragma unroll
            for (int i = 0; i < 16; ++i) { const int d = sub * 16 + i; const float z = bf2f(proj[(size_t)t * EVN + 1536 + h * 128 + d]);
                omix[(size_t)t * 1024 + h * 128 + d] = f2bf(os[row * 128 + d] * rstd * onorm_g[d] * siluf(z)); }
        }
    }
}

__global__ __launch_bounds__(256) void k_foxpre(const bf16_t* __restrict__ proj, const float* __restrict__ qg, const float* __restrict__ kg, const float* __restrict__ fbias,
                                               bf16_t* __restrict__ fqn, bf16_t* __restrict__ fkn, float* __restrict__ lf) {
    const int lane = threadIdx.x & 63, wv = (blockIdx.x * 256 + threadIdx.x) >> 6, nw = gridDim.x * 4;
    for (int it = wv; it < T_ * 8; it += nw) {
        const int t = it >> 3, grp = it & 7, which = grp >> 2, hd = grp & 3;
        const bf16_t* p = proj + (size_t)t * EVN + 2048 + which * 512 + hd * 128 + lane * 2;
        float v0 = bf2f(p[0]), v1 = bf2f(p[1]);
        const float ss = wave_sum(v0 * v0 + v1 * v1);
        const float rstd = rsqrtf(ss * (1.f / 128.f) + 1e-6f);
        const float* gg = which ? kg : qg;
        bf16_t* dst = (which ? fkn : fqn) + (size_t)t * 512 + hd * 128 + lane * 2;
        dst[0] = f2bf(v0 * rstd * gg[lane * 2]); dst[1] = f2bf(v1 * rstd * gg[lane * 2 + 1]);
        if (which == 0 && lane == 0) { const float x = bf2f(proj[(size_t)t * EVN + 3592 + hd]) + fbias[hd]; lf[t * 4 + hd] = -softplusf_(-x); }
    }
}
__global__ __launch_bounds__(64) void k_cumsum(const float* __restrict__ lf, float* __restrict__ cum) {
    const int bh = blockIdx.x, b = bh >> 2, h = bh & 3, lane = threadIdx.x;
    float loc[32]; float run = 0.f;
#pragma unroll
    for (int i = 0; i < 32; ++i) { run += lf[(size_t)(b * S_ + lane * 32 + i) * 4 + h]; loc[i] = run; }
    float inc = run;
    for (int o = 1; o < 64; o <<= 1) { const float n = __shfl_up(inc, o); if (lane >= o) inc += n; }
    const float excl = inc - run;
#pragma unroll
    for (int i = 0; i < 32; ++i) cum[(size_t)(b * S_ + lane * 32 + i) * 4 + h] = loc[i] + excl;
}
__global__ __launch_bounds__(256) void k_fox_naive(const bf16_t* __restrict__ fqn, const bf16_t* __restrict__ fkn, const bf16_t* __restrict__ proj, const float* __restrict__ cum,
                                                  bf16_t* __restrict__ omix) {
    __shared__ float qsh[4][128]; __shared__ float psh[4][64];
    const int lane = threadIdx.x & 63, w = threadIdx.x >> 6;
    const int item = blockIdx.x * 4 + w;
    const int t = item & 2047, h = (item >> 11) & 3, b = item >> 13;
    const size_t tq = (size_t)(b * S_ + t);
    qsh[w][lane * 2] = bf2f(fqn[tq * 512 + h * 128 + lane * 2]); qsh[w][lane * 2 + 1] = bf2f(fqn[tq * 512 + h * 128 + lane * 2 + 1]);
    __syncthreads();
    const float ct = cum[tq * 4 + h];
    float m = -1e30f, l = 0.f, o0 = 0.f, o1 = 0.f;
    for (int s0 = 0; s0 <= t; s0 += 64) {
        const int s = s0 + lane; const bool valid = s <= t;
        float logit = -1e30f;
        if (valid) {
            const bf16_t* kp = fkn + (size_t)(b * S_ + s) * 512 + h * 128; float dot = 0.f;
#pragma unroll
            for (int d8 = 0; d8 < 16; ++d8) { const uint4 kv = *(const uint4*)(kp + d8 * 8); const unsigned kw[4] = {kv.x, kv.y, kv.z, kv.w};
#pragma unroll
                for (int q = 0; q < 4; ++q) { dot += qsh[w][d8 * 8 + 2 * q] * __uint_as_float(kw[q] << 16) + qsh[w][d8 * 8 + 2 * q + 1] * __uint_as_float(kw[q] & 0xffff0000u); } }
            logit = dot * 0.08838834764831845f + ct - cum[(size_t)(b * S_ + s) * 4 + h];
        }
        const float mn = fmaxf(m, wave_max(logit));
        const float p = valid ? __expf(logit - mn) : 0.f;
        const float alpha = __expf(m - mn);
        l = l * alpha + wave_sum(p); o0 *= alpha; o1 *= alpha; m = mn;
        psh[w][lane] = p;
        __syncthreads();
        const int ns = min(64, t - s0 + 1);
        for (int i = 0; i < ns; ++i) { const float pi = psh[w][i]; const bf16_t* vp = proj + (size_t)(b * S_ + s0 + i) * EVN + 3072 + h * 128 + lane * 2;
            o0 += pi * bf2f(vp[0]); o1 += pi * bf2f(vp[1]); }
        __syncthreads();
    }
    const float inv = 1.f / l;
    omix[tq * 1024 + 512 + h * 128 + lane * 2] = f2bf(o0 * inv); omix[tq * 1024 + 512 + h * 128 + lane * 2 + 1] = f2bf(o1 * inv);
}

__global__ __launch_bounds__(256) void k_route(const float* __restrict__ x, const float* __restrict__ g, const float* __restrict__ sc, const float* __restrict__ sh,
                                              const float* __restrict__ rw, const float* __restrict__ rb, bf16_t* __restrict__ h2, int* __restrict__ cnt, int* __restrict__ list, float* __restrict__ gw) {
    const int lane = threadIdx.x & 63, wv = (blockIdx.x * 256 + threadIdx.x) >> 6, nw = gridDim.x * 4;
    for (int t = wv; t < T_; t += nw) {
        const int b = t >> 11;
        float v[16]; float ss = 0.f;
#pragma unroll
        for (int i = 0; i < 4; ++i) { const float4 xv = *(const float4*)(x + (size_t)t * 1024 + i * 256 + lane * 4);
            v[i * 4] = xv.x; v[i * 4 + 1] = xv.y; v[i * 4 + 2] = xv.z; v[i * 4 + 3] = xv.w; ss += xv.x * xv.x + xv.y * xv.y + xv.z * xv.z + xv.w * xv.w; }
        ss = wave_sum(ss);
        const float rstd = rsqrtf(ss * (1.f / 1024.f) + 1e-6f);
        float lg[16];
#pragma unroll
        for (int e = 0; e < 16; ++e) lg[e] = 0.f;
#pragma unroll
        for (int i = 0; i < 4; ++i)
#pragma unroll
            for (int q = 0; q < 4; ++q) { const int col = i * 256 + lane * 4 + q;
                const float hv = v[i * 4 + q] * rstd * g[col] * (1.f + sc[b * 6144 + col]) + sh[b * 6144 + col];
                h2[(size_t)t * 1024 + col] = f2bf(hv);
                const float4* rp = (const float4*)(rw + col * 16);
                const float4 r0 = rp[0], r1 = rp[1], r2 = rp[2], r3 = rp[3];
                lg[0] += hv * r0.x; lg[1] += hv * r0.y; lg[2] += hv * r0.z; lg[3] += hv * r0.w; lg[4] += hv * r1.x; lg[5] += hv * r1.y; lg[6] += hv * r1.z; lg[7] += hv * r1.w;
                lg[8] += hv * r2.x; lg[9] += hv * r2.y; lg[10] += hv * r2.z; lg[11] += hv * r2.w; lg[12] += hv * r3.x; lg[13] += hv * r3.y; lg[14] += hv * r3.z; lg[15] += hv * r3.w; }
#pragma unroll
        for (int e = 0; e < 16; ++e) lg[e] = wave_sum(lg[e]);
        if (lane == 0) {
            float mx = lg[0];
#pragma unroll
            for (int e = 1; e < 16; ++e) mx = fmaxf(mx, lg[e]);
            float pr[16]; float den = 0.f;
#pragma unroll
            for (int e = 0; e < 16; ++e) { pr[e] = __expf(lg[e] - mx); den += pr[e]; }
            const float inv = 1.f / den;
            float sel[16];
#pragma unroll
            for (int e = 0; e < 16; ++e) { pr[e] *= inv; sel[e] = pr[e] + rb[e]; }
            int bg = 0; float bgs = -1e30f;
#pragma unroll
            for (int gi = 0; gi < 4; ++gi) { float m1 = -1e30f, m2 = -1e30f;
#pragma unroll
                for (int q = 0; q < 4; ++q) { const float sv = sel[gi * 4 + q]; if (sv > m1) { m2 = m1; m1 = sv; } else if (sv > m2) m2 = sv; }
                const float gs = m1 + m2; if (gs > bgs) { bgs = gs; bg = gi; } }
            int e1 = 0, e2 = 0; float s1 = -1e30f, s2 = -1e30f, p1 = 0.f, p2 = 0.f;
#pragma unroll
            for (int gi = 0; gi < 4; ++gi) if (gi == bg) {
#pragma unroll
                for (int q = 0; q < 4; ++q) { const float sv = sel[gi * 4 + q], pv = pr[gi * 4 + q];
                    if (sv > s1) { s2 = s1; e2 = e1; p2 = p1; s1 = sv; e1 = gi * 4 + q; p1 = pv; } else if (sv > s2) { s2 = sv; e2 = gi * 4 + q; p2 = pv; } } }
            const float wn = 1.f / (p1 + p2);
            const int r1 = atomicAdd(&cnt[e1], 1); list[e1 * T_ + r1] = 2 * t; gw[2 * t] = p1 * wn;
            const int r2 = atomicAdd(&cnt[e2], 1); list[e2 * T_ + r2] = 2 * t + 1; gw[2 * t + 1] = p2 * wn;
        }
    }
}

__global__ __launch_bounds__(128) void k_lru_ab(const bf16_t* __restrict__ proj2, const float* __restrict__ cw, const float* __restrict__ cb, const bf16_t* __restrict__ wrT, const bf16_t* __restrict__ wiT,
                                               const float* __restrict__ br, const float* __restrict__ bi, const float* __restrict__ lam, float* __restrict__ aa, float* __restrict__ bb) {
    __shared__ float xc[128];
    const int t = blockIdx.x >> 2, hb = blockIdx.x & 3, j = threadIdx.x, c = hb * 128 + j, s = t & 2047;
    float x = cb[c];
#pragma unroll
    for (int q = 0; q < 4; ++q) { const int sp = s - 3 + q; if (sp >= 0) x += cw[q * 512 + c] * bf2f(proj2[(size_t)(t - 3 + q) * 2048 + c]); }
    xc[j] = x;
    __syncthreads();
    float ar = br[c], ai = bi[c];
    const bf16_t* wr = wrT + ((size_t)hb * 128 + j) * 128; const bf16_t* wi = wiT + ((size_t)hb * 128 + j) * 128;
    for (int i = 0; i < 128; ++i) { ar += xc[i] * bf2f(wr[i]); ai += xc[i] * bf2f(wi[i]); }
    const float r = sigm(ar), ig = sigm(ai);
    const float log_a = -8.f * r * softplusf_(-lam[c]);
    const float a = __expf(log_a);
    const float bq = sqrtf(fmaxf(0.f, -expm1f(2.f * log_a))) * (ig * x);
    aa[(size_t)t * 512 + c] = a; bb[(size_t)t * 512 + c] = bq;
}
__global__ __launch_bounds__(64) void k_lru_scan(const float* __restrict__ aa, const float* __restrict__ bb, const bf16_t* __restrict__ proj2, bf16_t* __restrict__ omix) {
    const int i = blockIdx.x * 64 + threadIdx.x, b = i >> 9, c = i & 511;
    float h = 0.f;
    for (int s = 0; s < S_; ++s) { const size_t t = (size_t)b * S_ + s; h = aa[t * 512 + c] * h + bb[t * 512 + c];
        omix[t * 1024 + c] = f2bf(h * bf2f(proj2[t * 2048 + 512 + c])); }
}
__global__ __launch_bounds__(256) void k_sgu_norm(const bf16_t* __restrict__ proj2, const float* __restrict__ g, bf16_t* __restrict__ vn) {
    const int lane = threadIdx.x & 63, wv = (blockIdx.x * 256 + threadIdx.x) >> 6, nw = gridDim.x * 4;
    for (int t = wv; t < T_; t += nw) {
        float v[8]; float ss = 0.f;
#pragma unroll
        for (int i = 0; i < 8; ++i) { v[i] = bf2f(proj2[(size_t)t * 2048 + 1536 + i * 64 + lane]); ss += v[i] * v[i]; }
        ss = wave_sum(ss); const float rstd = rsqrtf(ss * (1.f / 512.f) + 1e-6f);
#pragma unroll
        for (int i = 0; i < 8; ++i) vn[(size_t)t * 512 + i * 64 + lane] = f2bf(v[i] * rstd * g[i * 64 + lane]);
    }
}
__global__ __launch_bounds__(512) void k_sgu_mix(const bf16_t* __restrict__ proj2, const bf16_t* __restrict__ vn, const bf16_t* __restrict__ wb, const float* __restrict__ bs, bf16_t* __restrict__ omix) {
    const int t = blockIdx.x, tt = t & 127, t0 = t - tt, c = threadIdx.x, gi = c >> 7;
    float acc = bs[gi * 128 + tt];
    const bf16_t* wrow = wb + ((size_t)gi * 128 + tt) * 128;
    for (int s = 0; s <= tt; ++s) acc += bf2f(wrow[s]) * bf2f(vn[(size_t)(t0 + s) * 512 + c]);
    omix[(size_t)t * 1024 + 512 + c] = f2bf(bf2f(proj2[(size_t)t * 2048 + 1024 + c]) * acc);
}

static inline size_t al(size_t x) { return (x + 255) & ~(size_t)255; }

extern "C" void kernel_launch(void* const* d_in, const int* in_sizes, int n_in, void* d_out, int out_size, void* d_ws, size_t ws_size, hipStream_t stream) {
    const float* x = (const float*)d_in[0]; const float* c = (const float*)d_in[1]; const float* ada_w = (const float*)d_in[2]; const float* ada_b = (const float*)d_in[3];
    const float* norm1_g = (const float*)d_in[4]; const float* norm2_g = (const float*)d_in[5];
    const float* ev_w_in = (const float*)d_in[6]; const float* ev_conv_w = (const float*)d_in[7]; const float* ev_a_log = (const float*)d_in[8]; const float* ev_dt_bias = (const float*)d_in[9];
    const float* ev_onorm_g = (const float*)d_in[10]; const float* ev_f_bias = (const float*)d_in[11]; const float* ev_qnorm_g = (const float*)d_in[12]; const float* ev_knorm_g = (const float*)d_in[13];
    const float* ev_w_out = (const float*)d_in[14];
    const float* od_w_in = (const float*)d_in[15]; const float* od_conv_w = (const float*)d_in[16]; const float* od_conv_b = (const float*)d_in[17];
    const float* od_wr = (const float*)d_in[18]; const float* od_br = (const float*)d_in[19]; const float* od_wi = (const float*)d_in[20]; const float* od_bi = (const float*)d_in[21];
    const float* od_lam = (const float*)d_in[22]; const float* od_sgu_g = (const float*)d_in[23]; const float* od_sgu_w = (const float*)d_in[24]; const float* od_sgu_b = (const float*)d_in[25];
    const float* od_w_out = (const float*)d_in[26]; const float* router_w = (const float*)d_in[27]; const float* router_b = (const float*)d_in[28];
    const float* moe_wg = (const float*)d_in[29]; const float* moe_wu = (const float*)d_in[30]; const float* moe_wd = (const float*)d_in[31];
    float* out = (float*)d_out;

    unsigned char* ws = (unsigned char*)d_ws; size_t off = 0;
    auto take = [&](size_t bytes) { unsigned char* p = ws + off; off += al(bytes); return p; };
    bf16_t* W_evin = (bf16_t*)take((size_t)EVN * 1024 * 2);
    bf16_t* W_evout = (bf16_t*)take((size_t)1024 * 1024 * 2);
    bf16_t* W_odin = (bf16_t*)take((size_t)2048 * 1024 * 2);
    bf16_t* W_odout = (bf16_t*)take((size_t)1024 * 1024 * 2);
    bf16_t* W_moe1 = (bf16_t*)take((size_t)2 * 16 * 512 * 1024 * 2);
    bf16_t* W_moe2 = (bf16_t*)take((size_t)2 * 16 * 1024 * 256 * 2);
    bf16_t* W_lr = (bf16_t*)take((size_t)4 * 128 * 128 * 2);
    bf16_t* W_li = (bf16_t*)take((size_t)4 * 128 * 128 * 2);
    bf16_t* W_sgu = (bf16_t*)take((size_t)4 * 128 * 128 * 2);
    float* mod = (float*)take((size_t)2 * 16 * 6144 * 4);
    int* cnt = (int*)take(256);
    int* list = (int*)take((size_t)16 * T_ * 4);
    float* gw = (float*)take((size_t)2 * T_ * 4);
    float* gdec = (float*)take((size_t)T_ * 4 * 4);
    float* beta = (float*)take((size_t)T_ * 4 * 4);
    float* lf = (float*)take((size_t)T_ * 4 * 4);
    float* cum = (float*)take((size_t)T_ * 4 * 4);
    bf16_t* H = (bf16_t*)take((size_t)T_ * 1024 * 2);
    unsigned char* PROJ = take((size_t)T_ * EVN * 2);
    bf16_t* OMIX = (bf16_t*)take((size_t)T_ * 1024 * 2);
    bf16_t* VN = (bf16_t*)take((size_t)T_ * 512 * 2);
    (void)ws_size; (void)n_in; (void)in_sizes; (void)out_size;

    k_tcvt<MapEv><<<dim3(57, 16, 1), 256, 0, stream>>>(ev_w_in, 3596, 1024, W_evin, 0, 0);
    k_zero_u32<<<8, 256, 0, stream>>>((unsigned*)(W_evin + (size_t)3596 * 1024), 4 * 1024 / 2);
    k_tcvt<MapId><<<dim3(16, 16, 1), 256, 0, stream>>>(ev_w_out, 1024, 1024, W_evout, 0, 0);
    k_tcvt<MapId><<<dim3(32, 16, 1), 256, 0, stream>>>(od_w_in, 2048, 1024, W_odin, 0, 0);
    k_tcvt<MapId><<<dim3(16, 16, 1), 256, 0, stream>>>(od_w_out, 1024, 1024, W_odout, 0, 0);
    k_tcvt<MapEven><<<dim3(4, 16, 32), 256, 0, stream>>>(moe_wg, 256, 1024, W_moe1, (size_t)1024 * 256, (size_t)512 * 1024);
    k_tcvt<MapOdd><<<dim3(4, 16, 32), 256, 0, stream>>>(moe_wu, 256, 1024, W_moe1, (size_t)1024 * 256, (size_t)512 * 1024);
    k_tcvt<MapId><<<dim3(16, 4, 32), 256, 0, stream>>>(moe_wd, 1024, 256, W_moe2, (size_t)256 * 1024, (size_t)1024 * 256);
    k_tcvt<MapId><<<dim3(2, 2, 4), 256, 0, stream>>>(od_wr, 128, 128, W_lr, (size_t)128 * 128, (size_t)128 * 128);
    k_tcvt<MapId><<<dim3(2, 2, 4), 256, 0, stream>>>(od_wi, 128, 128, W_li, (size_t)128 * 128, (size_t)128 * 128);
    k_sguw<<<256, 256, 0, stream>>>(od_sgu_w, W_sgu);
    k_mod<<<dim3(24, 2), 256, 0, stream>>>(c, ada_w, ada_b, mod);

    const float* mod0 = mod; const float* mod1 = mod + 16 * 6144;
    k_norm<<<2048, 256, 0, stream>>>(x, nullptr, nullptr, nullptr, norm1_g, mod0 + 1024, mod0 + 0, H);
    { GemmArgs g; memset(&g, 0, sizeof(g)); g.A = H; g.Bt = W_evin; g.M = T_; g.N = EVN; g.K = 1024; g.O = (bf16_t*)PROJ; g.ldo = EVN;
      k_gemm<0><<<dim3((EVN + 63) / 64, T_ / 64), 256, 0, stream>>>(g); }
    bf16_t* qn = H; bf16_t* kn = H + (size_t)T_ * 512;
    k_dnpre<<<4096, 256, 0, stream>>>((const bf16_t*)PROJ, ev_conv_w, ev_a_log, ev_dt_bias, qn, kn, VN, gdec, beta);
    { const size_t sm = (size_t)(4 * 64 * 128 + 1024 + 128) * 4;
      (void)hipFuncSetAttribute((const void*)k_dn_naive, hipFuncAttributeMaxDynamicSharedMemorySize, (int)sm);
      k_dn_naive<<<64, 512, sm, stream>>>(qn, kn, VN, gdec, beta, ev_onorm_g, (const bf16_t*)PROJ, OMIX); }
    bf16_t* fqn = H; bf16_t* fkn = H + (size_t)T_ * 512;
    k_foxpre<<<4096, 256, 0, stream>>>((const bf16_t*)PROJ, ev_qnorm_g, ev_knorm_g, ev_f_bias, fqn, fkn, lf);
    k_cumsum<<<64, 64, 0, stream>>>(lf, cum);
    k_fox_naive<<<B_ * 4 * S_ / 4, 256, 0, stream>>>(fqn, fkn, (const bf16_t*)PROJ, cum, OMIX);
    { GemmArgs g; memset(&g, 0, sizeof(g)); g.A = OMIX; g.Bt = W_evout; g.M = T_; g.N = 1024; g.K = 1024; g.xin = x; g.xout = out; g.gt = mod0 + 2048;
      k_gemm<1><<<dim3(16, T_ / 64), 256, 0, stream>>>(g); }
    bf16_t* ACT = (bf16_t*)PROJ; bf16_t* Y = (bf16_t*)(PROJ + (size_t)2 * T_ * 256 * 2);
    for (int l = 0; l < 2; ++l) {
        const float* modl = l ? mod1 : mod0;
        if (l == 1) {
            k_norm<<<2048, 256, 0, stream>>>(out, Y, mod0 + 5120, out, norm1_g + 1024, mod1 + 1024, mod1 + 0, H);
            bf16_t* P2 = (bf16_t*)PROJ; float* AA = (float*)(PROJ + (size_t)T_ * 2048 * 2); float* BB = (float*)H;
            { GemmArgs g; memset(&g, 0, sizeof(g)); g.A = H; g.Bt = W_odin; g.M = T_; g.N = 2048; g.K = 1024; g.O = P2; g.ldo = 2048;
              k_gemm<2><<<dim3(32, T_ / 64), 256, 0, stream>>>(g); }
            k_lru_ab<<<T_ * 4, 128, 0, stream>>>(P2, od_conv_w, od_conv_b, W_lr, W_li, od_br, od_bi, od_lam, AA, BB);
            k_lru_scan<<<B_ * 512 / 64, 64, 0, stream>>>(AA, BB, P2, OMIX);
            k_sgu_norm<<<2048, 256, 0, stream>>>(P2, od_sgu_g, VN);
            k_sgu_mix<<<T_, 512, 0, stream>>>(P2, VN, W_sgu, od_sgu_b, OMIX);
            { GemmArgs g; memset(&g, 0, sizeof(g)); g.A = OMIX; g.Bt = W_odout; g.M = T_; g.N = 1024; g.K = 1024; g.xin = out; g.xout = out; g.gt = mod1 + 2048;
              k_gemm<1><<<dim3(16, T_ / 64), 256, 0, stream>>>(g); }
        }
        k_zero_u32<<<1, 64, 0, stream>>>((unsigned*)cnt, 16);
        k_route<<<2048, 256, 0, stream>>>(out, norm2_g + l * 1024, modl + 4096, modl + 3072, router_w, router_b, H, cnt, list, gw);
        { GemmArgs g; memset(&g, 0, sizeof(g)); g.A = H; g.Bt = W_moe1 + (size_t)l * 16 * 512 * 1024; g.M = 0; g.N = 512; g.K = 1024; g.O = ACT; g.cnt = cnt; g.list = list; g.gw = gw; g.wstride = (size_t)512 * 1024;
          k_gemm<3><<<dim3(8, 2 * T_ / 64 + 16), 256, 0, stream>>>(g); }
        { GemmArgs g; memset(&g, 0, sizeof(g)); g.A = ACT; g.Bt = W_moe2 + (size_t)l * 16 * 1024 * 256; g.M = 0; g.N = 1024; g.K = 256; g.O = Y; g.cnt = cnt; g.list = list; g.gw = gw; g.wstride = (size_t)1024 * 256;
          k_gemm<4><<<dim3(16, 2 * T_ / 64 + 16), 256, 0, stream>>>(g); }
    }
    k_norm<<<2048, 256, 0, stream>>>(out, Y, mod1 + 5120, out, nullptr, nullptr, nullptr, nullptr);
}
```

```cpp
#include <hip/hip_runtime.h>
#include <hip/hip_cooperative_groups.h>
#include <stdint.h>
#include <string.h>
namespace cg = cooperative_groups;

#define PG8_LAS __attribute__((address_space(3)))
typedef unsigned short bf16_t;
constexpr int B_ = 16, S_ = 2048, D_ = 1024, T_ = B_ * S_;
constexpr int EVN = 3584;
constexpr int NT = 512;
constexpr int LDS_BYTES = 139264;

__device__ __forceinline__ float bf2f(bf16_t b) { return __uint_as_float(((unsigned)b) << 16); }
__device__ __forceinline__ bf16_t f2bf(float f) { unsigned u = __float_as_uint(f); u += 0x7FFFu + ((u >> 16) & 1u); return (bf16_t)(u >> 16); }
typedef __bf16 pk_bf16x2_t __attribute__((ext_vector_type(2)));
typedef float pk_f32x2_t __attribute__((ext_vector_type(2)));
__device__ __forceinline__ unsigned pk_bf16(float lo, float hi) { pk_f32x2_t f = {lo, hi}; pk_bf16x2_t b = __builtin_convertvector(f, pk_bf16x2_t); return __builtin_bit_cast(unsigned, b); }
__device__ __forceinline__ float sigm(float x) { return __builtin_amdgcn_rcpf(1.f + __builtin_amdgcn_exp2f(-1.4426950408889634f * x)); }
__device__ __forceinline__ float siluf(float x) { return x * sigm(x); }
__device__ __forceinline__ float softplusf_(float x) { return x > 20.f ? x : log1pf(__expf(x)); }
__device__ __forceinline__ float softplus_fast(float x) { return x > 15.f ? x : __logf(1.f + __expf(x)); }
__device__ __forceinline__ float geluf_(float x) { const float x2 = x * x; const float t = x * fmaf(x2, -0.10294324f, -2.3022082f); return x * __builtin_amdgcn_rcpf(1.f + __builtin_amdgcn_exp2f(t)); }
template <int CTRL> __device__ __forceinline__ float dppf(float v) { return __int_as_float(__builtin_amdgcn_update_dpp(0, __float_as_int(v), CTRL, 0xf, 0xf, false)); }
__device__ __forceinline__ float red8_sum(float v) { v += dppf<0xB1>(v); v += dppf<0x4E>(v); v += dppf<0x141>(v); return v; }
__device__ __forceinline__ float wave_sum(float v) {
    v += dppf<0xB1>(v); v += dppf<0x4E>(v); v += dppf<0x141>(v); v += dppf<0x140>(v);
    { auto r = __builtin_amdgcn_permlane16_swap(__float_as_uint(v), __float_as_uint(v), false, false); v = __uint_as_float(r[0]) + __uint_as_float(r[1]); }
    { auto r = __builtin_amdgcn_permlane32_swap(__float_as_uint(v), __float_as_uint(v), false, false); v = __uint_as_float(r[0]) + __uint_as_float(r[1]); }
    return v;
}
__device__ __forceinline__ float wave_max(float v) {
    v = fmaxf(v, dppf<0xB1>(v)); v = fmaxf(v, dppf<0x4E>(v)); v = fmaxf(v, dppf<0x141>(v)); v = fmaxf(v, dppf<0x140>(v));
    { auto r = __builtin_amdgcn_permlane16_swap(__float_as_uint(v), __float_as_uint(v), false, false); v = fmaxf(__uint_as_float(r[0]), __uint_as_float(r[1])); }
    { auto r = __builtin_amdgcn_permlane32_swap(__float_as_uint(v), __float_as_uint(v), false, false); v = fmaxf(__uint_as_float(r[0]), __uint_as_float(r[1])); }
    return v;
}
__device__ __forceinline__ int otid(const int WV) { int l; asm volatile("v_mbcnt_lo_u32_b32 %0, -1, 0\n\tv_mbcnt_hi_u32_b32 %0, -1, %0" : "=v"(l)); return WV * 64 + l; }

struct Params {
    const float *x, *c, *ada_w, *ada_b, *norm1_g, *norm2_g, *ev_w_in, *ev_conv_w, *ev_a_log, *ev_dt_bias, *ev_onorm_g, *ev_f_bias, *ev_qnorm_g, *ev_knorm_g, *ev_w_out;
    const float *od_w_in, *od_conv_w, *od_conv_b, *od_wr, *od_br, *od_wi, *od_bi, *od_lam, *od_sgu_g, *od_sgu_w, *od_sgu_b, *od_w_out, *router_w, *router_b, *moe_wg, *moe_wu, *moe_wd;
    float* out;
    bf16_t *W_evin, *W_evout, *W_odin, *W_odout, *W_moe1, *W_moe2, *W_lr, *W_li, *W_sgu;
    float* mod; int* cnt; unsigned* bar; int* list; float* gw; float* gdec; float* beta; float* lf; float* cum;
    bf16_t* H; unsigned char* PROJ; bf16_t* OMIX; bf16_t* VN; bf16_t* DNQK; float* DNGL; float* small;
};
static_assert(sizeof(Params) % 8 == 0, "params");
typedef const __attribute__((address_space(4))) Params CParams;

struct MapEv { __device__ int operator()(int j) const { if (j < 2048) return j; if (j < 2056) return 3584 + (j - 2048); if (j < 3592) return j - 8; return j; } };
struct MapId { __device__ int operator()(int j) const { return j; } };
struct MapEven { __device__ int operator()(int j) const { return 2 * j; } };
struct MapOdd { __device__ int operator()(int j) const { return 2 * j + 1; } };
template <class F>
__device__ __forceinline__ void ph_tcvt(const int WV, const float* __restrict__ src0, int nsrc, int K, bf16_t* __restrict__ dst0, size_t sstride, size_t dstride, int nz, unsigned char* smem) {
    const int tix_ = otid(WV);
    float (*tile)[64][65] = (float (*)[64][65])smem; F rowmap;
    const int half = tix_ >> 8, tid = tix_ & 255, tx4 = tid & 15, ty4 = tid >> 4;
    const int nj = (nsrc + 63) >> 6, nk = K >> 6, ntiles = nj * nk * nz;
    float4 v[4];
    auto ldtile = [&](int vt) {
        const int z = vt / (nj * nk), rem = vt % (nj * nk), j0 = (rem % nj) * 64, k0 = (rem / nj) * 64;
        const float* src = src0 + (size_t)z * sstride;
#pragma unroll
        for (int ps = 0; ps < 4; ++ps) { v[ps] = make_float4(0.f, 0.f, 0.f, 0.f); if (j0 + 4 * tx4 < nsrc) v[ps] = *(const float4*)(src + (size_t)(k0 + ty4 + 16 * ps) * nsrc + j0 + 4 * tx4); }
    };
    int base = blockIdx.x * 2;
    if (base + half < ntiles) ldtile(base + half);
    for (; base < ntiles; base += gridDim.x * 2) {
        const int vt = base + half; const bool valid = vt < ntiles;
        const int z = vt / (nj * nk), rem = vt % (nj * nk), j0 = (rem % nj) * 64, k0 = (rem / nj) * 64;
        bf16_t* dst = dst0 + (size_t)z * dstride;
        __syncthreads();
        if (valid) {
#pragma unroll
            for (int ps = 0; ps < 4; ++ps) { const int kk = ty4 + 16 * ps; tile[half][kk][4 * tx4] = v[ps].x; tile[half][kk][4 * tx4 + 1] = v[ps].y; tile[half][kk][4 * tx4 + 2] = v[ps].z; tile[half][kk][4 * tx4 + 3] = v[ps].w; } }
        __syncthreads();
        { const int nvt = vt + gridDim.x * 2; if (nvt < ntiles) ldtile(nvt); }
        if (valid) { const int kq = tid & 15, jr = tid >> 4;
#pragma unroll
            for (int ps = 0; ps < 4; ++ps) { const int jj = jr + 16 * ps; if (j0 + jj < nsrc) { const int r = rowmap(j0 + jj);
                if (r >= 0) { uint2 o; o.x = pk_bf16(tile[half][4 * kq][jj], tile[half][4 * kq + 1][jj]); o.y = pk_bf16(tile[half][4 * kq + 2][jj], tile[half][4 * kq + 3][jj]);
                    *(uint2*)(dst + (size_t)r * K + k0 + 4 * kq) = o; } } } }
    }
    __syncthreads();
}
__device__ __forceinline__ void ph_misc(const int WV, CParams& p) {
    const int tix_ = otid(WV);
    const int gtid = blockIdx.x * NT + tix_, gn = gridDim.x * NT;
    for (int i = gtid; i < 4 * 128 * 128; i += gn) { const int s = i & 127, t = (i >> 7) & 127; p.W_sgu[i] = f2bf(s <= t ? p.od_sgu_w[i] : 0.f); }
    if (gtid < 64) p.cnt[gtid] = 0;
    for (int i = gtid; i < 4 * 1024 / 2; i += gn) ((unsigned*)(p.W_evin + (size_t)3596 * 1024))[i] = 0u;
}

__device__ __forceinline__ void ph_mod(const int WV, CParams& p, unsigned char* smem) {
    const int tix_ = otid(WV);
    const int lane = tix_ & 63, w = tix_ >> 6;
    float* ca = (float*)smem;
    float* red = ca + 16384;
    __syncthreads();
#pragma unroll 8
    for (int i = tix_; i < 16384; i += NT) { const int b = i >> 10, k = i & 1023; ca[k * 16 + b] = siluf(p.c[i]); }
    __syncthreads();
    for (int item = blockIdx.x; item < 256; item += gridDim.x) {
        const int cidx = item * 48 + min(lane, 47), l = cidx / 6144, j = cidx % 6144;
        float acc[16];
#pragma unroll
        for (int b = 0; b < 16; ++b) acc[b] = 0.f;
        const float* wp = p.ada_w + ((size_t)l * 1024 + 128 * w) * 6144 + j;
#pragma unroll 1
        for (int kb = 0; kb < 128; kb += 32) {
            float wv[32];
#pragma unroll
            for (int kk = 0; kk < 32; ++kk) wv[kk] = wp[(size_t)(kb + kk) * 6144];
#pragma unroll
            for (int kk = 0; kk < 32; ++kk) { const float4* cp = (const float4*)(ca + (128 * w + kb + kk) * 16);
                const float4 c0 = cp[0], c1 = cp[1], c2 = cp[2], c3 = cp[3]; const float x = wv[kk];
                acc[0] += c0.x * x; acc[1] += c0.y * x; acc[2] += c0.z * x; acc[3] += c0.w * x; acc[4] += c1.x * x; acc[5] += c1.y * x; acc[6] += c1.z * x; acc[7] += c1.w * x;
                acc[8] += c2.x * x; acc[9] += c2.y * x; acc[10] += c2.z * x; acc[11] += c2.w * x; acc[12] += c3.x * x; acc[13] += c3.y * x; acc[14] += c3.z * x; acc[15] += c3.w * x; }
        }
#pragma unroll
        for (int b = 0; b < 16; ++b) red[(w * 16 + b) * 64 + lane] = acc[b];
        __syncthreads();
#pragma unroll
        for (int i = 0; i < 2; ++i) { const int o = tix_ + i * NT, b = o >> 6, cl = o & 63; float sum = 0.f;
#pragma unroll
            for (int ww = 0; ww < 8; ++ww) sum += red[(ww * 16 + b) * 64 + cl];
            const int ci2 = item * 48 + cl, l2 = ci2 / 6144, j2 = ci2 % 6144;
            if (cl < 48) p.mod[((size_t)l2 * 16 + b) * 6144 + j2] = sum + p.ada_b[l2 * 6144 + j2]; }
        __syncthreads();
    }
}

__device__ __forceinline__ float4 ld_res4(const void* p, size_t idx, bool is16) {
    if (is16) { const uint2 v = *(const uint2*)((const bf16_t*)p + idx); return make_float4(__uint_as_float(v.x << 16), __uint_as_float(v.x & 0xffff0000u), __uint_as_float(v.y << 16), __uint_as_float(v.y & 0xffff0000u)); }
    return *(const float4*)((const float*)p + idx);
}
template <bool XIN16, bool XOUT16>
__device__ __forceinline__ void ph_norm(const int WV, CParams& p, const void* xin, const bf16_t* __restrict__ y, const float* __restrict__ gt2, void* xout,
                        const float* __restrict__ g, const float* __restrict__ sc, const float* __restrict__ sh, bf16_t* __restrict__ hout, unsigned char* smem) {
    const int tix_ = otid(WV);
    const int lane = tix_ & 63, wv = (blockIdx.x * NT + tix_) >> 6, nw = gridDim.x * (NT / 64);
    constexpr int U = 2;
    for (int tb = wv * U; tb < T_; tb += nw * U) {
        const int b = tb >> 11;
        float4 xv[U][4]; float ss[U];
#pragma unroll
        for (int u = 0; u < U; ++u)
#pragma unroll
            for (int i = 0; i < 4; ++i) xv[u][i] = ld_res4(xin, (size_t)(tb + u) * 1024 + i * 256 + lane * 4, XIN16);
        if (y) {
#pragma unroll
            for (int i = 0; i < 4; ++i) { const int col = i * 256 + lane * 4; const float4 gv = *(const float4*)(gt2 + b * 6144 + col);
#pragma unroll
                for (int u = 0; u < U; ++u) { const bf16_t* y0 = y + (size_t)(2 * (tb + u)) * 1024 + col; const uint2 a0 = *(const uint2*)y0, a1 = *(const uint2*)(y0 + 1024);
                    float4 v = xv[u][i];
                    v.x += gv.x * (__uint_as_float(a0.x << 16) + __uint_as_float(a1.x << 16)); v.y += gv.y * (__uint_as_float(a0.x & 0xffff0000u) + __uint_as_float(a1.x & 0xffff0000u));
                    v.z += gv.z * (__uint_as_float(a0.y << 16) + __uint_as_float(a1.y << 16)); v.w += gv.w * (__uint_as_float(a0.y & 0xffff0000u) + __uint_as_float(a1.y & 0xffff0000u));
                    xv[u][i] = v;
                    if (XOUT16) { uint2 o; o.x = pk_bf16(v.x, v.y); o.y = pk_bf16(v.z, v.w); *(uint2*)((bf16_t*)xout + (size_t)(tb + u) * 1024 + col) = o; }
                    else *(float4*)((float*)xout + (size_t)(tb + u) * 1024 + col) = v; } }
        }
        if (!hout) continue;
#pragma unroll
        for (int u = 0; u < U; ++u) { float a = 0.f;
#pragma unroll
            for (int i = 0; i < 4; ++i) a += xv[u][i].x * xv[u][i].x + xv[u][i].y * xv[u][i].y + xv[u][i].z * xv[u][i].z + xv[u][i].w * xv[u][i].w;
            ss[u] = rsqrtf(wave_sum(a) * (1.f / 1024.f) + 1e-6f); }
#pragma unroll
        for (int i = 0; i < 4; ++i) {
            const int col = i * 256 + lane * 4;
            const float4 gv = *(const float4*)(g + col), scv = *(const float4*)(sc + b * 6144 + col), shv = *(const float4*)(sh + b * 6144 + col);
            const float m0 = gv.x * (1.f + scv.x), m1 = gv.y * (1.f + scv.y), m2 = gv.z * (1.f + scv.z), m3 = gv.w * (1.f + scv.w);
#pragma unroll
            for (int u = 0; u < U; ++u) { const float r = ss[u];
                uint2 o; o.x = pk_bf16(xv[u][i].x * r * m0 + shv.x, xv[u][i].y * r * m1 + shv.y); o.y = pk_bf16(xv[u][i].z * r * m2 + shv.z, xv[u][i].w * r * m3 + shv.w);
                *(uint2*)(hout + (size_t)(tb + u) * 1024 + col) = o; }
        }
    }
}

typedef short dn_bf16x8 __attribute__((ext_vector_type(8)));
typedef float dn_f32x4 __attribute__((ext_vector_type(4)));
struct DnBufs { bf16_t* Wp; bf16_t* QDp; bf16_t* KDTp; bf16_t* UTp; bf16_t* QKp; float* GL; };
__device__ __forceinline__ dn_f32x4 dn_mfma(dn_bf16x8 a, dn_bf16x8 b, dn_f32x4 c) { return __builtin_amdgcn_mfma_f32_16x16x32_bf16(a, b, c, 0, 0, 0); }
__device__ __forceinline__ unsigned dn_pk(float lo, float hi) { return pk_bf16(lo, hi); }
#define DN_LFENCE() asm volatile("s_waitcnt lgkmcnt(0)" ::: "memory")

__device__ __forceinline__ void dn_conv_tile(const bf16_t* __restrict__ proj, const float* __restrict__ cw, int t0, int s0, int ten, int hd, int lane, bf16_t* tile) {
    const int col = ten * 512 + hd * 128 + lane * 2;
    const float wa0 = cw[0 * 1536 + col], wa1 = cw[1 * 1536 + col], wa2 = cw[2 * 1536 + col], wa3 = cw[3 * 1536 + col];
    const float wb0 = cw[0 * 1536 + col + 1], wb1 = cw[1 * 1536 + col + 1], wb2 = cw[2 * 1536 + col + 1], wb3 = cw[3 * 1536 + col + 1];
    const bf16_t* src = proj + (size_t)t0 * EVN + col;
    float a0 = 0.f, a1 = 0.f, a2 = 0.f, b0 = 0.f, b1 = 0.f, b2 = 0.f;
    if (s0 > 0) {
        const unsigned p0 = *(const unsigned*)(src - 3 * EVN), p1 = *(const unsigned*)(src - 2 * EVN), p2 = *(const unsigned*)(src - 1 * EVN);
        a0 = __uint_as_float(p0 << 16); b0 = __uint_as_float(p0 & 0xffff0000u); a1 = __uint_as_float(p1 << 16); b1 = __uint_as_float(p1 & 0xffff0000u); a2 = __uint_as_float(p2 << 16); b2 = __uint_as_float(p2 & 0xffff0000u);
    }
#pragma unroll
    for (int rb = 0; rb < 2; ++rb) {
        unsigned pv[16];
#pragma unroll
        for (int r = 0; r < 16; ++r) pv[r] = *(const unsigned*)(src + (size_t)(rb * 16 + r) * EVN);
#pragma unroll
        for (int r = 0; r < 16; ++r) {
            const float a3 = __uint_as_float(pv[r] << 16), b3 = __uint_as_float(pv[r] & 0xffff0000u);
            const float oa = siluf(wa0 * a0 + wa1 * a1 + wa2 * a2 + wa3 * a3), ob = siluf(wb0 * b0 + wb1 * b1 + wb2 * b2 + wb3 * b3);
            *(unsigned*)(tile + (rb * 16 + r) * 136 + lane * 2) = dn_pk(oa, ob);
            a0 = a1; a1 = a2; a2 = a3; b0 = b1; b1 = b2; b2 = b3;
        }
    }
}

__device__ __forceinline__ void ph_dn_prep(const int WV, CParams& p, const bf16_t* __restrict__ proj, const DnBufs d, unsigned char* smem) {
    const int tid = otid(WV), lane = tid & 63, w = tid >> 6, c = lane & 15, g = lane >> 4;
    unsigned char* base = smem + w * 16896;
    bf16_t* tile = (bf16_t*)base; float* Lm = (float*)(base + 8704); bf16_t* Tm = (bf16_t*)(base + 13312); float* tab = (float*)(base + 15872);
    float* t_gc = tab, *t_be = tab + 32, *t_ek = tab + 64, *t_dk = tab + 96, *t_rk = tab + 128, *t_rq = tab + 160;
    const int gw = blockIdx.x * (NT / 64) + w, nw = gridDim.x * (NT / 64);
    for (int ci = gw; ci < 64 * 64; ci += nw) {
        const int bh = ci >> 6, ch = ci & 63, b = bh >> 2, hd = bh & 3, s0 = ch * 32, t0 = b * S_ + s0;
        DN_LFENCE();
        if (lane < 32) { const float* sp = p.small + (size_t)(t0 + lane) * 16; t_gc[lane] = -__expf(p.ev_a_log[hd]) * softplus_fast(sp[hd] + p.ev_dt_bias[hd]); t_be[lane] = sigm(sp[4 + hd]); }
        DN_LFENCE();
        float gcs = 0.f;
        if (lane < 32) { for (int i = 0; i <= lane; ++i) gcs += t_gc[i]; }
        DN_LFENCE();
        if (lane < 32) { t_gc[lane] = gcs; t_ek[lane] = __expf(gcs); }
        DN_LFENCE();
        const float gc31 = t_gc[31];
        if (lane < 32) t_dk[lane] = __expf(gc31 - gcs);
        dn_conv_tile(proj, p.ev_conv_w, t0, s0, 1, hd, lane, tile);
        DN_LFENCE();
        dn_bf16x8 Kr[2][4];
#pragma unroll
        for (int mi = 0; mi < 2; ++mi)
#pragma unroll
            for (int s = 0; s < 4; ++s) Kr[mi][s] = *(const dn_bf16x8*)(tile + (16 * mi + c) * 136 + 32 * s + 8 * g);
        union U8 { dn_bf16x8 v; unsigned short e[8]; unsigned u[4]; };
        U8 KT[8];
#pragma unroll
        for (int mb = 0; mb < 8; ++mb)
#pragma unroll
            for (int jj = 0; jj < 8; ++jj) KT[mb].e[jj] = tile[(16 * (jj >> 2) + 4 * g + (jj & 3)) * 136 + 16 * mb + c];
        dn_f32x4 ak[2][2];
#pragma unroll
        for (int mi = 0; mi < 2; ++mi)
#pragma unroll
            for (int nj = 0; nj < 2; ++nj) { dn_f32x4 a = {0.f, 0.f, 0.f, 0.f};
#pragma unroll
                for (int s = 0; s < 4; ++s) a = dn_mfma(Kr[mi][s], Kr[nj][s], a);
                ak[mi][nj] = a; }
#pragma unroll
        for (int mi = 0; mi < 2; ++mi)
#pragma unroll
            for (int r = 0; r < 4; ++r) if (g == (c >> 2) && (c & 3) == r) t_rk[16 * mi + c] = rsqrtf(ak[mi][mi][r] + 1e-6f);
        DN_LFENCE();
#pragma unroll
        for (int mi = 0; mi < 2; ++mi)
#pragma unroll
            for (int nj = 0; nj < 2; ++nj)
#pragma unroll
                for (int r = 0; r < 4; ++r) { const int i = 16 * mi + 4 * g + r, j = 16 * nj + c;
                    const float v = (i > j) ? t_be[i] * t_rk[i] * t_rk[j] * ak[mi][nj][r] * __expf(t_gc[i] - t_gc[j]) : 0.f;
                    Lm[i * 36 + j] = v; }
        DN_LFENCE();
        {
            const int cc = lane & 31;
            float T[32];
#pragma unroll
            for (int i = 0; i < 32; ++i) {
                float acc = (i == cc) ? 1.f : 0.f;
#pragma unroll
                for (int j4 = 0; j4 < (i + 3) / 4; ++j4) { const dn_f32x4 lv = *(const dn_f32x4*)(Lm + i * 36 + 4 * j4);
#pragma unroll
                    for (int q = 0; q < 4; ++q) if (4 * j4 + q < i) acc -= lv[q] * T[4 * j4 + q]; }
                T[i] = acc;
            }
            if (lane < 32) {
#pragma unroll
                for (int i = 0; i < 32; ++i) Tm[i * 40 + cc] = f2bf(T[i]);
            }
        }
        DN_LFENCE();
        U8 Tr[2];
#pragma unroll
        for (int mi = 0; mi < 2; ++mi) { const uint2 lo = *(const uint2*)(Tm + (16 * mi + c) * 40 + 4 * g), hi = *(const uint2*)(Tm + (16 * mi + c) * 40 + 16 + 4 * g);
            Tr[mi].u[0] = lo.x; Tr[mi].u[1] = lo.y; Tr[mi].u[2] = hi.x; Tr[mi].u[3] = hi.y; }
        dn_conv_tile(proj, p.ev_conv_w, t0, s0, 0, hd, lane, tile);
        DN_LFENCE();
        dn_f32x4 as_[2][2];
        {
            dn_bf16x8 Qr[2][4];
#pragma unroll
            for (int ni = 0; ni < 2; ++ni)
#pragma unroll
                for (int s = 0; s < 4; ++s) Qr[ni][s] = *(const dn_bf16x8*)(tile + (16 * ni + c) * 136 + 32 * s + 8 * g);
#pragma unroll
            for (int mj = 0; mj < 2; ++mj)
#pragma unroll
                for (int ni = 0; ni < 2; ++ni) { dn_f32x4 a = {0.f, 0.f, 0.f, 0.f};
#pragma unroll
                    for (int s = 0; s < 4; ++s) a = dn_mfma(Kr[mj][s], Qr[ni][s], a);
                    as_[mj][ni] = a; }
#pragma unroll
            for (int ni = 0; ni < 2; ++ni) { dn_f32x4 a = {0.f, 0.f, 0.f, 0.f};
#pragma unroll
                for (int s = 0; s < 4; ++s) a = dn_mfma(Qr[ni][s], Qr[ni][s], a);
#pragma unroll
                for (int r = 0; r < 4; ++r) if (g == (c >> 2) && (c & 3) == r) t_rq[16 * ni + c] = rsqrtf(a[r] + 1e-6f) * 0.08838834764831845f; }
        }
        DN_LFENCE();
        { bf16_t* qo = d.QDp + (size_t)ci * 4096;
#pragma unroll
            for (int it = 0; it < 8; ++it) { const int id = it * 64 + lane, i = id >> 4, s = (id >> 2) & 3, gg = id & 3;
                const uint2 lo = *(const uint2*)(tile + i * 136 + 32 * s + 4 * gg), hi = *(const uint2*)(tile + i * 136 + 32 * s + 16 + 4 * gg);
                const float f = t_rq[i] * t_ek[i];
                uint4 o; o.x = dn_pk(__uint_as_float(lo.x << 16) * f, __uint_as_float(lo.x & 0xffff0000u) * f); o.y = dn_pk(__uint_as_float(lo.y << 16) * f, __uint_as_float(lo.y & 0xffff0000u) * f);
                o.z = dn_pk(__uint_as_float(hi.x << 16) * f, __uint_as_float(hi.x & 0xffff0000u) * f); o.w = dn_pk(__uint_as_float(hi.y << 16) * f, __uint_as_float(hi.y & 0xffff0000u) * f);
                *(uint4*)(qo + i * 128 + 32 * s + 8 * gg) = o; } }
        DN_LFENCE();
        dn_conv_tile(proj, p.ev_conv_w, t0, s0, 2, hd, lane, tile);
        DN_LFENCE();
        float bej[8], fwj[8], fkj[8];
#pragma unroll
        for (int jj = 0; jj < 8; ++jj) { const int j = 16 * (jj >> 2) + 4 * g + (jj & 3); const float rk = t_rk[j]; bej[jj] = t_be[j]; fwj[jj] = bej[jj] * rk * t_ek[j]; fkj[jj] = rk * t_dk[j]; }
        U8 VT[8];
#pragma unroll
        for (int nb = 0; nb < 8; ++nb) {
            float tv[8];
#pragma unroll
            for (int jj = 0; jj < 8; ++jj) tv[jj] = bf2f(tile[(16 * (jj >> 2) + 4 * g + (jj & 3)) * 136 + 16 * nb + c]) * bej[jj];
#pragma unroll
            for (int q = 0; q < 4; ++q) VT[nb].u[q] = dn_pk(tv[2 * q], tv[2 * q + 1]);
        }
        { bf16_t* uo = d.UTp + (size_t)ci * 4096;
#pragma unroll
            for (int nb = 0; nb < 8; ++nb)
#pragma unroll
                for (int mi = 0; mi < 2; ++mi) { const dn_f32x4 z4 = {0.f, 0.f, 0.f, 0.f}; const dn_f32x4 a = dn_mfma(Tr[mi].v, VT[nb].v, z4);
                    uint2 o; o.x = dn_pk(a[0], a[1]); o.y = dn_pk(a[2], a[3]); *(uint2*)(uo + (16 * nb + c) * 32 + 16 * mi + 4 * g) = o; } }
        { bf16_t* ko = d.KDTp + (size_t)ci * 4096; bf16_t* wo = d.Wp + (size_t)ci * 4096;
#pragma unroll
            for (int s = 0; s < 4; ++s) {
                U8 kw[2];
#pragma unroll
                for (int hf = 0; hf < 2; ++hf) { const int mb = 2 * s + hf; float kv[8];
#pragma unroll
                    for (int jj = 0; jj < 8; ++jj) kv[jj] = bf2f(KT[mb].e[jj]);
                    uint4 o; o.x = dn_pk(kv[0] * fkj[0], kv[1] * fkj[1]); o.y = dn_pk(kv[2] * fkj[2], kv[3] * fkj[3]); o.z = dn_pk(kv[4] * fkj[4], kv[5] * fkj[5]); o.w = dn_pk(kv[6] * fkj[6], kv[7] * fkj[7]);
                    *(uint4*)(ko + (16 * mb + c) * 32 + 8 * g) = o;
#pragma unroll
                    for (int q = 0; q < 4; ++q) kw[hf].u[q] = dn_pk(kv[2 * q] * fwj[2 * q], kv[2 * q + 1] * fwj[2 * q + 1]); }
#pragma unroll
                for (int ni = 0; ni < 2; ++ni) { const dn_f32x4 z4 = {0.f, 0.f, 0.f, 0.f};
                    const dn_f32x4 c0 = dn_mfma(kw[0].v, Tr[ni].v, z4), c1 = dn_mfma(kw[1].v, Tr[ni].v, z4);
                    uint4 o; o.x = dn_pk(c0[0], c0[1]); o.y = dn_pk(c0[2], c0[3]); o.z = dn_pk(c1[0], c1[1]); o.w = dn_pk(c1[2], c1[3]);
                    *(uint4*)(wo + (16 * ni + c) * 128 + 32 * s + 8 * g) = o; }
            } }
        { bf16_t* qo = d.QKp + (size_t)ci * 1024;
#pragma unroll
            for (int ni = 0; ni < 2; ++ni) { const int i = 16 * ni + c; const float rq = t_rq[i], gi = t_gc[i]; float v[8];
#pragma unroll
                for (int mj = 0; mj < 2; ++mj)
#pragma unroll
                    for (int r = 0; r < 4; ++r) { const int j = 16 * mj + 4 * g + r; v[4 * mj + r] = (i >= j) ? as_[mj][ni][r] * rq * t_rk[j] * __expf(gi - t_gc[j]) : 0.f; }
                uint4 o; o.x = dn_pk(v[0], v[1]); o.y = dn_pk(v[2], v[3]); o.z = dn_pk(v[4], v[5]); o.w = dn_pk(v[6], v[7]);
                *(uint4*)(qo + i * 32 + 8 * g) = o; } }
        if (lane == 0) d.GL[ci] = __expf(gc31);
    }
    __syncthreads();
}

#define DN_DECL(R) uint4 R##w, R##qd, R##kdt, R##ut, R##qk, R##z; float R##gl
#define DN_LOAD(R, ci_, trow_) do { const size_t _ci = (ci_); \
    R##w = *(const uint4*)(d.Wp + _ci * 4096 + tid * 8); R##qd = *(const uint4*)(d.QDp + _ci * 4096 + tid * 8); R##kdt = *(const uint4*)(d.KDTp + _ci * 4096 + tid * 8); \
    R##ut = *(const uint4*)(d.UTp + _ci * 4096 + tid * 8); R##qk = *(const uint4*)(d.QKp + _ci * 1024 + (tid & 127) * 8); R##gl = d.GL[_ci]; \
    R##z = *(const uint4*)(proj + (size_t)(trow_) * EVN + 1536 + hd * 128 + (tid & 15) * 8); } while (0)
#define DN_WRITE(R, bb_) do { unsigned char* _bb = (bb_); \
    *(uint4*)(_bb + (tid >> 4) * 272 + (tid & 15) * 16) = R##w; *(uint4*)(_bb + 8704 + (tid >> 4) * 272 + (tid & 15) * 16) = R##qd; \
    *(uint4*)(_bb + 17408 + tid * 16) = R##kdt; *(uint4*)(_bb + 25600 + tid * 16) = R##ut; if (tid < 128) *(uint4*)(_bb + 33792 + tid * 16) = R##qk; } while (0)
__device__ __forceinline__ void dn_step_compute(dn_f32x4 (&Sf)[8], const unsigned char* bb, float* Ot, float gl, int w, int c, int g) {
    union U8 { dn_bf16x8 v; unsigned u[4]; };
    U8 Sb[4];
#pragma unroll
    for (int s = 0; s < 4; ++s) { Sb[s].u[0] = dn_pk(Sf[2 * s][0], Sf[2 * s][1]); Sb[s].u[1] = dn_pk(Sf[2 * s][2], Sf[2 * s][3]); Sb[s].u[2] = dn_pk(Sf[2 * s + 1][0], Sf[2 * s + 1][1]); Sb[s].u[3] = dn_pk(Sf[2 * s + 1][2], Sf[2 * s + 1][3]); }
    dn_f32x4 vn[2], O[2];
#pragma unroll
    for (int mi = 0; mi < 2; ++mi) {
        dn_f32x4 P = {0.f, 0.f, 0.f, 0.f}, Oa = {0.f, 0.f, 0.f, 0.f};
#pragma unroll
        for (int s = 0; s < 4; ++s) { const dn_bf16x8 wa = *(const dn_bf16x8*)(bb + (16 * mi + c) * 272 + 64 * s + 16 * g); P = dn_mfma(wa, Sb[s].v, P);
            const dn_bf16x8 qa = *(const dn_bf16x8*)(bb + 8704 + (16 * mi + c) * 272 + 64 * s + 16 * g); Oa = dn_mfma(qa, Sb[s].v, Oa); }
        const uint2 uu = *(const uint2*)(bb + 25600 + (16 * w + c) * 64 + (16 * mi + 4 * g) * 2);
        vn[mi][0] = __uint_as_float(uu.x << 16) - P[0]; vn[mi][1] = __uint_as_float(uu.x & 0xffff0000u) - P[1]; vn[mi][2] = __uint_as_float(uu.y << 16) - P[2]; vn[mi][3] = __uint_as_float(uu.y & 0xffff0000u) - P[3];
        O[mi] = Oa;
    }
    U8 Vb; Vb.u[0] = dn_pk(vn[0][0], vn[0][1]); Vb.u[1] = dn_pk(vn[0][2], vn[0][3]); Vb.u[2] = dn_pk(vn[1][0], vn[1][1]); Vb.u[3] = dn_pk(vn[1][2], vn[1][3]);
#pragma unroll
    for (int mi = 0; mi < 2; ++mi) { const dn_bf16x8 qk = *(const dn_bf16x8*)(bb + 33792 + (16 * mi + c) * 64 + 16 * g); O[mi] = dn_mfma(qk, Vb.v, O[mi]);
#pragma unroll
        for (int r = 0; r < 4; ++r) Ot[(16 * mi + 4 * g + r) * 132 + 16 * w + c] = O[mi][r]; }
#pragma unroll
    for (int mb = 0; mb < 8; ++mb) { const dn_bf16x8 ka = *(const dn_bf16x8*)(bb + 17408 + (16 * mb + c) * 64 + 16 * g); Sf[mb] = dn_mfma(ka, Vb.v, Sf[mb] * gl); }
}
__device__ __forceinline__ void dn_step_norm(const float* Ot, uint4 zz, const float4 g0, const float4 g1, bf16_t* __restrict__ omix, size_t t, int hd, int tid) {
    const int row = tid >> 4, sub = tid & 15;
    const dn_f32x4 o0 = *(const dn_f32x4*)(Ot + row * 132 + sub * 8), o1 = *(const dn_f32x4*)(Ot + row * 132 + sub * 8 + 4);
    float ss = o0[0] * o0[0] + o0[1] * o0[1] + o0[2] * o0[2] + o0[3] * o0[3] + o1[0] * o1[0] + o1[1] * o1[1] + o1[2] * o1[2] + o1[3] * o1[3];
    ss += dppf<0xB1>(ss); ss += dppf<0x4E>(ss); ss += dppf<0x141>(ss); ss += dppf<0x140>(ss);
    const float rstd = rsqrtf(ss * (1.f / 128.f) + 1e-6f);
    uint4 ov;
    ov.x = dn_pk(o0[0] * rstd * g0.x * siluf(__uint_as_float(zz.x << 16)), o0[1] * rstd * g0.y * siluf(__uint_as_float(zz.x & 0xffff0000u)));
    ov.y = dn_pk(o0[2] * rstd * g0.z * siluf(__uint_as_float(zz.y << 16)), o0[3] * rstd * g0.w * siluf(__uint_as_float(zz.y & 0xffff0000u)));
    ov.z = dn_pk(o1[0] * rstd * g1.x * siluf(__uint_as_float(zz.z << 16)), o1[1] * rstd * g1.y * siluf(__uint_as_float(zz.z & 0xffff0000u)));
    ov.w = dn_pk(o1[2] * rstd * g1.z * siluf(__uint_as_float(zz.w << 16)), o1[3] * rstd * g1.w * siluf(__uint_as_float(zz.w & 0xffff0000u)));
    *(uint4*)(omix + (t + row) * 1024 + hd * 128 + sub * 8) = ov;
}
__device__ __forceinline__ void ph_dn_scan(const int WV, CParams& p, const bf16_t* __restrict__ proj, const DnBufs d, bf16_t* __restrict__ omix, unsigned char* smem) {
    const int tid = otid(WV), lane = tid & 63, w = tid >> 6, c = lane & 15, g = lane >> 4;
    constexpr int BUF = 35840, OFF_O = 2 * BUF, OSZ = 32 * 132 * 4;
    for (int bh = blockIdx.x; bh < 64; bh += gridDim.x) {
        const int b = bh >> 2, hd = bh & 3; const size_t ci0 = (size_t)bh * 64, tr0 = (size_t)b * S_ + (tid >> 4);
        dn_f32x4 Sf[8];
#pragma unroll
        for (int mb = 0; mb < 8; ++mb) Sf[mb] = (dn_f32x4){0.f, 0.f, 0.f, 0.f};
        const float4 og0 = *(const float4*)(p.ev_onorm_g + (tid & 15) * 8), og1 = *(const float4*)(p.ev_onorm_g + (tid & 15) * 8 + 4);
        DN_DECL(R0); DN_DECL(R1);
        DN_LOAD(R0, ci0, tr0);
        DN_LOAD(R1, ci0 + 1, tr0 + 32);
        __syncthreads();
        DN_WRITE(R0, smem);
        float gl0 = R0gl; uint4 z0 = R0z;
        __syncthreads();
        for (int ch = 0; ch < 64; ch += 2) {
            const int n2 = min(ch + 2, 63), n3 = min(ch + 3, 63);
            DN_LOAD(R0, ci0 + n2, tr0 + (size_t)n2 * 32);
            dn_step_compute(Sf, smem, (float*)(smem + OFF_O), gl0, w, c, g);
            DN_WRITE(R1, smem + BUF);
            const float gl1 = R1gl; const uint4 z1 = R1z;
            __syncthreads();
            dn_step_norm((const float*)(smem + OFF_O), z0, og0, og1, omix, (size_t)b * S_ + ch * 32, hd, tid);
            DN_LOAD(R1, ci0 + n3, tr0 + (size_t)n3 * 32);
            dn_step_compute(Sf, smem + BUF, (float*)(smem + OFF_O + OSZ), gl1, w, c, g);
            DN_WRITE(R0, smem); gl0 = R0gl; z0 = R0z;
            __syncthreads();
            dn_step_norm((const float*)(smem + OFF_O + OSZ), z1, og0, og1, omix, (size_t)b * S_ + (ch + 1) * 32, hd, tid);
        }
        __syncthreads();
    }
}

__device__ __forceinline__ void ph_small_gemm(const int WV, CParams& p, unsigned char* smem) {
    const int tid = otid(WV), lane = tid & 63, c = lane & 15, g4 = lane >> 4;
    constexpr int RP = 1032;
    bf16_t* Ws = (bf16_t*)smem;
    __syncthreads();
    for (int i = tid; i < 16 * 128; i += NT) { const int r = i >> 7, ch = i & 127; *(uint4*)(Ws + r * RP + ch * 8) = *(const uint4*)(p.W_evin + (size_t)(3584 + r) * 1024 + ch * 8); }
    __syncthreads();
    const int gw = blockIdx.x * (NT / 64) + (tid >> 6), nw = gridDim.x * (NT / 64);
    for (int rb = gw; rb < T_ / 16; rb += nw) {
        const bf16_t* ap = p.H + (size_t)(rb * 16 + c) * 1024 + 8 * g4;
        dn_f32x4 acc = {0.f, 0.f, 0.f, 0.f};
#pragma unroll
        for (int kb = 0; kb < 2; ++kb) {
            dn_bf16x8 af[16];
#pragma unroll
            for (int ks = 0; ks < 16; ++ks) af[ks] = *(const dn_bf16x8*)(ap + 32 * (kb * 16 + ks));
#pragma unroll
            for (int ks = 0; ks < 16; ++ks) acc = dn_mfma(af[ks], *(const dn_bf16x8*)(Ws + c * RP + 32 * (kb * 16 + ks) + 8 * g4), acc);
        }
#pragma unroll
        for (int r = 0; r < 4; ++r) p.small[(size_t)(rb * 16 + 4 * g4 + r) * 16 + c] = acc[r];
    }
    __syncthreads();
}
__device__ __forceinline__ uint4 fx_knorm(uint4 v, const float* __restrict__ gp) {
    const float4 ga = *(const float4*)gp, gb = *(const float4*)(gp + 4); const float g[8] = {ga.x, ga.y, ga.z, ga.w, gb.x, gb.y, gb.z, gb.w};
    const unsigned u[4] = {v.x, v.y, v.z, v.w}; float f[8]; float ss = 0.f;
#pragma unroll
    for (int k = 0; k < 4; ++k) { f[2 * k] = __uint_as_float(u[k] << 16); f[2 * k + 1] = __uint_as_float(u[k] & 0xffff0000u); ss += f[2 * k] * f[2 * k] + f[2 * k + 1] * f[2 * k + 1]; }
    ss += dppf<0xB1>(ss); ss += dppf<0x4E>(ss); ss += dppf<0x141>(ss); ss += dppf<0x140>(ss);
    const float r = rsqrtf(ss * (1.f / 128.f) + 1e-6f);
    uint4 o; o.x = pk_bf16(f[0] * r * g[0], f[1] * r * g[1]); o.y = pk_bf16(f[2] * r * g[2], f[3] * r * g[3]); o.z = pk_bf16(f[4] * r * g[4], f[5] * r * g[5]); o.w = pk_bf16(f[6] * r * g[6], f[7] * r * g[7]);
    return o;
}
__device__ __forceinline__ void ph_foxpre(const int WV, CParams& p, const bf16_t* __restrict__ proj, bf16_t* __restrict__ fk, bf16_t* __restrict__ vt, unsigned char* smem) {
    const int tix_ = otid(WV);
    bf16_t* tile = (bf16_t*)smem;
    for (int item = blockIdx.x; item < 64 * 32; item += gridDim.x) {
        const int bh = item >> 5, st = item & 31, bb = bh >> 2, hd = bh & 3, t0 = bb * S_ + st * 64;
        __syncthreads();
#pragma unroll
        for (int i = 0; i < 2; ++i) { const int id = tix_ + i * NT, r = id >> 4, c16 = id & 15;
            const uint4 kv = *(const uint4*)(proj + (size_t)(t0 + r) * EVN + 2560 + hd * 128 + c16 * 8);
            *(uint4*)(fk + ((size_t)bh * S_ + st * 64 + r) * 128 + c16 * 8) = fx_knorm(kv, p.ev_knorm_g + c16 * 8); }
#pragma unroll
        for (int i = 0; i < 2; ++i) { const int id = tix_ + i * NT, r = id >> 4, c16 = id & 15;
            const uint4 v = *(const uint4*)(proj + (size_t)(t0 + r) * EVN + 3072 + hd * 128 + c16 * 8);
            unsigned* d = (unsigned*)(tile + r * 130 + c16 * 8); d[0] = v.x; d[1] = v.y; d[2] = v.z; d[3] = v.w; }
        __syncthreads();
        { const int d = tix_ >> 2, qt = tix_ & 3; unsigned w[8];
#pragma unroll
            for (int i = 0; i < 8; ++i) w[i] = (unsigned)tile[(qt * 16 + 2 * i) * 130 + d] | ((unsigned)tile[(qt * 16 + 2 * i + 1) * 130 + d] << 16);
            uint4* dst = (uint4*)(vt + ((size_t)bh * 128 + d) * S_ + st * 64 + qt * 16);
            dst[0] = make_uint4(w[0], w[1], w[2], w[3]); dst[1] = make_uint4(w[4], w[5], w[6], w[7]); }
    }
    __syncthreads();
}
__device__ __forceinline__ void ph_cumsum(const int WV, CParams& p, unsigned char* smem) {
    const int tix_ = otid(WV);
    const int lane = tix_ & 63, w = tix_ >> 6, wv = (blockIdx.x * NT + tix_) >> 6, nw = gridDim.x * (NT / 64);
    float* part = (float*)smem + w * 64;
    for (int bh = wv; bh < 64; bh += nw) {
        const int b = bh >> 2, h = bh & 3;
        float loc[32]; float run = 0.f;
#pragma unroll
        for (int i = 0; i < 32; ++i) { run += -softplus_fast(-(p.small[(size_t)(b * S_ + lane * 32 + i) * 16 + 8 + h] + p.ev_f_bias[h])); loc[i] = run; }
        asm volatile("s_waitcnt lgkmcnt(0)" ::: "memory");
        part[lane] = run;
        asm volatile("s_waitcnt lgkmcnt(0)" ::: "memory");
        float excl = 0.f;
        for (int i = 0; i < lane; ++i) excl += part[i];
#pragma unroll
        for (int i = 0; i < 32; ++i) p.cum[(size_t)(b * S_ + lane * 32 + i) * 4 + h] = loc[i] + excl;
    }
    __syncthreads();
}

typedef short fx_bf16x8 __attribute__((ext_vector_type(8)));
typedef float fx_f32x16 __attribute__((ext_vector_type(16)));
typedef float fx_f32x4 __attribute__((ext_vector_type(4)));
__device__ __forceinline__ unsigned fx_pk(float lo, float hi) { return pk_bf16(lo, hi); }
__device__ __forceinline__ void ph_fox_flash(const int WV, CParams& p, const bf16_t* __restrict__ proj, const bf16_t* __restrict__ fk, const bf16_t* __restrict__ vt, bf16_t* __restrict__ omix, unsigned char* smem) {
    const int tid = otid(WV), lane = tid & 63, w = tid >> 6, c = lane & 31, h5 = lane >> 5;
    constexpr int KB = 16384, VB = 128 * 136, OFF_V = 2 * KB, OFF_B = OFF_V + 2 * VB, OFF_I = OFF_B + 2 * 256;
    constexpr float C2 = 0.08838834764831845f * 1.4426950408889634f, NEG_INV_SCALE = -11.313708498984761f;
    int* itemw = (int*)(smem + OFF_I);
    for (;;) {
        __syncthreads();
        if (tid == 0) itemw[0] = atomicAdd(p.cnt + 32, 1);
        __syncthreads();
        const int idx = itemw[0];
        if (idx >= 512) break;
        const int qb = 7 - (idx >> 6), bh = idx & 63, b = bh >> 2, hd = bh & 3;
        const int q0 = qb * 256 + w * 32, ntiles = 4 * (qb + 1);
        fx_bf16x8 qf[8];
        { const bf16_t* qp = proj + ((size_t)(b * S_ + q0 + c)) * EVN + 2048 + hd * 128 + 8 * h5;
          float ssq = 0.f;
#pragma unroll
          for (int s = 0; s < 8; ++s) { qf[s] = *(const fx_bf16x8*)(qp + 16 * s);
#pragma unroll
              for (int j = 0; j < 8; ++j) { const float v = bf2f((bf16_t)qf[s][j]); ssq += v * v; } }
          { auto rr = __builtin_amdgcn_permlane32_swap(__float_as_uint(ssq), __float_as_uint(ssq), false, false); ssq = __uint_as_float(rr[0]) + __uint_as_float(rr[1]); }
          const float rq = rsqrtf(ssq * (1.f / 128.f) + 1e-6f);
#pragma unroll
          for (int s = 0; s < 8; ++s) { const float4 g0 = *(const float4*)(p.ev_qnorm_g + 16 * s + 8 * h5), g1 = *(const float4*)(p.ev_qnorm_g + 16 * s + 8 * h5 + 4);
              union { fx_bf16x8 v; unsigned u[4]; } t;
              t.u[0] = pk_bf16(bf2f((bf16_t)qf[s][0]) * rq * g0.x, bf2f((bf16_t)qf[s][1]) * rq * g0.y); t.u[1] = pk_bf16(bf2f((bf16_t)qf[s][2]) * rq * g0.z, bf2f((bf16_t)qf[s][3]) * rq * g0.w);
              t.u[2] = pk_bf16(bf2f((bf16_t)qf[s][4]) * rq * g1.x, bf2f((bf16_t)qf[s][5]) * rq * g1.y); t.u[3] = pk_bf16(bf2f((bf16_t)qf[s][6]) * rq * g1.z, bf2f((bf16_t)qf[s][7]) * rq * g1.w);
              qf[s] = t.v; } }
        fx_f32x16 o[4];
#pragma unroll
        for (int mb = 0; mb < 4; ++mb)
#pragma unroll
            for (int r = 0; r < 16; ++r) o[mb][r] = 0.f;
        float m = -1e30f, l = 0.f;
        const float ct2 = p.cum[(size_t)(b * S_ + q0 + c) * 4 + hd] * 1.4426950408889634f;
        const bf16_t* kg = fk + (size_t)bh * S_ * 128;
        const bf16_t* vg = vt + (size_t)bh * 128 * S_;
        uint4 kr0, kr1, vr0, vr1; float br = 0.f;
        const int idA = tid, idB = tid + NT;
        kr0 = *(const uint4*)(kg + (size_t)(idA >> 4) * 128 + (idA & 15) * 8); kr1 = *(const uint4*)(kg + (size_t)(idB >> 4) * 128 + (idB & 15) * 8);
        vr0 = *(const uint4*)(vg + (size_t)(idA >> 3) * S_ + (idA & 7) * 8); vr1 = *(const uint4*)(vg + (size_t)(idB >> 3) * S_ + (idB & 7) * 8);
        if (tid < 64) br = p.cum[(size_t)(b * S_ + tid) * 4 + hd] * NEG_INV_SCALE;
        { const int rA = idA >> 4, chA = idA & 15, rB = idB >> 4, chB = idB & 15;
          *(uint4*)(smem + rA * 256 + ((chA ^ (rA & 15)) << 4)) = kr0; *(uint4*)(smem + rB * 256 + ((chB ^ (rB & 15)) << 4)) = kr1;
          uint2* vd = (uint2*)(smem + OFF_V + (idA >> 3) * 136 + (idA & 7) * 16); vd[0] = make_uint2(vr0.x, vr0.y); vd[1] = make_uint2(vr0.z, vr0.w);
          vd = (uint2*)(smem + OFF_V + (idB >> 3) * 136 + (idB & 7) * 16); vd[0] = make_uint2(vr1.x, vr1.y); vd[1] = make_uint2(vr1.z, vr1.w); }
        if (tid < 64) ((float*)(smem + OFF_B))[tid] = br;
        __syncthreads();
        for (int t = 0; t < ntiles; ++t) {
            const int cur = t & 1;
            if (t + 1 < ntiles) {
                const int k0 = (t + 1) * 64;
                kr0 = *(const uint4*)(kg + (size_t)(k0 + (idA >> 4)) * 128 + (idA & 15) * 8); kr1 = *(const uint4*)(kg + (size_t)(k0 + (idB >> 4)) * 128 + (idB & 15) * 8);
                vr0 = *(const uint4*)(vg + (size_t)(idA >> 3) * S_ + k0 + (idA & 7) * 8); vr1 = *(const uint4*)(vg + (size_t)(idB >> 3) * S_ + k0 + (idB & 7) * 8);
                if (tid < 64) br = p.cum[(size_t)(b * S_ + k0 + tid) * 4 + hd] * NEG_INV_SCALE;
            }
            const int kbase = t * 64;
            if (kbase <= q0) {
                const unsigned char* Kt = smem + cur * KB; const unsigned char* Vt = smem + OFF_V + cur * VB; const float* Bt = (const float*)(smem + OFF_B + cur * 256);
                const bool two = (kbase + 32 <= q0);
                fx_f32x16 sA, sB;
#pragma unroll
                for (int g = 0; g < 4; ++g) { const fx_f32x4 bv = *(const fx_f32x4*)(Bt + 8 * g + 4 * h5);
                    sA[4 * g] = bv[0]; sA[4 * g + 1] = bv[1]; sA[4 * g + 2] = bv[2]; sA[4 * g + 3] = bv[3]; }
#pragma unroll
                for (int s = 0; s < 8; ++s) { const fx_bf16x8 ka = *(const fx_bf16x8*)(Kt + c * 256 + (((2 * s + h5) ^ (c & 15)) << 4));
                    sA = __builtin_amdgcn_mfma_f32_32x32x16_bf16(ka, qf[s], sA, 0, 0, 0); }
                if (two) {
#pragma unroll
                    for (int g = 0; g < 4; ++g) { const fx_f32x4 bv = *(const fx_f32x4*)(Bt + 32 + 8 * g + 4 * h5);
                        sB[4 * g] = bv[0]; sB[4 * g + 1] = bv[1]; sB[4 * g + 2] = bv[2]; sB[4 * g + 3] = bv[3]; }
#pragma unroll
                    for (int s = 0; s < 8; ++s) { const fx_bf16x8 ka = *(const fx_bf16x8*)(Kt + (32 + c) * 256 + (((2 * s + h5) ^ (c & 15)) << 4));
                        sB = __builtin_amdgcn_mfma_f32_32x32x16_bf16(ka, qf[s], sB, 0, 0, 0); }
                } else {
#pragma unroll
                    for (int r = 0; r < 16; ++r) sB[r] = -__builtin_inff();
                }
                if (kbase + 31 > q0) { const int d0 = kbase - q0 + 4 * h5 - c;
#pragma unroll
                    for (int r = 0; r < 16; ++r) if (d0 + (r & 3) + 8 * (r >> 2) > 0) sA[r] = -__builtin_inff(); }
                if (two && kbase + 63 > q0) { const int d0 = kbase + 32 - q0 + 4 * h5 - c;
#pragma unroll
                    for (int r = 0; r < 16; ++r) if (d0 + (r & 3) + 8 * (r >> 2) > 0) sB[r] = -__builtin_inff(); }
                float mx = sA[0];
#pragma unroll
                for (int r = 1; r < 16; ++r) mx = fmaxf(mx, sA[r]);
#pragma unroll
                for (int r = 0; r < 16; ++r) mx = fmaxf(mx, sB[r]);
                { auto rr = __builtin_amdgcn_permlane32_swap(__float_as_uint(mx), __float_as_uint(mx), false, false); mx = fmaxf(__uint_as_float(rr[0]), __uint_as_float(rr[1])); }
                const float mc = fmaf(mx, C2, ct2);
                if (!__all(mc - m <= 8.f)) {
                    const float mn = fmaxf(m, mc); const float alpha = __builtin_amdgcn_exp2f(m - mn); m = mn; l *= alpha;
#pragma unroll
                    for (int mb = 0; mb < 4; ++mb)
#pragma unroll
                        for (int r = 0; r < 16; ++r) o[mb][r] *= alpha;
                }
                const float dm = ct2 - m;
                float ps = 0.f;
#pragma unroll
                for (int r = 0; r < 16; ++r) { sA[r] = __builtin_amdgcn_exp2f(fmaf(sA[r], C2, dm)); ps += sA[r]; }
#pragma unroll
                for (int r = 0; r < 16; ++r) { sB[r] = __builtin_amdgcn_exp2f(fmaf(sB[r], C2, dm)); ps += sB[r]; }
                l += ps;
#pragma unroll
                for (int s2 = 0; s2 < 2; ++s2) {
                    union { fx_bf16x8 v; unsigned u[4]; } pb;
#pragma unroll
                    for (int j = 0; j < 4; ++j) pb.u[j] = fx_pk(sA[8 * s2 + 2 * j], sA[8 * s2 + 2 * j + 1]);
#pragma unroll
                    for (int mb = 0; mb < 4; ++mb) { const unsigned char* vp = Vt + (mb * 32 + c) * 136 + (16 * s2 + 4 * h5) * 2;
                        union { fx_bf16x8 v; uint2 q[2]; } va; va.q[0] = *(const uint2*)vp; va.q[1] = *(const uint2*)(vp + 16);
                        o[mb] = __builtin_amdgcn_mfma_f32_32x32x16_bf16(va.v, pb.v, o[mb], 0, 0, 0); }
                }
                if (two) {
#pragma unroll
                    for (int s2 = 0; s2 < 2; ++s2) {
                        union { fx_bf16x8 v; unsigned u[4]; } pb;
#pragma unroll
                        for (int j = 0; j < 4; ++j) pb.u[j] = fx_pk(sB[8 * s2 + 2 * j], sB[8 * s2 + 2 * j + 1]);
#pragma unroll
                        for (int mb = 0; mb < 4; ++mb) { const unsigned char* vp = Vt + (mb * 32 + c) * 136 + (32 + 16 * s2 + 4 * h5) * 2;
                            union { fx_bf16x8 v; uint2 q[2]; } va; va.q[0] = *(const uint2*)vp; va.q[1] = *(const uint2*)(vp + 16);
                            o[mb] = __builtin_amdgcn_mfma_f32_32x32x16_bf16(va.v, pb.v, o[mb], 0, 0, 0); }
                    }
                }
            }
            if (t + 1 < ntiles) {
                const int nb = cur ^ 1; const int rA = idA >> 4, chA = idA & 15, rB = idB >> 4, chB = idB & 15;
                *(uint4*)(smem + nb * KB + rA * 256 + ((chA ^ (rA & 15)) << 4)) = kr0; *(uint4*)(smem + nb * KB + rB * 256 + ((chB ^ (rB & 15)) << 4)) = kr1;
                uint2* vd = (uint2*)(smem + OFF_V + nb * VB + (idA >> 3) * 136 + (idA & 7) * 16); vd[0] = make_uint2(vr0.x, vr0.y); vd[1] = make_uint2(vr0.z, vr0.w);
                vd = (uint2*)(smem + OFF_V + nb * VB + (idB >> 3) * 136 + (idB & 7) * 16); vd[0] = make_uint2(vr1.x, vr1.y); vd[1] = make_uint2(vr1.z, vr1.w);
                if (tid < 64) ((float*)(smem + OFF_B + nb * 256))[tid] = br;
            }
            __syncthreads();
        }
        { auto rr = __builtin_amdgcn_permlane32_swap(__float_as_uint(l), __float_as_uint(l), false, false); l = __uint_as_float(rr[0]) + __uint_as_float(rr[1]); }
        const float inv = 1.f / l;
        bf16_t* op = omix + (size_t)(b * S_ + q0 + c) * 1024 + 512 + hd * 128 + 4 * h5;
#pragma unroll
        for (int mb = 0; mb < 4; ++mb)
#pragma unroll
            for (int g = 0; g < 4; ++g) { uint2 ov; ov.x = fx_pk(o[mb][4 * g] * inv, o[mb][4 * g + 1] * inv); ov.y = fx_pk(o[mb][4 * g + 2] * inv, o[mb][4 * g + 3] * inv);
                *(uint2*)(op + mb * 32 + 8 * g) = ov; }
    }
}

__device__ __forceinline__ void ph_route(const int WV, CParams& p, const bf16_t* __restrict__ x, const float* __restrict__ g, const float* __restrict__ sc, const float* __restrict__ sh, bf16_t* __restrict__ h2, unsigned char* smem) {
    const int tix_ = otid(WV);
    const int lane = tix_ & 63, w = tix_ >> 6, c = lane & 15, g4 = lane >> 4;
    constexpr int RP = 1032;
    bf16_t* Rhi = (bf16_t*)smem;
    bf16_t* Rlo = Rhi + 16 * RP;
    float* mv = (float*)(smem + 2 * 16 * RP * 2);
    float* sv = mv + 1024;
    float* lgs = sv + 1024;
    int* selE = (int*)(lgs + 128 * 16);
    float* selW = (float*)(selE + 128);
    int* lcnt = (int*)(selW + 256);
    int* lbase = lcnt + 16;
    __syncthreads();
    for (int i = tix_; i < 16384; i += NT) { const int k = i >> 4, e = i & 15; const float r = p.router_w[i]; const bf16_t hi = f2bf(r); Rhi[e * RP + k] = hi; Rlo[e * RP + k] = f2bf(r - bf2f(hi)); }
    for (int chunk = blockIdx.x; chunk < T_ / 128; chunk += gridDim.x) {
        const int b = (chunk * 128) >> 11;
        __syncthreads();
        for (int k = tix_; k < 1024; k += NT) { mv[k] = g[k] * (1.f + sc[b * 6144 + k]); sv[k] = sh[b * 6144 + k]; }
        if (tix_ < 16) lcnt[tix_] = 0;
        __syncthreads();
        const int t = chunk * 128 + w * 16 + c;
        const bf16_t* xr = x + (size_t)t * 1024 + 8 * g4;
        float ss = 0.f;
#pragma unroll 8
        for (int s = 0; s < 32; ++s) { const uint4 xw = *(const uint4*)(xr + 32 * s); const unsigned u[4] = {xw.x, xw.y, xw.z, xw.w};
#pragma unroll
            for (int q = 0; q < 4; ++q) { const float a = __uint_as_float(u[q] << 16), bq = __uint_as_float(u[q] & 0xffff0000u); ss += a * a + bq * bq; } }
        { auto r = __builtin_amdgcn_permlane16_swap(__float_as_uint(ss), __float_as_uint(ss), false, false); ss = __uint_as_float(r[0]) + __uint_as_float(r[1]); }
        { auto r = __builtin_amdgcn_permlane32_swap(__float_as_uint(ss), __float_as_uint(ss), false, false); ss = __uint_as_float(r[0]) + __uint_as_float(r[1]); }
        const float rstd = rsqrtf(ss * (1.f / 1024.f) + 1e-6f);
        dn_f32x4 acc = {0.f, 0.f, 0.f, 0.f};
#pragma unroll 4
        for (int s = 0; s < 32; ++s) {
            const int k0 = 32 * s + 8 * g4;
            const uint4 xw = *(const uint4*)(xr + 32 * s); const unsigned u[4] = {xw.x, xw.y, xw.z, xw.w};
            const float4 m0 = *(const float4*)(mv + k0), m1 = *(const float4*)(mv + k0 + 4), s0 = *(const float4*)(sv + k0), s1 = *(const float4*)(sv + k0 + 4);
            float hv[8];
            hv[0] = __uint_as_float(u[0] << 16) * rstd * m0.x + s0.x; hv[1] = __uint_as_float(u[0] & 0xffff0000u) * rstd * m0.y + s0.y;
            hv[2] = __uint_as_float(u[1] << 16) * rstd * m0.z + s0.z; hv[3] = __uint_as_float(u[1] & 0xffff0000u) * rstd * m0.w + s0.w;
            hv[4] = __uint_as_float(u[2] << 16) * rstd * m1.x + s1.x; hv[5] = __uint_as_float(u[2] & 0xffff0000u) * rstd * m1.y + s1.y;
            hv[6] = __uint_as_float(u[3] << 16) * rstd * m1.z + s1.z; hv[7] = __uint_as_float(u[3] & 0xffff0000u) * rstd * m1.w + s1.w;
            union { dn_bf16x8 v; unsigned q[4]; uint4 w4; } ahi, alo;
#pragma unroll
            for (int q = 0; q < 4; ++q) { ahi.q[q] = pk_bf16(hv[2 * q], hv[2 * q + 1]);
                alo.q[q] = pk_bf16(hv[2 * q] - __uint_as_float(ahi.q[q] << 16), hv[2 * q + 1] - __uint_as_float(ahi.q[q] & 0xffff0000u)); }
            *(uint4*)(h2 + (size_t)t * 1024 + k0) = ahi.w4;
            const dn_bf16x8 bhi = *(const dn_bf16x8*)(Rhi + c * RP + k0), blo = *(const dn_bf16x8*)(Rlo + c * RP + k0);
            acc = dn_mfma(ahi.v, bhi, acc); acc = dn_mfma(ahi.v, blo, acc); acc = dn_mfma(alo.v, bhi, acc);
        }
#pragma unroll
        for (int r = 0; r < 4; ++r) lgs[(w * 16 + 4 * g4 + r) * 16 + c] = acc[r];
        asm volatile("s_waitcnt lgkmcnt(0)" ::: "memory");
        if (lane < 16) {
            const int kt = lane; float lgv[16];
#pragma unroll
            for (int q = 0; q < 4; ++q) { const float4 v = *(const float4*)(lgs + (w * 16 + kt) * 16 + 4 * q); lgv[4 * q] = v.x; lgv[4 * q + 1] = v.y; lgv[4 * q + 2] = v.z; lgv[4 * q + 3] = v.w; }
            float mx = lgv[0];
#pragma unroll
            for (int e = 1; e < 16; ++e) mx = fmaxf(mx, lgv[e]);
            float pr[16]; float den = 0.f;
#pragma unroll
            for (int e = 0; e < 16; ++e) { pr[e] = __expf(lgv[e] - mx); den += pr[e]; }
            const float inv = 1.f / den;
            float sel[16];
#pragma unroll
            for (int e = 0; e < 16; ++e) { pr[e] *= inv; sel[e] = pr[e] + p.router_b[e]; }
            int bg = 0; float bgs = -1e30f;
#pragma unroll
            for (int gi = 0; gi < 4; ++gi) { float m1 = -1e30f, m2 = -1e30f;
#pragma unroll
                for (int q = 0; q < 4; ++q) { const float sv2 = sel[gi * 4 + q]; if (sv2 > m1) { m2 = m1; m1 = sv2; } else if (sv2 > m2) m2 = sv2; }
                const float gs = m1 + m2; if (gs > bgs) { bgs = gs; bg = gi; } }
            int e1 = 0, e2 = 0; float s1 = -1e30f, s2 = -1e30f, p1 = 0.f, p2 = 0.f;
#pragma unroll
            for (int gi = 0; gi < 4; ++gi) if (gi == bg) {
#pragma unroll
                for (int q = 0; q < 4; ++q) { const float sv2 = sel[gi * 4 + q], pv = pr[gi * 4 + q];
                    if (sv2 > s1) { s2 = s1; e2 = e1; p2 = p1; s1 = sv2; e1 = gi * 4 + q; p1 = pv; } else if (sv2 > s2) { s2 = sv2; e2 = gi * 4 + q; p2 = pv; } } }
            const float wn = 1.f / (p1 + p2);
            selE[w * 16 + kt] = e1 | (e2 << 8); selW[2 * (w * 16 + kt)] = p1 * wn; selW[2 * (w * 16 + kt) + 1] = p2 * wn;
        }
        __syncthreads();
        int myE = 0, myR = 0;
        if (tix_ < 256) { const int ee = selE[tix_ >> 1]; myE = (tix_ & 1) ? (ee >> 8) : (ee & 255); myR = atomicAdd(&lcnt[myE], 1); }
        __syncthreads();
        if (tix_ < 16) lbase[tix_] = atomicAdd(&p.cnt[tix_], lcnt[tix_]);
        __syncthreads();
        if (tix_ < 256) { const int pair = chunk * 256 + tix_; p.list[myE * T_ + lbase[myE] + myR] = pair; p.gw[pair] = selW[tix_]; }
    }
    __syncthreads();
}

__device__ __forceinline__ void ph_lru(const int WV, CParams& p, const bf16_t* __restrict__ proj2, bf16_t* __restrict__ omix, unsigned char* smem) {
    const int tid = otid(WV), lane = tid & 63, w = tid >> 6, c = lane & 15, g4 = lane >> 4;
    bf16_t* xcs = (bf16_t*)smem;
    float* As = (float*)(smem + 34816);
    float* Bs = As + 128 * 33;
    float* segA = Bs + 128 * 33;
    float* segB = segA + 512;
    float* cin = segB + 512;
    for (int item = blockIdx.x; item < 256; item += gridDim.x) {
        const int b = item >> 4, hb = (item >> 2) & 3, q = item & 3;
        dn_bf16x8 wrf[2][4], wif[2][4];
#pragma unroll
        for (int nb = 0; nb < 2; ++nb)
#pragma unroll
            for (int ks = 0; ks < 4; ++ks) { const size_t o = ((size_t)hb * 128 + q * 32 + 16 * nb + c) * 128 + 32 * ks + 8 * g4;
                wrf[nb][ks] = *(const dn_bf16x8*)(p.W_lr + o); wif[nb][ks] = *(const dn_bf16x8*)(p.W_li + o); }
        float brj[2], bij[2], spn[2];
#pragma unroll
        for (int nb = 0; nb < 2; ++nb) { const int ch = hb * 128 + q * 32 + 16 * nb + c; brj[nb] = p.od_br[ch]; bij[nb] = p.od_bi[ch]; spn[nb] = -8.f * softplusf_(-p.od_lam[ch]); }
        const int cp = tid & 63, rg = tid >> 6, cch = hb * 128 + cp * 2;
        const float wa0 = p.od_conv_w[cch], wa1 = p.od_conv_w[512 + cch], wa2 = p.od_conv_w[1024 + cch], wa3 = p.od_conv_w[1536 + cch], ba = p.od_conv_b[cch];
        const float wb0 = p.od_conv_w[cch + 1], wb1 = p.od_conv_w[512 + cch + 1], wb2 = p.od_conv_w[1024 + cch + 1], wb3 = p.od_conv_w[1536 + cch + 1], bb2 = p.od_conv_b[cch + 1];
        float h_in = 0.f;
        unsigned raw[19];
        { const bf16_t* src = proj2 + (size_t)(b * S_ + rg * 16) * 2048 + cch;
#pragma unroll
          for (int r = 0; r < 19; ++r) raw[r] = (rg == 0 && r < 3) ? 0u : *(const unsigned*)(src + (ptrdiff_t)(r - 3) * 2048); }
        for (int ti = 0; ti < 16; ++ti) {
            const int t0 = b * S_ + ti * 128;
            {
                float a0 = __uint_as_float(raw[0] << 16), b0 = __uint_as_float(raw[0] & 0xffff0000u), a1 = __uint_as_float(raw[1] << 16), b1 = __uint_as_float(raw[1] & 0xffff0000u), a2 = __uint_as_float(raw[2] << 16), b2 = __uint_as_float(raw[2] & 0xffff0000u);
                if (ti == 0 && rg == 0) { a0 = a1 = a2 = b0 = b1 = b2 = 0.f; }
#pragma unroll
                for (int r = 0; r < 16; ++r) { const unsigned pv = raw[3 + r];
                    const float a3 = __uint_as_float(pv << 16), b3 = __uint_as_float(pv & 0xffff0000u);
                    *(unsigned*)(xcs + (rg * 16 + r) * 136 + cp * 2) = pk_bf16(ba + wa0 * a0 + wa1 * a1 + wa2 * a2 + wa3 * a3, bb2 + wb0 * b0 + wb1 * b1 + wb2 * b2 + wb3 * b3);
                    a0 = a1; a1 = a2; a2 = a3; b0 = b1; b1 = b2; b2 = b3; }
                if (ti + 1 < 16) { const bf16_t* src = proj2 + (size_t)(t0 + 128 + rg * 16) * 2048 + cch;
#pragma unroll
                    for (int r = 0; r < 19; ++r) raw[r] = *(const unsigned*)(src + (ptrdiff_t)(r - 3) * 2048); }
            }
            __syncthreads();
            {
                dn_bf16x8 af[4];
#pragma unroll
                for (int ks = 0; ks < 4; ++ks) af[ks] = *(const dn_bf16x8*)(xcs + (16 * w + c) * 136 + 32 * ks + 8 * g4);
#pragma unroll
                for (int nb = 0; nb < 2; ++nb) { dn_f32x4 ar = {0.f, 0.f, 0.f, 0.f}, ai = {0.f, 0.f, 0.f, 0.f};
#pragma unroll
                    for (int ks = 0; ks < 4; ++ks) { ar = dn_mfma(af[ks], wrf[nb][ks], ar); ai = dn_mfma(af[ks], wif[nb][ks], ai); }
#pragma unroll
                    for (int r = 0; r < 4; ++r) { const int t = 16 * w + 4 * g4 + r, jl = 16 * nb + c;
                        const float rr = sigm(ar[r] + brj[nb]), ig = sigm(ai[r] + bij[nb]);
                        const float log_a = spn[nb] * rr, av = __expf(log_a), x = bf2f(xcs[t * 136 + q * 32 + jl]);
                        As[t * 33 + jl] = av; Bs[t * 33 + jl] = sqrtf(fmaxf(0.f, (1.f - av) * (1.f + av))) * ig * x; } }
            }
            __syncthreads();
            const int j = tid & 31, seg = tid >> 5;
            { float A = 1.f, Bc = 0.f;
#pragma unroll
                for (int k = 0; k < 8; ++k) { const float av = As[(8 * seg + k) * 33 + j], bv = Bs[(8 * seg + k) * 33 + j]; A = av * A; Bc = av * Bc + bv; }
                segA[seg * 32 + j] = A; segB[seg * 32 + j] = Bc; }
            __syncthreads();
            if (tid < 32) { float sa[16], sb[16];
#pragma unroll
                for (int sg = 0; sg < 16; ++sg) { sa[sg] = segA[sg * 32 + tid]; sb[sg] = segB[sg * 32 + tid]; }
                float h = h_in;
#pragma unroll
                for (int sg = 0; sg < 16; ++sg) { cin[sg * 32 + tid] = h; h = sa[sg] * h + sb[sg]; }
                h_in = h; }
            __syncthreads();
            { float h = cin[seg * 32 + j]; const int cg = hb * 128 + q * 32 + j;
#pragma unroll
                for (int k = 0; k < 8; ++k) { const int t = 8 * seg + k; h = As[t * 33 + j] * h + Bs[t * 33 + j];
                    omix[(size_t)(t0 + t) * 1024 + cg] = f2bf(h * bf2f(proj2[(size_t)(t0 + t) * 2048 + 512 + cg])); } }
        }
        __syncthreads();
    }
}
typedef unsigned short sg_u16x4 __attribute__((ext_vector_type(4)));
__device__ __forceinline__ unsigned sgu_off(unsigned row, unsigned ch) { return 256u * row + 16u * (ch ^ (((row & 3u) << 2) | ((row >> 2) & 3u))); }
__device__ __forceinline__ void ph_sgu(const int WV, CParams& p, const bf16_t* __restrict__ proj2, bf16_t* __restrict__ omix, unsigned char* smem) {
    const int tid = otid(WV), lane = tid & 63, w = tid >> 6, c = lane & 15, g4 = lane >> 4;
    float* rstd = (float*)(smem + 32768);
    const unsigned ldsb = (unsigned)(size_t)(PG8_LAS unsigned char*)smem;
    const unsigned q4 = (unsigned)(lane & 15) >> 2, p4 = (unsigned)lane & 3u;
    for (int item = blockIdx.x; item < 256; item += gridDim.x) {
        const int t0 = item * 128;
        __syncthreads();
#pragma unroll 4
        for (int rr = 0; rr < 16; ++rr) { const int sI = 16 * w + rr; const uint4 v = *(const uint4*)(proj2 + (size_t)(t0 + sI) * 2048 + 1536 + lane * 8);
            const unsigned u[4] = {v.x, v.y, v.z, v.w}; float ss = 0.f;
#pragma unroll
            for (int k = 0; k < 4; ++k) { const float x0 = __uint_as_float(u[k] << 16), x1 = __uint_as_float(u[k] & 0xffff0000u); ss += x0 * x0 + x1 * x1; }
            ss = wave_sum(ss);
            if (lane == 0) rstd[sI] = rsqrtf(ss * (1.f / 512.f) + 1e-6f); }
        __syncthreads();
        for (int g = 0; g < 4; ++g) {
#pragma unroll
            for (int i = 0; i < 4; ++i) { const int id = tid + i * NT, sI = id >> 4, c16 = id & 15;
                const uint4 v = *(const uint4*)(proj2 + (size_t)(t0 + sI) * 2048 + 1536 + g * 128 + c16 * 8);
                const float rs = rstd[sI]; const float4 g0 = *(const float4*)(p.od_sgu_g + g * 128 + c16 * 8), g1 = *(const float4*)(p.od_sgu_g + g * 128 + c16 * 8 + 4);
                uint4 o;
                o.x = pk_bf16(__uint_as_float(v.x << 16) * rs * g0.x, __uint_as_float(v.x & 0xffff0000u) * rs * g0.y); o.y = pk_bf16(__uint_as_float(v.y << 16) * rs * g0.z, __uint_as_float(v.y & 0xffff0000u) * rs * g0.w);
                o.z = pk_bf16(__uint_as_float(v.z << 16) * rs * g1.x, __uint_as_float(v.z & 0xffff0000u) * rs * g1.y); o.w = pk_bf16(__uint_as_float(v.w << 16) * rs * g1.z, __uint_as_float(v.w & 0xffff0000u) * rs * g1.w);
                *(uint4*)(smem + sgu_off((unsigned)sI, (unsigned)c16)) = o; }
            __syncthreads();
            {
                const int nks = (16 * w + 15) / 32 + 1, t = 16 * w + c;
                dn_bf16x8 wf[4];
#pragma unroll
                for (int ks = 0; ks < 4; ++ks) wf[ks] = *(const dn_bf16x8*)(p.W_sgu + ((size_t)(g * 128 + t)) * 128 + 32 * ks + 8 * g4);
                const float bias = p.od_sgu_b[g * 128 + t];
#pragma unroll
                for (int db = 0; db < 8; ++db) {
                    union { dn_bf16x8 v; sg_u16x4 h[2]; } va[4];
                    {
                        unsigned ad[8];
#pragma unroll
                        for (int ks = 0; ks < 4; ++ks)
#pragma unroll
                            for (int tt = 0; tt < 2; ++tt) ad[2 * ks + tt] = ldsb + sgu_off(32u * ks + 8u * (unsigned)g4 + 4u * tt + q4, 2u * db + (p4 >> 1)) + 8u * (p4 & 1u);
                        asm volatile("ds_read_b64_tr_b16 %0, %8\n\tds_read_b64_tr_b16 %1, %9\n\tds_read_b64_tr_b16 %2, %10\n\tds_read_b64_tr_b16 %3, %11\n\t"
                                     "ds_read_b64_tr_b16 %4, %12\n\tds_read_b64_tr_b16 %5, %13\n\tds_read_b64_tr_b16 %6, %14\n\tds_read_b64_tr_b16 %7, %15\n\ts_waitcnt lgkmcnt(0)"
                                     : "=&v"(va[0].h[0]), "=&v"(va[0].h[1]), "=&v"(va[1].h[0]), "=&v"(va[1].h[1]), "=&v"(va[2].h[0]), "=&v"(va[2].h[1]), "=&v"(va[3].h[0]), "=&v"(va[3].h[1])
                                     : "v"(ad[0]), "v"(ad[1]), "v"(ad[2]), "v"(ad[3]), "v"(ad[4]), "v"(ad[5]), "v"(ad[6]), "v"(ad[7]) : "memory");
                    }
                    dn_f32x4 acc = {0.f, 0.f, 0.f, 0.f};
#pragma unroll
                    for (int ks = 0; ks < 4; ++ks) if (ks < nks) acc = dn_mfma(va[ks].v, wf[ks], acc);
                    const size_t go = (size_t)(t0 + t);
                    const uint2 uu = *(const uint2*)(proj2 + go * 2048 + 1024 + g * 128 + 16 * db + 4 * g4);
                    uint2 o; o.x = pk_bf16(__uint_as_float(uu.x << 16) * (acc[0] + bias), __uint_as_float(uu.x & 0xffff0000u) * (acc[1] + bias));
                    o.y = pk_bf16(__uint_as_float(uu.y << 16) * (acc[2] + bias), __uint_as_float(uu.y & 0xffff0000u) * (acc[3] + bias));
                    *(uint2*)(omix + go * 1024 + 512 + g * 128 + 16 * db + 4 * g4) = o; }
            }
            __syncthreads();
        }
    }
}

namespace pg8 {
typedef short bf16x8 __attribute__((ext_vector_type(8)));
typedef float f32x4 __attribute__((ext_vector_type(4)));
typedef unsigned u32x4 __attribute__((ext_vector_type(4)));
typedef unsigned u32x2 __attribute__((ext_vector_type(2)));
constexpr int BM = 256, BK = 64, HALF = 128, HTB = HALF * BK * 2, STAGE_BYTES = 8 * HTB, NXCD = 8, WGM = 8;
__device__ __forceinline__ int lds_byte(int r, int c) { const int st = (r >> 4) * 2 + (c >> 5), rr = r & 15, cc = c & 31, ob = rr * 64 + cc * 2; return st * 1024 + (ob ^ (((ob >> 9) & 1) << 5)); }
__device__ __forceinline__ void stage_rc(int b, int& R, int& C) { const int st = b / 1024, sb = b % 1024, swz = sb ^ (((sb >> 9) & 1) << 5); R = (st >> 1) * 16 + swz / 64; C = (st & 1) * 32 + (swz % 64) / 2; }
__device__ __forceinline__ int perm32(int rho) { const int n = rho >> 4, i = rho & 15; return 8 * (i >> 2) + 4 * n + (i & 3); }
struct Unit { int pm, pn, e, nvalid; };
struct Gemm { const bf16_t* A; const bf16_t* Bt; size_t wstride; int K; int pad_; };

struct StaticOrder {
    static constexpr bool GATHER = false; static constexpr int SHIFT = 0;
    int nM, nN, nwg, G, c;
    __device__ __forceinline__ int rowid(const Unit&, int) const { return 0; }
    __device__ void init(int M, int N, int G_, int c_) { nM = M / BM; nN = N / BM; nwg = nM * nN; G = G_; c = c_; }
    __device__ bool next(int i, Unit& u) const {
        const long L = (long)i * G + c; if (L >= nwg) return false;
        int wgid = (int)L; { const int q = nwg / NXCD, r = nwg % NXCD, xcd = wgid % NXCD, off = wgid / NXCD; wgid = (xcd < r ? xcd * (q + 1) : r * (q + 1) + (xcd - r) * q) + off; }
        const int nig = WGM * nN, gid = wgid / nig, fm = gid * WGM, gsz = (nM - fm) < WGM ? (nM - fm) : WGM;
        u.pm = fm + ((wgid % nig) % gsz); u.pn = (wgid % nig) / gsz; u.e = 0; u.nvalid = 256; return true;
    }
};
template <int NN, int SHIFT_>
struct MoeOrder {
    static constexpr bool GATHER = true; static constexpr int SHIFT = SHIFT_;
    const int* cnt; const int* list; int G, c; int cntv;
    __device__ __forceinline__ int rowid(const Unit& u, int r) const { return list[u.e * T_ + u.pm * 256 + min(r, u.nvalid - 1)]; }
    __device__ bool next(int i, Unit& u) const {
        const int L = i * G + c; int rt = L / NN; u.pn = L % NN;
        int e = 0, cc = 0;
        for (; e < 16; ++e) { cc = __builtin_amdgcn_readlane(cntv, e); const int ntile = (cc + 255) >> 8; if (rt < ntile) break; rt -= ntile; }
        if (e == 16) return false;
        u.e = e; u.pm = rt; u.nvalid = min(256, cc - rt * 256); return true;
    }
};
__device__ __forceinline__ unsigned cvt_pk_bf16(float lo, float hi) { return pk_bf16(lo, hi); }

template <int KC, class Epi, class Sched>
__device__ __forceinline__ void gemm_phase(const int WV, PG8_LAS unsigned char* lds, const Gemm g, const Sched& S, const Epi& E) {
    const int tid = otid(WV), wid = __builtin_amdgcn_readfirstlane(tid >> 6), lane = tid & 63, wr = wid >> 2, wc = wid & 3, fr = lane & 15, fq = lane >> 4;
    constexpr int K = KC, nt = K / BK;
    unsigned voffB[2];
#pragma unroll
    for (int i = 0; i < 2; ++i) { int R, C; stage_rc(tid * 16 + i * 8192, R, C); const int Rb = Epi::PERM ? ((R & ~31) + perm32(R & 31)) : R; voffB[i] = (unsigned)(Rb * K + C) * 2u; }
    constexpr unsigned kstep = BK * 2, hstep = HALF * K * 2, tstep = 2 * hstep;
    const __amdgpu_buffer_rsrc_t rsA = __builtin_amdgcn_make_buffer_rsrc((void*)g.A, 0, 0x7fffffff, 0x00020000);
    const __amdgpu_buffer_rsrc_t rsB = __builtin_amdgcn_make_buffer_rsrc((void*)g.Bt, 0, 0x7fffffff, 0x00020000);
    const unsigned ldsw = (unsigned)wid * 1024u;
    const int aoff = lds_byte(wr * 64 + fr, fq * 8), boff = lds_byte(wc * 32 + fr, fq * 8);
#define PG8_SA(b, h) (((b) * 2 + (h)) * HTB)
#define PG8_SB(b, h) ((4 + (b) * 2 + (h)) * HTB)
#define PG8_STAGE(bufoff, rsrc, soff, voff) do { _Pragma("unroll") for (int _i = 0; _i < 2; ++_i) \
        __builtin_amdgcn_raw_ptr_buffer_load_lds(rsrc, (PG8_LAS unsigned*)(lds + (bufoff) + ldsw + _i * 8192), 16, (voff)[_i], (soff), 0, 0); } while (0)
#define PG8_LDA(dst, b, h) do { _Pragma("unroll") for (int m = 0; m < 4; ++m) _Pragma("unroll") for (int k = 0; k < 2; ++k) dst[m][k] = *(const PG8_LAS bf16x8*)(lds + PG8_SA(b, h) + aoff + m * 2048 + k * 1024); } while (0)
#define PG8_LDB(dst, b, h) do { _Pragma("unroll") for (int n = 0; n < 2; ++n) _Pragma("unroll") for (int k = 0; k < 2; ++k) dst[n][k] = *(const PG8_LAS bf16x8*)(lds + PG8_SB(b, h) + boff + n * 2048 + k * 1024); } while (0)
#define PG8_MMA(ai, bj, At, Bt) do { __builtin_amdgcn_s_setprio(1); _Pragma("unroll") for (int m = 0; m < 4; ++m) _Pragma("unroll") for (int n = 0; n < 2; ++n) _Pragma("unroll") for (int k = 0; k < 2; ++k) \
        acc[ai][bj][m][n] = __builtin_amdgcn_mfma_f32_16x16x32_bf16(Bt[n][k], At[m][k], acc[ai][bj][m][n], 0, 0, 0); __builtin_amdgcn_s_setprio(0); } while (0)
#define PG8_WAIT_V(n) asm volatile("s_waitcnt vmcnt(" #n ")" ::: "memory")
#define PG8_WAIT_L(n) asm volatile("s_waitcnt lgkmcnt(" #n ")" ::: "memory")
#define PG8_BAR __builtin_amdgcn_s_barrier()
#define PG8_SCHED __builtin_amdgcn_sched_barrier(0)
    Unit cur, nxt; int ui = 0;
    if (!S.next(0, cur)) return;
    f32x4 acc[2][2][4][2];
#pragma unroll
    for (int a = 0; a < 2; ++a)
#pragma unroll
        for (int b = 0; b < 2; ++b)
#pragma unroll
            for (int m = 0; m < 4; ++m)
#pragma unroll
                for (int n = 0; n < 2; ++n) acc[a][b][m][n] = (f32x4){0.f, 0.f, 0.f, 0.f};
    bf16x8 At[4][2], B0[2][2], B1[2][2];
    unsigned vA0[2], vA1[2];
    PG8_LAS int* rows = (PG8_LAS int*)(lds + STAGE_BYTES);
    if constexpr (Sched::GATHER) { if (tid < 256) rows[tid] = S.rowid(cur, tid); __syncthreads(); }
#pragma unroll
    for (int i = 0; i < 2; ++i) { int R, C; stage_rc(tid * 16 + i * 8192, R, C);
        const int r0 = Sched::GATHER ? (rows[R] >> Sched::SHIFT) : cur.pm * BM + R, r1 = Sched::GATHER ? (rows[HALF + R] >> Sched::SHIFT) : cur.pm * BM + HALF + R;
        vA0[i] = ((unsigned)r0 * (unsigned)K + (unsigned)C) * 2u; vA1[i] = ((unsigned)r1 * (unsigned)K + (unsigned)C) * 2u; }
    unsigned cB = (unsigned)cur.e * (unsigned)(g.wstride * 2) + (unsigned)cur.pn * tstep;
    PG8_STAGE(PG8_SB(0, 0), rsB, cB, voffB); PG8_STAGE(PG8_SA(0, 0), rsA, 0u, vA0); PG8_STAGE(PG8_SB(0, 1), rsB, cB + hstep, voffB); PG8_STAGE(PG8_SA(0, 1), rsA, 0u, vA1);
    if (wr == 1) PG8_BAR;
    PG8_WAIT_V(4); PG8_BAR;
    PG8_STAGE(PG8_SB(1, 0), rsB, cB + kstep, voffB); PG8_STAGE(PG8_SA(1, 0), rsA, kstep, vA0); PG8_STAGE(PG8_SB(1, 1), rsB, cB + hstep + kstep, voffB);
    PG8_WAIT_V(6); PG8_BAR;
    for (;;) {
        const bool has_next = S.next(ui + 1, nxt);
        if constexpr (Sched::GATHER) { if (has_next) { const int t3 = otid(WV); if (t3 < 256) rows[((ui + 1) % 3) * 256 + t3] = S.rowid(nxt, t3); } }
        const unsigned nB = has_next ? (unsigned)nxt.e * (unsigned)(g.wstride * 2) + (unsigned)nxt.pn * tstep : cB;
        for (int t = 0; t < nt; t += 2) {
            const bool last = (t == nt - 2);
            const unsigned a1 = (unsigned)(t + 1) * kstep;
            const unsigned a2 = last ? 0u : (unsigned)(t + 2) * kstep, b2 = last ? nB : cB + (unsigned)(t + 2) * kstep;
            const unsigned a3 = a2 + kstep, b3 = b2 + kstep;
            PG8_LDB(B0, 0, 0); PG8_SCHED; PG8_LDA(At, 0, 0); PG8_STAGE(PG8_SA(1, 1), rsA, a1, vA1);
            if (last && has_next) {
                const int t3 = otid(WV); PG8_LAS const int* rn = rows + ((ui + 1) % 3) * 256;
#pragma unroll
                for (int i = 0; i < 2; ++i) { int R, C; stage_rc(t3 * 16 + i * 8192, R, C);
                    const int r0 = Sched::GATHER ? (rn[R] >> Sched::SHIFT) : nxt.pm * BM + R, r1 = Sched::GATHER ? (rn[HALF + R] >> Sched::SHIFT) : nxt.pm * BM + HALF + R;
                    vA0[i] = ((unsigned)r0 * (unsigned)K + (unsigned)C) * 2u; vA1[i] = ((unsigned)r1 * (unsigned)K + (unsigned)C) * 2u; }
            }
            PG8_WAIT_L(8); PG8_BAR; PG8_WAIT_L(0); PG8_MMA(0, 0, At, B0); PG8_BAR; PG8_SCHED;
            PG8_LDB(B1, 0, 1); PG8_STAGE(PG8_SB(0, 0), rsB, b2, voffB);
            PG8_BAR; PG8_WAIT_L(0); PG8_MMA(0, 1, At, B1); PG8_BAR;
            PG8_LDA(At, 0, 1); PG8_STAGE(PG8_SA(0, 0), rsA, a2, vA0);
            PG8_BAR; PG8_WAIT_L(0); PG8_MMA(1, 0, At, B0); PG8_BAR; PG8_SCHED;
            PG8_STAGE(PG8_SB(0, 1), rsB, b2 + hstep, voffB);
            PG8_WAIT_V(6); PG8_BAR; PG8_MMA(1, 1, At, B1); PG8_BAR;
            PG8_LDB(B0, 1, 0); PG8_SCHED; PG8_LDA(At, 1, 0); PG8_STAGE(PG8_SA(0, 1), rsA, a2, vA1);
            PG8_WAIT_L(8); PG8_BAR; PG8_WAIT_L(0); PG8_MMA(0, 0, At, B0); PG8_BAR; PG8_SCHED;
            PG8_LDB(B1, 1, 1); PG8_STAGE(PG8_SB(1, 0), rsB, b3, voffB);
            PG8_BAR; PG8_WAIT_L(0); PG8_MMA(0, 1, At, B1); PG8_BAR;
            PG8_LDA(At, 1, 1); PG8_STAGE(PG8_SA(1, 0), rsA, a3, vA0);
            PG8_BAR; PG8_WAIT_L(0); PG8_MMA(1, 0, At, B0); PG8_BAR; PG8_SCHED;
            PG8_STAGE(PG8_SB(1, 1), rsB, b3 + hstep, voffB);
            PG8_WAIT_V(6); PG8_BAR; PG8_MMA(1, 1, At, B1); PG8_BAR;
        }
        { const int t2 = otid(WV), w2 = __builtin_amdgcn_readfirstlane(t2 >> 6), l2 = t2 & 63; E(acc, cur, w2 >> 2, w2 & 3, l2 & 15, l2 >> 4, rows + (ui % 3) * 256); }
        if (!has_next) break;
#pragma unroll
        for (int a = 0; a < 2; ++a)
#pragma unroll
            for (int b = 0; b < 2; ++b)
#pragma unroll
                for (int m = 0; m < 4; ++m)
#pragma unroll
                    for (int n = 0; n < 2; ++n) acc[a][b][m][n] = (f32x4){0.f, 0.f, 0.f, 0.f};
        cur = nxt; cB = nB; ++ui;
    }
    PG8_WAIT_V(0);
    if (wr == 0) PG8_BAR;
    PG8_BAR;
#undef PG8_SA
#undef PG8_SB
#undef PG8_STAGE
#undef PG8_LDA
#undef PG8_LDB
#undef PG8_MMA
#undef PG8_WAIT_V
#undef PG8_WAIT_L
#undef PG8_BAR
#undef PG8_SCHED
}

struct EpiBf16 {
    static constexpr bool PERM = true;
    bf16_t* O; int ldo, gelu_from;
    __device__ __forceinline__ void operator()(const f32x4 (&acc)[2][2][4][2], const Unit& u, int wr, int wc, int fr, int fq, PG8_LAS const int* rows) const {
        const int row0 = u.pm * BM + wr * 64 + fr, col0 = u.pn * BM + wc * 32 + 8 * fq; const bool gl = u.pn >= gelu_from;
#pragma unroll
        for (int ai = 0; ai < 2; ++ai)
#pragma unroll
            for (int m = 0; m < 4; ++m) { bf16_t* rowp = O + (size_t)(row0 + ai * HALF + m * 16) * ldo + col0;
#pragma unroll
                for (int bj = 0; bj < 2; ++bj) { f32x4 v0 = acc[ai][bj][m][0], v1 = acc[ai][bj][m][1];
                    if (gl) {
#pragma unroll
                        for (int j = 0; j < 4; ++j) { v0[j] = geluf_(v0[j]); v1[j] = geluf_(v1[j]); } }
                    u32x4 w; w.x = cvt_pk_bf16(v0[0], v0[1]); w.y = cvt_pk_bf16(v0[2], v0[3]); w.z = cvt_pk_bf16(v1[0], v1[1]); w.w = cvt_pk_bf16(v1[2], v1[3]);
                    *(u32x4*)(rowp + bj * HALF) = w; } }
    }
};
struct EpiRes {
    static constexpr bool PERM = false;
    const float* xin; float* xout; const float* gt;
    __device__ __forceinline__ void operator()(const f32x4 (&acc)[2][2][4][2], const Unit& u, int wr, int wc, int fr, int fq, PG8_LAS const int* rows) const {
        const int row0 = u.pm * BM + wr * 64 + fr, col0 = u.pn * BM + wc * 32 + 4 * fq;
#pragma unroll
        for (int ai = 0; ai < 2; ++ai)
#pragma unroll
            for (int m = 0; m < 4; ++m) { const int r = row0 + ai * HALF + m * 16; const float* gp = gt + (r >> 11) * 6144 + col0; const size_t off = (size_t)r * 1024 + col0;
#pragma unroll
                for (int bj = 0; bj < 2; ++bj)
#pragma unroll
                    for (int n = 0; n < 2; ++n) { const int cc = bj * HALF + n * 16; const f32x4 xv = *(const f32x4*)(xin + off + cc); const f32x4 gv = *(const f32x4*)(gp + cc);
                        *(f32x4*)(xout + off + cc) = xv + gv * acc[ai][bj][m][n]; }
                if (m & 1) asm volatile("" ::: "memory"); }
    }
};
template <bool XIN16>
struct EpiRes16 {
    static constexpr bool PERM = true;
    const void* xin; bf16_t* xout; const float* gt;
    __device__ __forceinline__ void operator()(const f32x4 (&acc)[2][2][4][2], const Unit& u, int wr, int wc, int fr, int fq, PG8_LAS const int* rows) const {
        const int row0 = u.pm * BM + wr * 64 + fr, col0 = u.pn * BM + wc * 32 + 8 * fq;
        const float* gp = gt + (row0 >> 11) * 6144 + col0;
        f32x4 gv[2][2];
#pragma unroll
        for (int bj = 0; bj < 2; ++bj) { gv[bj][0] = *(const f32x4*)(gp + bj * HALF); gv[bj][1] = *(const f32x4*)(gp + bj * HALF + 4); }
        u32x4 xb[2][2]; f32x4 xf[2][2][2];
#define ER_LOAD(it_) do { const size_t off_ = (size_t)(row0 + ((it_) >> 2) * HALF + ((it_) & 3) * 16) * 1024 + col0; _Pragma("unroll") for (int bj = 0; bj < 2; ++bj) { \
            if (XIN16) xb[(it_) & 1][bj] = *(const u32x4*)((const bf16_t*)xin + off_ + bj * HALF); \
            else { xf[(it_) & 1][bj][0] = *(const f32x4*)((const float*)xin + off_ + bj * HALF); xf[(it_) & 1][bj][1] = *(const f32x4*)((const float*)xin + off_ + bj * HALF + 4); } } } while (0)
        ER_LOAD(0);
#pragma unroll
        for (int it = 0; it < 8; ++it) { const int ai = it >> 2, m = it & 3;
            if (it + 1 < 8) ER_LOAD(it + 1);
            const size_t off = (size_t)(row0 + ai * HALF + m * 16) * 1024 + col0;
#pragma unroll
            for (int bj = 0; bj < 2; ++bj) { const int cc = bj * HALF;
                f32x4 x0, x1;
                if (XIN16) { const u32x4 q = xb[it & 1][bj];
                    x0 = (f32x4){__uint_as_float(q.x << 16), __uint_as_float(q.x & 0xffff0000u), __uint_as_float(q.y << 16), __uint_as_float(q.y & 0xffff0000u)};
                    x1 = (f32x4){__uint_as_float(q.z << 16), __uint_as_float(q.z & 0xffff0000u), __uint_as_float(q.w << 16), __uint_as_float(q.w & 0xffff0000u)}; }
                else { x0 = xf[it & 1][bj][0]; x1 = xf[it & 1][bj][1]; }
                const f32x4 v0 = x0 + gv[bj][0] * acc[ai][bj][m][0], v1 = x1 + gv[bj][1] * acc[ai][bj][m][1];
                u32x4 w; w.x = cvt_pk_bf16(v0[0], v0[1]); w.y = cvt_pk_bf16(v0[2], v0[3]); w.z = cvt_pk_bf16(v1[0], v1[1]); w.w = cvt_pk_bf16(v1[2], v1[3]);
                *(u32x4*)(xout + off + cc) = w; }
            asm volatile("" ::: "memory"); }
#undef ER_LOAD
    }
};
struct EpiG1 {
    static constexpr bool PERM = true;
    bf16_t* act; const int* list; const float* gw;
    __device__ __forceinline__ void operator()(const f32x4 (&acc)[2][2][4][2], const Unit& u, int wr, int wc, int fr, int fq, PG8_LAS const int* rows) const {
        int pv[8]; float wv[8];
#pragma unroll
        for (int it = 0; it < 8; ++it) pv[it] = rows[(it >> 2) * HALF + wr * 64 + (it & 3) * 16 + fr];
#pragma unroll
        for (int it = 0; it < 8; ++it) wv[it] = gw[pv[it]];
#pragma unroll
        for (int it = 0; it < 8; ++it) { const int ai = it >> 2, m = it & 3; const int rr = ai * HALF + wr * 64 + m * 16 + fr;
                if (rr < u.nvalid) { const int p = pv[it]; const float w = wv[it];
#pragma unroll
                    for (int bj = 0; bj < 2; ++bj) { const int c = u.pn * BM + bj * HALF + wc * 32 + 8 * fq; const f32x4 v0 = acc[ai][bj][m][0], v1 = acc[ai][bj][m][1];
                        u32x2 o; o.x = cvt_pk_bf16(siluf(v0[0]) * v0[1] * w, siluf(v0[2]) * v0[3] * w); o.y = cvt_pk_bf16(siluf(v1[0]) * v1[1] * w, siluf(v1[2]) * v1[3] * w);
                        *(u32x2*)(act + (size_t)p * 256 + (c >> 1)) = o; } }
                asm volatile("" ::: "memory"); }
    }
};
struct EpiG2 {
    static constexpr bool PERM = true;
    bf16_t* y; const int* list;
    __device__ __forceinline__ void operator()(const f32x4 (&acc)[2][2][4][2], const Unit& u, int wr, int wc, int fr, int fq, PG8_LAS const int* rows) const {
#pragma unroll
        for (int ai = 0; ai < 2; ++ai)
#pragma unroll
            for (int m = 0; m < 4; ++m) { const int rr = ai * HALF + wr * 64 + m * 16 + fr;
                if (rr < u.nvalid) { const int p = rows[rr];
#pragma unroll
                    for (int bj = 0; bj < 2; ++bj) { const int c = u.pn * BM + bj * HALF + wc * 32 + 8 * fq; const f32x4 v0 = acc[ai][bj][m][0], v1 = acc[ai][bj][m][1];
                        u32x4 w; w.x = cvt_pk_bf16(v0[0], v0[1]); w.y = cvt_pk_bf16(v0[2], v0[3]); w.z = cvt_pk_bf16(v1[0], v1[1]); w.w = cvt_pk_bf16(v1[2], v1[3]);
                        *(u32x4*)(y + (size_t)p * 1024 + c) = w; } }
                asm volatile("" ::: "memory"); }
    }
};
}

__device__ __forceinline__ void run_gemm_dense_bf16(const int WV, PG8_LAS unsigned char* lds, const bf16_t* A, const bf16_t* Bt, int M, int N, int K, bf16_t* O, int ldo, int gelu_from) {
    pg8::Gemm g; g.A = A; g.Bt = Bt; g.wstride = 0; g.K = K; g.pad_ = 0;
    pg8::StaticOrder S; S.init(M, N, gridDim.x, blockIdx.x); pg8::EpiBf16 E{O, ldo, gelu_from}; pg8::gemm_phase<1024>(WV, lds, g, S, E);
}
template <bool XIN16>
__device__ __forceinline__ void run_gemm_dense_res(const int WV, PG8_LAS unsigned char* lds, const bf16_t* A, const bf16_t* Bt, int M, int N, int K, const void* xin, bf16_t* xout, const float* gt) {
    pg8::Gemm g; g.A = A; g.Bt = Bt; g.wstride = 0; g.K = K; g.pad_ = 0;
    pg8::StaticOrder S; S.init(M, N, gridDim.x, blockIdx.x); pg8::EpiRes16<XIN16> E{xin, xout, gt}; pg8::gemm_phase<1024>(WV, lds, g, S, E);
}
__device__ __forceinline__ void run_gemm_g1(const int WV, PG8_LAS unsigned char* lds, CParams& p, const bf16_t* A, const bf16_t* Bt, bf16_t* act) {
    pg8::Gemm g; g.A = A; g.Bt = Bt; g.wstride = (size_t)512 * 1024; g.K = 1024; g.pad_ = 0;
    const int l16 = otid(WV) & 63; pg8::MoeOrder<2, 1> S{p.cnt, p.list, (int)gridDim.x, (int)blockIdx.x, (l16 < 16) ? __hip_atomic_load(p.cnt + l16, __ATOMIC_RELAXED, __HIP_MEMORY_SCOPE_AGENT) : 0}; pg8::EpiG1 E{act, p.list, p.gw}; pg8::gemm_phase<1024>(WV, lds, g, S, E);
}
__device__ __forceinline__ void run_gemm_g2(const int WV, PG8_LAS unsigned char* lds, CParams& p, const bf16_t* A, const bf16_t* Bt, bf16_t* y) {
    pg8::Gemm g; g.A = A; g.Bt = Bt; g.wstride = (size_t)1024 * 256; g.K = 256; g.pad_ = 0;
    const int l16 = otid(WV) & 63; pg8::MoeOrder<4, 0> S{p.cnt, p.list, (int)gridDim.x, (int)blockIdx.x, (l16 < 16) ? __hip_atomic_load(p.cnt + l16, __ATOMIC_RELAXED, __HIP_MEMORY_SCOPE_AGENT) : 0}; pg8::EpiG2 E{y, p.list}; pg8::gemm_phase<256>(WV, lds, g, S, E);
}

__device__ __forceinline__ CParams* kparams() { CParams* q = (CParams*)__builtin_amdgcn_kernarg_segment_ptr(); asm volatile("" : "+s"(q)); return q; }
#define KP (*kparams())

#define XB_TMO      128
#define XB_XCNT(j)  (256  + 64 * (j))
#define XB_XSUB(j)  (1280 + 64 * (j))
#define XB_XGEN(j)  (2304 + 64 * (j))
#define XB_TOP      3328
#define XB_TOPGEN   3392
#define XCD_BAR_WORDS 3456
#define XB_SPIN_CAP (1u << 22)
__device__ __forceinline__ unsigned xb_ld(unsigned* p)              { return __hip_atomic_load(p, __ATOMIC_RELAXED, __HIP_MEMORY_SCOPE_AGENT); }
__device__ __forceinline__ unsigned xb_add(unsigned* p, unsigned v) { return __hip_atomic_fetch_add(p, v, __ATOMIC_RELAXED, __HIP_MEMORY_SCOPE_AGENT); }
__device__ __forceinline__ unsigned xb_xcc_id() { return (unsigned)__builtin_amdgcn_s_getreg((3 << 11) | 20) & 0xFu; }
#define XB_SPIN(cond, bar) do { unsigned _sp = 0; while (cond) { __builtin_amdgcn_s_sleep(1); \
    if ((++_sp & 255u) == 0u) { if (xb_ld(&(bar)[XB_TMO])) break; if (_sp > XB_SPIN_CAP) { atomicAdd(&(bar)[XB_TMO], 1u); break; } } } } while (0)
__device__ __forceinline__ void xcd_barrier_complete(unsigned* bar, unsigned x, unsigned& nloc, unsigned& nx) {
    const unsigned G = gridDim.x;
    unsigned sum, cnt, mine, sp = 0u;
    for (;;) {
        sum = 0u; cnt = 0u; mine = 0u;
#pragma unroll
        for (unsigned j = 0; j < 16; ++j) { const unsigned c = xb_ld(&bar[XB_XCNT(j)]); sum += c; cnt += (c > 0u) ? 1u : 0u; mine = (j == x) ? c : mine; }
        if (sum == G) break;
        __builtin_amdgcn_s_sleep(1);
        if ((++sp & 255u) == 0u) { if (xb_ld(&bar[XB_TMO])) break; if (sp > XB_SPIN_CAP) { atomicAdd(&bar[XB_TMO], 1u); break; } }
    }
    nloc = mine > 0u ? mine : 1u; nx = cnt > 0u ? cnt : 1u;
}
__device__ __forceinline__ void xcd_barrier(const int WV, unsigned* bar, volatile PG8_LAS unsigned* st) {
    asm volatile("s_waitcnt vmcnt(0)" ::: "memory");
    __syncthreads();
    if (otid(WV) == 0) {
        __builtin_amdgcn_s_waitcnt(0);
        const unsigned x = xb_xcc_id();
        unsigned nloc = st[0], nx = st[1];
        if (nloc == 0u) { xcd_barrier_complete(bar, x, nloc, nx); st[0] = nloc; st[1] = nx; }
        const unsigned old = xb_add(&bar[XB_XSUB(x)], 1u);
        const unsigned gen = old / nloc;
        if (old + 1u == (gen + 1u) * nloc) {
            __builtin_amdgcn_fence(__ATOMIC_RELEASE, "agent");
            asm volatile("s_waitcnt vmcnt(0)" ::: "memory");
            const unsigned og = xb_add(&bar[XB_TOP], 1u);
            const unsigned tg = og / nx;
            if (og + 1u == (tg + 1u) * nx) xb_add(&bar[XB_TOPGEN], 1u);
            else XB_SPIN(xb_ld(&bar[XB_TOPGEN]) == tg, bar);
            __builtin_amdgcn_fence(__ATOMIC_ACQUIRE, "agent");
            xb_add(&bar[XB_XGEN(x)], 1u);
            asm volatile("s_waitcnt vmcnt(0)" ::: "memory");
        } else {
            XB_SPIN(xb_ld(&bar[XB_XGEN(x)]) == gen, bar);
            __builtin_amdgcn_fence(__ATOMIC_ACQUIRE, "agent");
            asm volatile("s_waitcnt vmcnt(0)" ::: "memory");
        }
    }
    __syncthreads();
}
__global__ __launch_bounds__(512) void k_mega(Params p_unused) {
    extern __shared__ __attribute__((aligned(16))) unsigned char smem[];
    PG8_LAS unsigned char* lds = (PG8_LAS unsigned char*)smem;
    cg::grid_group grid = cg::this_grid();
    const int WV = __builtin_amdgcn_readfirstlane(threadIdx.x >> 6);
    volatile PG8_LAS unsigned* xb_st = (volatile PG8_LAS unsigned*)(lds + (LDS_BYTES - 16));
    { unsigned* bar0 = KP.bar; if (threadIdx.x == 0) { xb_st[0] = 0u; xb_st[1] = 0u; (void)xb_add(&bar0[XB_XCNT(xb_xcc_id())], 1u); } }
    __syncthreads();
#define GSYNC() xcd_barrier(WV, KP.bar, xb_st)
#define MOD0 (KP.mod)
#define MOD1 (KP.mod + 16 * 6144)
#define PROJB ((bf16_t*)KP.PROJ)
#define ACTB ((bf16_t*)KP.PROJ)
#define YB ((bf16_t*)KP.PROJ + (size_t)2 * T_ * 256)
#define XA16(p_) ((bf16_t*)(p_).PROJ + (size_t)2 * T_ * 256 + (size_t)2 * T_ * 1024)
    ph_tcvt<MapEv>(WV, KP.ev_w_in, 3596, 1024, KP.W_evin, 0, 0, 1, smem);
    ph_tcvt<MapId>(WV, KP.ev_w_out, 1024, 1024, KP.W_evout, 0, 0, 1, smem);
    ph_tcvt<MapId>(WV, KP.od_w_in, 2048, 1024, KP.W_odin, 0, 0, 1, smem);
    ph_tcvt<MapId>(WV, KP.od_w_out, 1024, 1024, KP.W_odout, 0, 0, 1, smem);
    ph_tcvt<MapEven>(WV, KP.moe_wg, 256, 1024, KP.W_moe1, (size_t)1024 * 256, (size_t)512 * 1024, 32, smem);
    ph_tcvt<MapOdd>(WV, KP.moe_wu, 256, 1024, KP.W_moe1, (size_t)1024 * 256, (size_t)512 * 1024, 32, smem);
    ph_tcvt<MapId>(WV, KP.moe_wd, 1024, 256, KP.W_moe2, (size_t)256 * 1024, (size_t)1024 * 256, 32, smem);
    ph_tcvt<MapId>(WV, KP.od_wr, 128, 128, KP.W_lr, (size_t)128 * 128, (size_t)128 * 128, 4, smem);
    ph_tcvt<MapId>(WV, KP.od_wi, 128, 128, KP.W_li, (size_t)128 * 128, (size_t)128 * 128, 4, smem);
    { CParams& p = KP; ph_misc(WV, p); }
    { CParams& p = KP; ph_mod(WV, p, smem); }
    if (KP.bar == nullptr) grid.sync();
    GSYNC();
    { CParams& p = KP; ph_norm<false, false>(WV, p, p.x, nullptr, nullptr, nullptr, p.norm1_g, p.mod + 1024, p.mod + 0, p.H, smem); }
    GSYNC();
    { CParams& p = KP; ph_small_gemm(WV, p, smem); }
    run_gemm_dense_bf16(WV, lds, KP.H, KP.W_evin, T_, EVN, 1024, PROJB, EVN, 1 << 20);
    GSYNC();
    { CParams& p = KP; bf16_t* fx = (bf16_t*)p.out; const DnBufs d{p.H, p.H + (size_t)T_ * 512, p.VN, fx + (size_t)3 * T_ * 512, p.DNQK, p.DNGL}; ph_dn_prep(WV, p, (const bf16_t*)p.PROJ, d, smem); }
    { CParams& p = KP; ph_cumsum(WV, p, smem); }
    { CParams& p = KP; bf16_t* fx = (bf16_t*)p.out; ph_foxpre(WV, p, (const bf16_t*)p.PROJ, fx, fx + (size_t)2 * T_ * 512, smem); }
    GSYNC();
    { CParams& p = KP; bf16_t* fx = (bf16_t*)p.out; const DnBufs d{p.H, p.H + (size_t)T_ * 512, p.VN, fx + (size_t)3 * T_ * 512, p.DNQK, p.DNGL}; ph_dn_scan(WV, p, (const bf16_t*)p.PROJ, d, p.OMIX, smem); }
    { CParams& p = KP; const bf16_t* fx = (const bf16_t*)p.out; ph_fox_flash(WV, p, (const bf16_t*)p.PROJ, fx, fx + (size_t)2 * T_ * 512, p.OMIX, smem); }
    GSYNC();
    { CParams& p = KP; run_gemm_dense_res<false>(WV, lds, p.OMIX, p.W_evout, T_, 1024, 1024, p.x, XA16(p), p.mod + 2048); }
    GSYNC();
    { CParams& p = KP; ph_route(WV, p, XA16(p), p.norm2_g, p.mod + 4096, p.mod + 3072, p.H, smem); }
    GSYNC();
    { CParams& p = KP; run_gemm_g1(WV, lds, p, p.H, p.W_moe1, (bf16_t*)p.PROJ); }
    GSYNC();
    { CParams& p = KP; run_gemm_g2(WV, lds, p, (const bf16_t*)p.PROJ, p.W_moe2, (bf16_t*)p.PROJ + (size_t)2 * T_ * 256); }
    GSYNC();
    { CParams& p = KP; ph_norm<true, true>(WV, p, XA16(p), (const bf16_t*)p.PROJ + (size_t)2 * T_ * 256, p.mod + 5120, XA16(p), p.norm1_g + 1024, p.mod + 16 * 6144 + 1024, p.mod + 16 * 6144, p.H, smem);
      { const int t0 = otid(WV); if (blockIdx.x == 0 && t0 < 64) p.cnt[t0] = 0; } }
    GSYNC();
    run_gemm_dense_bf16(WV, lds, KP.H, KP.W_odin, T_, 2048, 1024, PROJB, 2048, 2);
    GSYNC();
    { CParams& p = KP; ph_lru(WV, p, (const bf16_t*)p.PROJ, p.OMIX, smem); }
    { CParams& p = KP; ph_sgu(WV, p, (const bf16_t*)p.PROJ, p.OMIX, smem); }
    GSYNC();
    { CParams& p = KP; run_gemm_dense_res<true>(WV, lds, p.OMIX, p.W_odout, T_, 1024, 1024, XA16(p), XA16(p), p.mod + 16 * 6144 + 2048); }
    GSYNC();
    { CParams& p = KP; ph_route(WV, p, XA16(p), p.norm2_g + 1024, p.mod + 16 * 6144 + 4096, p.mod + 16 * 6144 + 3072, p.H, smem); }
    GSYNC();
    { CParams& p = KP; run_gemm_g1(WV, lds, p, p.H, p.W_moe1 + (size_t)16 * 512 * 1024, (bf16_t*)p.PROJ); }
    GSYNC();
    { CParams& p = KP; run_gemm_g2(WV, lds, p, (const bf16_t*)p.PROJ, p.W_moe2 + (size_t)16 * 1024 * 256, (bf16_t*)p.PROJ + (size_t)2 * T_ * 256); }
    GSYNC();
    { CParams& p = KP; ph_norm<true, false>(WV, p, XA16(p), (const bf16_t*)p.PROJ + (size_t)2 * T_ * 256, p.mod + 16 * 6144 + 5120, p.out, nullptr, nullptr, nullptr, nullptr, smem); }
}

static inline size_t al(size_t x) { return (x + 255) & ~(size_t)255; }

extern "C" void kernel_launch(void* const* d_in, const int* in_sizes, int n_in, void* d_out, int out_size, void* d_ws, size_t ws_size, hipStream_t stream) {
    Params p; memset(&p, 0, sizeof(p));
    const float** pin = (const float**)&p;
    for (int i = 0; i < 32; ++i) pin[i] = (const float*)d_in[i];
    p.out = (float*)d_out;
    unsigned char* ws = (unsigned char*)d_ws; size_t off = 0;
    auto take = [&](size_t bytes) { unsigned char* q = ws + off; off += al(bytes); return q; };
    p.W_evin = (bf16_t*)take((size_t)3600 * 1024 * 2);
    p.W_evout = (bf16_t*)take((size_t)1024 * 1024 * 2);
    p.W_odin = (bf16_t*)take((size_t)2048 * 1024 * 2);
    p.W_odout = (bf16_t*)take((size_t)1024 * 1024 * 2);
    p.W_moe1 = (bf16_t*)take((size_t)2 * 16 * 512 * 1024 * 2);
    p.W_moe2 = (bf16_t*)take((size_t)2 * 16 * 1024 * 256 * 2);
    p.W_lr = (bf16_t*)take((size_t)4 * 128 * 128 * 2);
    p.W_li = (bf16_t*)take((size_t)4 * 128 * 128 * 2);
    p.W_sgu = (bf16_t*)take((size_t)4 * 128 * 128 * 2);
    p.mod = (float*)take((size_t)2 * 16 * 6144 * 4);
    p.cnt = (int*)take(256);
    p.bar = (unsigned*)take(16384);
    p.list = (int*)take((size_t)16 * T_ * 4);
    p.gw = (float*)take((size_t)2 * T_ * 4);
    p.gdec = (float*)take((size_t)T_ * 4 * 4);
    p.beta = (float*)take((size_t)T_ * 4 * 4);
    p.lf = (float*)take((size_t)T_ * 4 * 4);
    p.cum = (float*)take((size_t)T_ * 4 * 4);
    p.H = (bf16_t*)take((size_t)T_ * 1024 * 2);
    p.PROJ = take((size_t)T_ * 3600 * 2);
    p.OMIX = (bf16_t*)take((size_t)T_ * 1024 * 2);
    p.VN = (bf16_t*)take((size_t)T_ * 512 * 2);
    p.DNQK = (bf16_t*)take((size_t)4096 * 1024 * 2);
    p.DNGL = (float*)take((size_t)4096 * 4);
    p.small = (float*)take((size_t)T_ * 16 * 4);
    (void)ws_size; (void)n_in; (void)in_sizes; (void)out_size;

    static int grid_blocks = 0;
    if (!grid_blocks) {
        (void)hipFuncSetAttribute((const void*)k_mega, hipFuncAttributeMaxDynamicSharedMemorySize, LDS_BYTES);
        int dev = 0, cus = 0, per_cu = 0; (void)hipGetDevice(&dev); (void)hipDeviceGetAttribute(&cus, hipDeviceAttributeMultiprocessorCount, dev);
        (void)hipOccupancyMaxActiveBlocksPerMultiprocessor(&per_cu, k_mega, NT, LDS_BYTES);
        if (per_cu > 1) per_cu = 1;
        grid_blocks = cus * per_cu;
    }
    (void)hipMemsetAsync(p.bar, 0, 16384, stream);
    void* args[] = {&p};
    (void)hipLaunchCooperativeKernel((const void*)k_mega, dim3(grid_blocks), dim3(NT), args, LDS_BYTES, stream);
}
```

```cpp
#include <hip/hip_runtime.h>
#include <hip/hip_cooperative_groups.h>
#include <stdint.h>
#include <string.h>
namespace cg = cooperative_groups;

#define PG8_LAS __attribute__((address_space(3)))
typedef unsigned short bf16_t;
constexpr int B_ = 16, S_ = 2048, D_ = 1024, T_ = B_ * S_;
constexpr int EVN = 3584;
constexpr int NT = 512;
constexpr int LDS_BYTES = 139264;

__device__ __forceinline__ float bf2f(bf16_t b) { return __uint_as_float(((unsigned)b) << 16); }
__device__ __forceinline__ bf16_t f2bf(float f) { unsigned u = __float_as_uint(f); u += 0x7FFFu + ((u >> 16) & 1u); return (bf16_t)(u >> 16); }
typedef __bf16 pk_bf16x2_t __attribute__((ext_vector_type(2)));
typedef float pk_f32x2_t __attribute__((ext_vector_type(2)));
__device__ __forceinline__ unsigned pk_bf16(float lo, float hi) { pk_f32x2_t f = {lo, hi}; pk_bf16x2_t b = __builtin_convertvector(f, pk_bf16x2_t); return __builtin_bit_cast(unsigned, b); }
__device__ __forceinline__ float sigm(float x) { return __builtin_amdgcn_rcpf(1.f + __builtin_amdgcn_exp2f(-1.4426950408889634f * x)); }
__device__ __forceinline__ float siluf(float x) { return x * sigm(x); }
__device__ __forceinline__ float softplusf_(float x) { return x > 20.f ? x : log1pf(__expf(x)); }
__device__ __forceinline__ float softplus_fast(float x) { return x > 15.f ? x : __logf(1.f + __expf(x)); }
__device__ __forceinline__ float geluf_(float x) { const float x2 = x * x; const float t = x * fmaf(x2, -0.10294324f, -2.3022082f); return x * __builtin_amdgcn_rcpf(1.f + __builtin_amdgcn_exp2f(t)); }
template <int CTRL> __device__ __forceinline__ float dppf(float v) { return __int_as_float(__builtin_amdgcn_update_dpp(0, __float_as_int(v), CTRL, 0xf, 0xf, false)); }
__device__ __forceinline__ float red8_sum(float v) { v += dppf<0xB1>(v); v += dppf<0x4E>(v); v += dppf<0x141>(v); return v; }
__device__ __forceinline__ float wave_sum(float v) {
    v += dppf<0xB1>(v); v += dppf<0x4E>(v); v += dppf<0x141>(v); v += dppf<0x140>(v);
    { auto r = __builtin_amdgcn_permlane16_swap(__float_as_uint(v), __float_as_uint(v), false, false); v = __uint_as_float(r[0]) + __uint_as_float(r[1]); }
    { auto r = __builtin_amdgcn_permlane32_swap(__float_as_uint(v), __float_as_uint(v), false, false); v = __uint_as_float(r[0]) + __uint_as_float(r[1]); }
    return v;
}
__device__ __forceinline__ float wave_max(float v) {
    v = fmaxf(v, dppf<0xB1>(v)); v = fmaxf(v, dppf<0x4E>(v)); v = fmaxf(v, dppf<0x141>(v)); v = fmaxf(v, dppf<0x140>(v));
    { auto r = __builtin_amdgcn_permlane16_swap(__float_as_uint(v), __float_as_uint(v), false, false); v = fmaxf(__uint_as_float(r[0]), __uint_as_float(r[1])); }
    { auto r = __builtin_amdgcn_permlane32_swap(__float_as_uint(v), __float_as_uint(v), false, false); v = fmaxf(__uint_as_float(r[0]), __uint_as_float(r[1])); }
    return v;
}
__device__ __forceinline__ int otid(const int WV) { int l; asm volatile("v_mbcnt_lo_u32_b32 %0, -1, 0\n\tv_mbcnt_hi_u32_b32 %0, -1, %0" : "=v"(l)); return WV * 64 + l; }

struct Params {
    const float *x, *c, *ada_w, *ada_b, *norm1_g, *norm2_g, *ev_w_in, *ev_conv_w, *ev_a_log, *ev_dt_bias, *ev_onorm_g, *ev_f_bias, *ev_qnorm_g, *ev_knorm_g, *ev_w_out;
    const float *od_w_in, *od_conv_w, *od_conv_b, *od_wr, *od_br, *od_wi, *od_bi, *od_lam, *od_sgu_g, *od_sgu_w, *od_sgu_b, *od_w_out, *router_w, *router_b, *moe_wg, *moe_wu, *moe_wd;
    float* out;
    bf16_t *W_evin, *W_evout, *W_odin, *W_odout, *W_moe1, *W_moe2, *W_lr, *W_li, *W_sgu;
    float* mod; int* cnt; unsigned* bar; int* list; float* gw; float* gdec; float* beta; float* lf; float* cum;
    bf16_t* H; unsigned char* PROJ; bf16_t* OMIX; bf16_t* VN; bf16_t* DNQK; float* DNGL; float* small;
};
static_assert(sizeof(Params) % 8 == 0, "params");
typedef const __attribute__((address_space(4))) Params CParams;

struct MapEv { __device__ int operator()(int j) const { if (j < 2048) return j; if (j < 2056) return 3584 + (j - 2048); if (j < 3592) return j - 8; return j; } };
struct MapId { __device__ int operator()(int j) const { return j; } };
struct MapEven { __device__ int operator()(int j) const { return 2 * j; } };
struct MapOdd { __device__ int operator()(int j) const { return 2 * j + 1; } };
template <class F>
__device__ __forceinline__ void ph_tcvt(const int WV, const float* __restrict__ src0, int nsrc, int K, bf16_t* __restrict__ dst0, size_t sstride, size_t dstride, int nz, unsigned char* smem) {
    const int tix_ = otid(WV);
    float (*tile)[64][65] = (float (*)[64][65])smem; F rowmap;
    const int half = tix_ >> 8, tid = tix_ & 255, tx4 = tid & 15, ty4 = tid >> 4;
    const int nj = (nsrc + 63) >> 6, nk = K >> 6, ntiles = nj * nk * nz;
    float4 v[4];
    auto ldtile = [&](int vt) {
        const int z = vt / (nj * nk), rem = vt % (nj * nk), j0 = (rem % nj) * 64, k0 = (rem / nj) * 64;
        const float* src = src0 + (size_t)z * sstride;
#pragma unroll
        for (int ps = 0; ps < 4; ++ps) { v[ps] = make_float4(0.f, 0.f, 0.f, 0.f); if (j0 + 4 * tx4 < nsrc) v[ps] = *(const float4*)(src + (size_t)(k0 + ty4 + 16 * ps) * nsrc + j0 + 4 * tx4); }
    };
    int base = blockIdx.x * 2;
    if (base + half < ntiles) ldtile(base + half);
    for (; base < ntiles; base += gridDim.x * 2) {
        const int vt = base + half; const bool valid = vt < ntiles;
        const int z = vt / (nj * nk), rem = vt % (nj * nk), j0 = (rem % nj) * 64, k0 = (rem / nj) * 64;
        bf16_t* dst = dst0 + (size_t)z * dstride;
        __syncthreads();
        if (valid) {
#pragma unroll
            for (int ps = 0; ps < 4; ++ps) { const int kk = ty4 + 16 * ps; tile[half][kk][4 * tx4] = v[ps].x; tile[half][kk][4 * tx4 + 1] = v[ps].y; tile[half][kk][4 * tx4 + 2] = v[ps].z; tile[half][kk][4 * tx4 + 3] = v[ps].w; } }
        __syncthreads();
        { const int nvt = vt + gridDim.x * 2; if (nvt < ntiles) ldtile(nvt); }
        if (valid) { const int kq = tid & 15, jr = tid >> 4;
#pragma unroll
            for (int ps = 0; ps < 4; ++ps) { const int jj = jr + 16 * ps; if (j0 + jj < nsrc) { const int r = rowmap(j0 + jj);
                if (r >= 0) { uint2 o; o.x = pk_bf16(tile[half][4 * kq][jj], tile[half][4 * kq + 1][jj]); o.y = pk_bf16(tile[half][4 * kq + 2][jj], tile[half][4 * kq + 3][jj]);
                    *(uint2*)(dst + (size_t)r * K + k0 + 4 * kq) = o; } } } }
    }
    __syncthreads();
}
__device__ __forceinline__ void ph_misc(const int WV, CParams& p) {
    const int tix_ = otid(WV);
    const int gtid = blockIdx.x * NT + tix_, gn = gridDim.x * NT;
    for (int i = gtid; i < 4 * 128 * 128; i += gn) { const int s = i & 127, t = (i >> 7) & 127; p.W_sgu[i] = f2bf(s <= t ? p.od_sgu_w[i] : 0.f); }
    if (gtid < 512) p.cnt[gtid] = 0;
    for (int i = gtid; i < 4 * 1024 / 2; i += gn) ((unsigned*)(p.W_evin + (size_t)3596 * 1024))[i] = 0u;
}

__device__ __forceinline__ void ph_mod(const int WV, CParams& p, unsigned char* smem) {
    const int tix_ = otid(WV);
    const int lane = tix_ & 63, w = tix_ >> 6;
    float* ca = (float*)smem;
    float* red = ca + 16384;
    __syncthreads();
#pragma unroll 8
    for (int i = tix_; i < 16384; i += NT) { const int b = i >> 10, k = i & 1023; ca[k * 16 + b] = siluf(p.c[i]); }
    __syncthreads();
    for (int item = blockIdx.x; item < 256; item += gridDim.x) {
        const int cidx = item * 48 + min(lane, 47), l = cidx / 6144, j = cidx % 6144;
        float acc[16];
#pragma unroll
        for (int b = 0; b < 16; ++b) acc[b] = 0.f;
        const float* wp = p.ada_w + ((size_t)l * 1024 + 128 * w) * 6144 + j;
#pragma unroll 1
        for (int kb = 0; kb < 128; kb += 32) {
            float wv[32];
#pragma unroll
            for (int kk = 0; kk < 32; ++kk) wv[kk] = wp[(size_t)(kb + kk) * 6144];
#pragma unroll
            for (int kk = 0; kk < 32; ++kk) { const float4* cp = (const float4*)(ca + (128 * w + kb + kk) * 16);
                const float4 c0 = cp[0], c1 = cp[1], c2 = cp[2], c3 = cp[3]; const float x = wv[kk];
                acc[0] += c0.x * x; acc[1] += c0.y * x; acc[2] += c0.z * x; acc[3] += c0.w * x; acc[4] += c1.x * x; acc[5] += c1.y * x; acc[6] += c1.z * x; acc[7] += c1.w * x;
                acc[8] += c2.x * x; acc[9] += c2.y * x; acc[10] += c2.z * x; acc[11] += c2.w * x; acc[12] += c3.x * x; acc[13] += c3.y * x; acc[14] += c3.z * x; acc[15] += c3.w * x; }
        }
#pragma unroll
        for (int b = 0; b < 16; ++b) red[(w * 16 + b) * 64 + lane] = acc[b];
        __syncthreads();
#pragma unroll
        for (int i = 0; i < 2; ++i) { const int o = tix_ + i * NT, b = o >> 6, cl = o & 63; float sum = 0.f;
#pragma unroll
            for (int ww = 0; ww < 8; ++ww) sum += red[(ww * 16 + b) * 64 + cl];
            const int ci2 = item * 48 + cl, l2 = ci2 / 6144, j2 = ci2 % 6144;
            if (cl < 48) p.mod[((size_t)l2 * 16 + b) * 6144 + j2] = sum + p.ada_b[l2 * 6144 + j2]; }
        __syncthreads();
    }
}

__device__ __forceinline__ float4 ld_res4(const void* p, size_t idx, bool is16) {
    if (is16) { const uint2 v = *(const uint2*)((const bf16_t*)p + idx); return make_float4(__uint_as_float(v.x << 16), __uint_as_float(v.x & 0xffff0000u), __uint_as_float(v.y << 16), __uint_as_float(v.y & 0xffff0000u)); }
    return *(const float4*)((const float*)p + idx);
}
template <bool XIN16, bool XOUT16>
__device__ __forceinline__ void ph_norm(const int WV, CParams& p, const void* xin, const bf16_t* __restrict__ y, const float* __restrict__ gt2, void* xout,
                        const float* __restrict__ g, const float* __restrict__ sc, const float* __restrict__ sh, bf16_t* __restrict__ hout, unsigned char* smem) {
    const int tix_ = otid(WV);
    const int lane = tix_ & 63, wv = (blockIdx.x * NT + tix_) >> 6, nw = gridDim.x * (NT / 64);
    constexpr int U = 2;
    for (int tb = wv * U; tb < T_; tb += nw * U) {
        const int b = tb >> 11;
        float4 xv[U][4]; float ss[U];
#pragma unroll
        for (int u = 0; u < U; ++u)
#pragma unroll
            for (int i = 0; i < 4; ++i) xv[u][i] = ld_res4(xin, (size_t)(tb + u) * 1024 + i * 256 + lane * 4, XIN16);
        if (y) {
#pragma unroll
            for (int i = 0; i < 4; ++i) { const int col = i * 256 + lane * 4; const float4 gv = *(const float4*)(gt2 + b * 6144 + col);
#pragma unroll
                for (int u = 0; u < U; ++u) { const bf16_t* y0 = y + (size_t)(2 * (tb + u)) * 1024 + col; const uint2 a0 = *(const uint2*)y0, a1 = *(const uint2*)(y0 + 1024);
                    float4 v = xv[u][i];
                    v.x += gv.x * (__uint_as_float(a0.x << 16) + __uint_as_float(a1.x << 16)); v.y += gv.y * (__uint_as_float(a0.x & 0xffff0000u) + __uint_as_float(a1.x & 0xffff0000u));
                    v.z += gv.z * (__uint_as_float(a0.y << 16) + __uint_as_float(a1.y << 16)); v.w += gv.w * (__uint_as_float(a0.y & 0xffff0000u) + __uint_as_float(a1.y & 0xffff0000u));
                    xv[u][i] = v;
                    if (XOUT16) { uint2 o; o.x = pk_bf16(v.x, v.y); o.y = pk_bf16(v.z, v.w); *(uint2*)((bf16_t*)xout + (size_t)(tb + u) * 1024 + col) = o; }
                    else *(float4*)((float*)xout + (size_t)(tb + u) * 1024 + col) = v; } }
        }
        if (!hout) continue;
#pragma unroll
        for (int u = 0; u < U; ++u) { float a = 0.f;
#pragma unroll
            for (int i = 0; i < 4; ++i) a += xv[u][i].x * xv[u][i].x + xv[u][i].y * xv[u][i].y + xv[u][i].z * xv[u][i].z + xv[u][i].w * xv[u][i].w;
            ss[u] = rsqrtf(wave_sum(a) * (1.f / 1024.f) + 1e-6f); }
#pragma unroll
        for (int i = 0; i < 4; ++i) {
            const int col = i * 256 + lane * 4;
            const float4 gv = *(const float4*)(g + col), scv = *(const float4*)(sc + b * 6144 + col), shv = *(const float4*)(sh + b * 6144 + col);
            const float m0 = gv.x * (1.f + scv.x), m1 = gv.y * (1.f + scv.y), m2 = gv.z * (1.f + scv.z), m3 = gv.w * (1.f + scv.w);
#pragma unroll
            for (int u = 0; u < U; ++u) { const float r = ss[u];
                uint2 o; o.x = pk_bf16(xv[u][i].x * r * m0 + shv.x, xv[u][i].y * r * m1 + shv.y); o.y = pk_bf16(xv[u][i].z * r * m2 + shv.z, xv[u][i].w * r * m3 + shv.w);
                *(uint2*)(hout + (size_t)(tb + u) * 1024 + col) = o; }
        }
    }
}

typedef short dn_bf16x8 __attribute__((ext_vector_type(8)));
typedef float dn_f32x4 __attribute__((ext_vector_type(4)));
struct DnBufs { bf16_t* Wp; bf16_t* QDp; bf16_t* KDTp; bf16_t* UTp; bf16_t* QKp; float* GL; };
__device__ __forceinline__ dn_f32x4 dn_mfma(dn_bf16x8 a, dn_bf16x8 b, dn_f32x4 c) { return __builtin_amdgcn_mfma_f32_16x16x32_bf16(a, b, c, 0, 0, 0); }
__device__ __forceinline__ unsigned dn_pk(float lo, float hi) { return pk_bf16(lo, hi); }
#define DN_LFENCE() asm volatile("s_waitcnt lgkmcnt(0)" ::: "memory")

__device__ __forceinline__ void dn_conv_tile(const bf16_t* __restrict__ proj, const float* __restrict__ cw, int t0, int s0, int ten, int hd, int lane, bf16_t* tile) {
    const int col = ten * 512 + hd * 128 + lane * 2;
    const float wa0 = cw[0 * 1536 + col], wa1 = cw[1 * 1536 + col], wa2 = cw[2 * 1536 + col], wa3 = cw[3 * 1536 + col];
    const float wb0 = cw[0 * 1536 + col + 1], wb1 = cw[1 * 1536 + col + 1], wb2 = cw[2 * 1536 + col + 1], wb3 = cw[3 * 1536 + col + 1];
    const bf16_t* src = proj + (size_t)t0 * EVN + col;
    float a0 = 0.f, a1 = 0.f, a2 = 0.f, b0 = 0.f, b1 = 0.f, b2 = 0.f;
    if (s0 > 0) {
        const unsigned p0 = *(const unsigned*)(src - 3 * EVN), p1 = *(const unsigned*)(src - 2 * EVN), p2 = *(const unsigned*)(src - 1 * EVN);
        a0 = __uint_as_float(p0 << 16); b0 = __uint_as_float(p0 & 0xffff0000u); a1 = __uint_as_float(p1 << 16); b1 = __uint_as_float(p1 & 0xffff0000u); a2 = __uint_as_float(p2 << 16); b2 = __uint_as_float(p2 & 0xffff0000u);
    }
#pragma unroll
    for (int rb = 0; rb < 2; ++rb) {
        unsigned pv[16];
#pragma unroll
        for (int r = 0; r < 16; ++r) pv[r] = *(const unsigned*)(src + (size_t)(rb * 16 + r) * EVN);
#pragma unroll
        for (int r = 0; r < 16; ++r) {
            const float a3 = __uint_as_float(pv[r] << 16), b3 = __uint_as_float(pv[r] & 0xffff0000u);
            const float oa = siluf(wa0 * a0 + wa1 * a1 + wa2 * a2 + wa3 * a3), ob = siluf(wb0 * b0 + wb1 * b1 + wb2 * b2 + wb3 * b3);
            *(unsigned*)(tile + (rb * 16 + r) * 136 + lane * 2) = dn_pk(oa, ob);
            a0 = a1; a1 = a2; a2 = a3; b0 = b1; b1 = b2; b2 = b3;
        }
    }
}

__device__ __forceinline__ void ph_dn_prep(const int WV, CParams& p, const bf16_t* __restrict__ proj, const DnBufs d, unsigned char* smem) {
    const int tid = otid(WV), lane = tid & 63, w = tid >> 6, c = lane & 15, g = lane >> 4;
    unsigned char* base = smem + w * 16896;
    bf16_t* tile = (bf16_t*)base; float* Lm = (float*)(base + 8704); bf16_t* Tm = (bf16_t*)(base + 13312); float* tab = (float*)(base + 15872);
    float* t_gc = tab, *t_be = tab + 32, *t_ek = tab + 64, *t_dk = tab + 96, *t_rk = tab + 128, *t_rq = tab + 160;
    const int gw = blockIdx.x * (NT / 64) + w, nw = gridDim.x * (NT / 64);
    for (int ci = gw; ci < 64 * 64; ci += nw) {
        const int bh = ci >> 6, ch = ci & 63, b = bh >> 2, hd = bh & 3, s0 = ch * 32, t0 = b * S_ + s0;
        DN_LFENCE();
        if (lane < 32) { const float* sp = p.small + (size_t)(t0 + lane) * 16; t_gc[lane] = -__expf(p.ev_a_log[hd]) * softplus_fast(sp[hd] + p.ev_dt_bias[hd]); t_be[lane] = sigm(sp[4 + hd]); }
        DN_LFENCE();
        float gcs = 0.f;
        if (lane < 32) { for (int i = 0; i <= lane; ++i) gcs += t_gc[i]; }
        DN_LFENCE();
        if (lane < 32) { t_gc[lane] = gcs; t_ek[lane] = __expf(gcs); }
        DN_LFENCE();
        const float gc31 = t_gc[31];
        if (lane < 32) t_dk[lane] = __expf(gc31 - gcs);
        dn_conv_tile(proj, p.ev_conv_w, t0, s0, 1, hd, lane, tile);
        DN_LFENCE();
        dn_bf16x8 Kr[2][4];
#pragma unroll
        for (int mi = 0; mi < 2; ++mi)
#pragma unroll
            for (int s = 0; s < 4; ++s) Kr[mi][s] = *(const dn_bf16x8*)(tile + (16 * mi + c) * 136 + 32 * s + 8 * g);
        union U8 { dn_bf16x8 v; unsigned short e[8]; unsigned u[4]; };
        U8 KT[8];
#pragma unroll
        for (int mb = 0; mb < 8; ++mb)
#pragma unroll
            for (int jj = 0; jj < 8; ++jj) KT[mb].e[jj] = tile[(16 * (jj >> 2) + 4 * g + (jj & 3)) * 136 + 16 * mb + c];
        dn_f32x4 ak[2][2];
#pragma unroll
        for (int mi = 0; mi < 2; ++mi)
#pragma unroll
            for (int nj = 0; nj < 2; ++nj) { dn_f32x4 a = {0.f, 0.f, 0.f, 0.f};
#pragma unroll
                for (int s = 0; s < 4; ++s) a = dn_mfma(Kr[mi][s], Kr[nj][s], a);
                ak[mi][nj] = a; }
#pragma unroll
        for (int mi = 0; mi < 2; ++mi)
#pragma unroll
            for (int r = 0; r < 4; ++r) if (g == (c >> 2) && (c & 3) == r) t_rk[16 * mi + c] = rsqrtf(ak[mi][mi][r] + 1e-6f);
        DN_LFENCE();
#pragma unroll
        for (int mi = 0; mi < 2; ++mi)
#pragma unroll
            for (int nj = 0; nj < 2; ++nj)
#pragma unroll
                for (int r = 0; r < 4; ++r) { const int i = 16 * mi + 4 * g + r, j = 16 * nj + c;
                    const float v = (i > j) ? t_be[i] * t_rk[i] * t_rk[j] * ak[mi][nj][r] * __expf(t_gc[i] - t_gc[j]) : 0.f;
                    Lm[i * 36 + j] = v; }
        DN_LFENCE();
        {
            const int cc = lane & 31;
            float T[32];
#pragma unroll
            for (int i = 0; i < 32; ++i) {
                float acc = (i == cc) ? 1.f : 0.f;
#pragma unroll
                for (int j4 = 0; j4 < (i + 3) / 4; ++j4) { const dn_f32x4 lv = *(const dn_f32x4*)(Lm + i * 36 + 4 * j4);
#pragma unroll
                    for (int q = 0; q < 4; ++q) if (4 * j4 + q < i) acc -= lv[q] * T[4 * j4 + q]; }
                T[i] = acc;
            }
            if (lane < 32) {
#pragma unroll
                for (int i = 0; i < 32; ++i) Tm[i * 40 + cc] = f2bf(T[i]);
            }
        }
        DN_LFENCE();
        U8 Tr[2];
#pragma unroll
        for (int mi = 0; mi < 2; ++mi) { const uint2 lo = *(const uint2*)(Tm + (16 * mi + c) * 40 + 4 * g), hi = *(const uint2*)(Tm + (16 * mi + c) * 40 + 16 + 4 * g);
            Tr[mi].u[0] = lo.x; Tr[mi].u[1] = lo.y; Tr[mi].u[2] = hi.x; Tr[mi].u[3] = hi.y; }
        dn_conv_tile(proj, p.ev_conv_w, t0, s0, 0, hd, lane, tile);
        DN_LFENCE();
        dn_f32x4 as_[2][2];
        {
            dn_bf16x8 Qr[2][4];
#pragma unroll
            for (int ni = 0; ni < 2; ++ni)
#pragma unroll
                for (int s = 0; s < 4; ++s) Qr[ni][s] = *(const dn_bf16x8*)(tile + (16 * ni + c) * 136 + 32 * s + 8 * g);
#pragma unroll
            for (int mj = 0; mj < 2; ++mj)
#pragma unroll
                for (int ni = 0; ni < 2; ++ni) { dn_f32x4 a = {0.f, 0.f, 0.f, 0.f};
#pragma unroll
                    for (int s = 0; s < 4; ++s) a = dn_mfma(Kr[mj][s], Qr[ni][s], a);
                    as_[mj][ni] = a; }
#pragma unroll
            for (int ni = 0; ni < 2; ++ni) { dn_f32x4 a = {0.f, 0.f, 0.f, 0.f};
#pragma unroll
                for (int s = 0; s < 4; ++s) a = dn_mfma(Qr[ni][s], Qr[ni][s], a);
#pragma unroll
                for (int r = 0; r < 4; ++r) if (g == (c >> 2) && (c & 3) == r) t_rq[16 * ni + c] = rsqrtf(a[r] + 1e-6f) * 0.08838834764831845f; }
        }
        DN_LFENCE();
        { bf16_t* qo = d.QDp + (size_t)ci * 4096;
#pragma unroll
            for (int it = 0; it < 8; ++it) { const int id = it * 64 + lane, i = id >> 4, s = (id >> 2) & 3, gg = id & 3;
                const uint2 lo = *(const uint2*)(tile + i * 136 + 32 * s + 4 * gg), hi = *(const uint2*)(tile + i * 136 + 32 * s + 16 + 4 * gg);
                const float f = t_rq[i] * t_ek[i];
                uint4 o; o.x = dn_pk(__uint_as_float(lo.x << 16) * f, __uint_as_float(lo.x & 0xffff0000u) * f); o.y = dn_pk(__uint_as_float(lo.y << 16) * f, __uint_as_float(lo.y & 0xffff0000u) * f);
                o.z = dn_pk(__uint_as_float(hi.x << 16) * f, __uint_as_float(hi.x & 0xffff0000u) * f); o.w = dn_pk(__uint_as_float(hi.y << 16) * f, __uint_as_float(hi.y & 0xffff0000u) * f);
                *(uint4*)(qo + i * 128 + 32 * s + 8 * gg) = o; } }
        DN_LFENCE();
        dn_conv_tile(proj, p.ev_conv_w, t0, s0, 2, hd, lane, tile);
        DN_LFENCE();
        float bej[8], fwj[8], fkj[8];
#pragma unroll
        for (int jj = 0; jj < 8; ++jj) { const int j = 16 * (jj >> 2) + 4 * g + (jj & 3); const float rk = t_rk[j]; bej[jj] = t_be[j]; fwj[jj] = bej[jj] * rk * t_ek[j]; fkj[jj] = rk * t_dk[j]; }
        U8 VT[8];
#pragma unroll
        for (int nb = 0; nb < 8; ++nb) {
            float tv[8];
#pragma unroll
            for (int jj = 0; jj < 8; ++jj) tv[jj] = bf2f(tile[(16 * (jj >> 2) + 4 * g + (jj & 3)) * 136 + 16 * nb + c]) * bej[jj];
#pragma unroll
            for (int q = 0; q < 4; ++q) VT[nb].u[q] = dn_pk(tv[2 * q], tv[2 * q + 1]);
        }
        { bf16_t* uo = d.UTp + (size_t)ci * 4096;
#pragma unroll
            for (int nb = 0; nb < 8; ++nb)
#pragma unroll
                for (int mi = 0; mi < 2; ++mi) { const dn_f32x4 z4 = {0.f, 0.f, 0.f, 0.f}; const dn_f32x4 a = dn_mfma(Tr[mi].v, VT[nb].v, z4);
                    uint2 o; o.x = dn_pk(a[0], a[1]); o.y = dn_pk(a[2], a[3]); *(uint2*)(uo + (16 * nb + c) * 32 + 16 * mi + 4 * g) = o; } }
        { bf16_t* ko = d.KDTp + (size_t)ci * 4096; bf16_t* wo = d.Wp + (size_t)ci * 4096;
#pragma unroll
            for (int s = 0; s < 4; ++s) {
                U8 kw[2];
#pragma unroll
                for (int hf = 0; hf < 2; ++hf) { const int mb = 2 * s + hf; float kv[8];
#pragma unroll
                    for (int jj = 0; jj < 8; ++jj) kv[jj] = bf2f(KT[mb].e[jj]);
                    uint4 o; o.x = dn_pk(kv[0] * fkj[0], kv[1] * fkj[1]); o.y = dn_pk(kv[2] * fkj[2], kv[3] * fkj[3]); o.z = dn_pk(kv[4] * fkj[4], kv[5] * fkj[5]); o.w = dn_pk(kv[6] * fkj[6], kv[7] * fkj[7]);
                    *(uint4*)(ko + (16 * mb + c) * 32 + 8 * g) = o;
#pragma unroll
                    for (int q = 0; q < 4; ++q) kw[hf].u[q] = dn_pk(kv[2 * q] * fwj[2 * q], kv[2 * q + 1] * fwj[2 * q + 1]); }
#pragma unroll
                for (int ni = 0; ni < 2; ++ni) { const dn_f32x4 z4 = {0.f, 0.f, 0.f, 0.f};
                    const dn_f32x4 c0 = dn_mfma(kw[0].v, Tr[ni].v, z4), c1 = dn_mfma(kw[1].v, Tr[ni].v, z4);
                    uint4 o; o.x = dn_pk(c0[0], c0[1]); o.y = dn_pk(c0[2], c0[3]); o.z = dn_pk(c1[0], c1[1]); o.w = dn_pk(c1[2], c1[3]);
                    *(uint4*)(wo + (16 * ni + c) * 128 + 32 * s + 8 * g) = o; }
            } }
        { bf16_t* qo = d.QKp + (size_t)ci * 1024;
#pragma unroll
            for (int ni = 0; ni < 2; ++ni) { const int i = 16 * ni + c; const float rq = t_rq[i], gi = t_gc[i]; float v[8];
#pragma unroll
                for (int mj = 0; mj < 2; ++mj)
#pragma unroll
                    for (int r = 0; r < 4; ++r) { const int j = 16 * mj + 4 * g + r; v[4 * mj + r] = (i >= j) ? as_[mj][ni][r] * rq * t_rk[j] * __expf(gi - t_gc[j]) : 0.f; }
                uint4 o; o.x = dn_pk(v[0], v[1]); o.y = dn_pk(v[2], v[3]); o.z = dn_pk(v[4], v[5]); o.w = dn_pk(v[6], v[7]);
                *(uint4*)(qo + i * 32 + 8 * g) = o; } }
        if (lane == 0) d.GL[ci] = __expf(gc31);
    }
    __syncthreads();
}

#define DN_DECL(R) uint4 R##w, R##qd, R##kdt, R##ut, R##qk, R##z; float R##gl
#define DN_LOAD(R, ci_, trow_) do { const size_t _ci = (ci_); \
    R##w = *(const uint4*)(d.Wp + _ci * 4096 + tid * 8); R##qd = *(const uint4*)(d.QDp + _ci * 4096 + tid * 8); R##kdt = *(const uint4*)(d.KDTp + _ci * 4096 + tid * 8); \
    R##ut = *(const uint4*)(d.UTp + _ci * 4096 + tid * 8); R##qk = *(const uint4*)(d.QKp + _ci * 1024 + (tid & 127) * 8); R##gl = d.GL[_ci]; \
    R##z = *(const uint4*)(proj + (size_t)(trow_) * EVN + 1536 + hd * 128 + (tid & 15) * 8); } while (0)
#define DN_WRITE(R, bb_) do { unsigned char* _bb = (bb_); \
    *(uint4*)(_bb + (tid >> 4) * 272 + (tid & 15) * 16) = R##w; *(uint4*)(_bb + 8704 + (tid >> 4) * 272 + (tid & 15) * 16) = R##qd; \
    *(uint4*)(_bb + 17408 + tid * 16) = R##kdt; *(uint4*)(_bb + 25600 + tid * 16) = R##ut; if (tid < 128) *(uint4*)(_bb + 33792 + tid * 16) = R##qk; } while (0)
__device__ __forceinline__ void dn_step_compute(dn_f32x4 (&Sf)[8], const unsigned char* bb, float* Ot, float gl, int w, int c, int g) {
    union U8 { dn_bf16x8 v; unsigned u[4]; };
    U8 Sb[4];
#pragma unroll
    for (int s = 0; s < 4; ++s) { Sb[s].u[0] = dn_pk(Sf[2 * s][0], Sf[2 * s][1]); Sb[s].u[1] = dn_pk(Sf[2 * s][2], Sf[2 * s][3]); Sb[s].u[2] = dn_pk(Sf[2 * s + 1][0], Sf[2 * s + 1][1]); Sb[s].u[3] = dn_pk(Sf[2 * s + 1][2], Sf[2 * s + 1][3]); }
    dn_f32x4 vn[2], O[2];
#pragma unroll
    for (int mi = 0; mi < 2; ++mi) {
        dn_f32x4 P = {0.f, 0.f, 0.f, 0.f}, Oa = {0.f, 0.f, 0.f, 0.f};
#pragma unroll
        for (int s = 0; s < 4; ++s) { const dn_bf16x8 wa = *(const dn_bf16x8*)(bb + (16 * mi + c) * 272 + 64 * s + 16 * g); P = dn_mfma(wa, Sb[s].v, P);
            const dn_bf16x8 qa = *(const dn_bf16x8*)(bb + 8704 + (16 * mi + c) * 272 + 64 * s + 16 * g); Oa = dn_mfma(qa, Sb[s].v, Oa); }
        const uint2 uu = *(const uint2*)(bb + 25600 + (16 * w + c) * 64 + (16 * mi + 4 * g) * 2);
        vn[mi][0] = __uint_as_float(uu.x << 16) - P[0]; vn[mi][1] = __uint_as_float(uu.x & 0xffff0000u) - P[1]; vn[mi][2] = __uint_as_float(uu.y << 16) - P[2]; vn[mi][3] = __uint_as_float(uu.y & 0xffff0000u) - P[3];
        O[mi] = Oa;
    }
    U8 Vb; Vb.u[0] = dn_pk(vn[0][0], vn[0][1]); Vb.u[1] = dn_pk(vn[0][2], vn[0][3]); Vb.u[2] = dn_pk(vn[1][0], vn[1][1]); Vb.u[3] = dn_pk(vn[1][2], vn[1][3]);
#pragma unroll
    for (int mi = 0; mi < 2; ++mi) { const dn_bf16x8 qk = *(const dn_bf16x8*)(bb + 33792 + (16 * mi + c) * 64 + 16 * g); O[mi] = dn_mfma(qk, Vb.v, O[mi]);
#pragma unroll
        for (int r = 0; r < 4; ++r) Ot[(16 * mi + 4 * g + r) * 132 + 16 * w + c] = O[mi][r]; }
#pragma unroll
    for (int mb = 0; mb < 8; ++mb) { const dn_bf16x8 ka = *(const dn_bf16x8*)(bb + 17408 + (16 * mb + c) * 64 + 16 * g); Sf[mb] = dn_mfma(ka, Vb.v, Sf[mb] * gl); }
}
__device__ __forceinline__ void dn_step_norm(const float* Ot, uint4 zz, const float4 g0, const float4 g1, bf16_t* __restrict__ omix, size_t t, int hd, int tid) {
    const int row = tid >> 4, sub = tid & 15;
    const dn_f32x4 o0 = *(const dn_f32x4*)(Ot + row * 132 + sub * 8), o1 = *(const dn_f32x4*)(Ot + row * 132 + sub * 8 + 4);
    float ss = o0[0] * o0[0] + o0[1] * o0[1] + o0[2] * o0[2] + o0[3] * o0[3] + o1[0] * o1[0] + o1[1] * o1[1] + o1[2] * o1[2] + o1[3] * o1[3];
    ss += dppf<0xB1>(ss); ss += dppf<0x4E>(ss); ss += dppf<0x141>(ss); ss += dppf<0x140>(ss);
    const float rstd = rsqrtf(ss * (1.f / 128.f) + 1e-6f);
    uint4 ov;
    ov.x = dn_pk(o0[0] * rstd * g0.x * siluf(__uint_as_float(zz.x << 16)), o0[1] * rstd * g0.y * siluf(__uint_as_float(zz.x & 0xffff0000u)));
    ov.y = dn_pk(o0[2] * rstd * g0.z * siluf(__uint_as_float(zz.y << 16)), o0[3] * rstd * g0.w * siluf(__uint_as_float(zz.y & 0xffff0000u)));
    ov.z = dn_pk(o1[0] * rstd * g1.x * siluf(__uint_as_float(zz.z << 16)), o1[1] * rstd * g1.y * siluf(__uint_as_float(zz.z & 0xffff0000u)));
    ov.w = dn_pk(o1[2] * rstd * g1.z * siluf(__uint_as_float(zz.w << 16)), o1[3] * rstd * g1.w * siluf(__uint_as_float(zz.w & 0xffff0000u)));
    *(uint4*)(omix + (t + row) * 1024 + hd * 128 + sub * 8) = ov;
}
__device__ __forceinline__ void ph_dn_scan(const int WV, CParams& p, const bf16_t* __restrict__ proj, const DnBufs d, bf16_t* __restrict__ omix, unsigned char* smem) {
    const int tid = otid(WV), lane = tid & 63, w = tid >> 6, c = lane & 15, g = lane >> 4;
    constexpr int BUF = 35840, OFF_O = 2 * BUF, OSZ = 32 * 132 * 4;
    for (int bh = blockIdx.x; bh < 64; bh += gridDim.x) {
        const int b = bh >> 2, hd = bh & 3; const size_t ci0 = (size_t)bh * 64, tr0 = (size_t)b * S_ + (tid >> 4);
        dn_f32x4 Sf[8];
#pragma unroll
        for (int mb = 0; mb < 8; ++mb) Sf[mb] = (dn_f32x4){0.f, 0.f, 0.f, 0.f};
        const float4 og0 = *(const float4*)(p.ev_onorm_g + (tid & 15) * 8), og1 = *(const float4*)(p.ev_onorm_g + (tid & 15) * 8 + 4);
        DN_DECL(R0); DN_DECL(R1);
        DN_LOAD(R0, ci0, tr0);
        DN_LOAD(R1, ci0 + 1, tr0 + 32);
        __syncthreads();
        DN_WRITE(R0, smem);
        float gl0 = R0gl; uint4 z0 = R0z;
        __syncthreads();
        for (int ch = 0; ch < 64; ch += 2) {
            const int n2 = min(ch + 2, 63), n3 = min(ch + 3, 63);
            DN_LOAD(R0, ci0 + n2, tr0 + (size_t)n2 * 32);
            dn_step_compute(Sf, smem, (float*)(smem + OFF_O), gl0, w, c, g);
            DN_WRITE(R1, smem + BUF);
            const float gl1 = R1gl; const uint4 z1 = R1z;
            __syncthreads();
            dn_step_norm((const float*)(smem + OFF_O), z0, og0, og1, omix, (size_t)b * S_ + ch * 32, hd, tid);
            DN_LOAD(R1, ci0 + n3, tr0 + (size_t)n3 * 32);
            dn_step_compute(Sf, smem + BUF, (float*)(smem + OFF_O + OSZ), gl1, w, c, g);
            DN_WRITE(R0, smem); gl0 = R0gl; z0 = R0z;
            __syncthreads();
            dn_step_norm((const float*)(smem + OFF_O + OSZ), z1, og0, og1, omix, (size_t)b * S_ + (ch + 1) * 32, hd, tid);
        }
        __syncthreads();
    }
}

__device__ __forceinline__ void ph_small_gemm(const int WV, CParams& p, unsigned char* smem) {
    const int tid = otid(WV), lane = tid & 63, c = lane & 15, g4 = lane >> 4;
    constexpr int RP = 1032;
    bf16_t* Ws = (bf16_t*)smem;
    __syncthreads();
    for (int i = tid; i < 16 * 128; i += NT) { const int r = i >> 7, ch = i & 127; *(uint4*)(Ws + r * RP + ch * 8) = *(const uint4*)(p.W_evin + (size_t)(3584 + r) * 1024 + ch * 8); }
    __syncthreads();
    const int gw = blockIdx.x * (NT / 64) + (tid >> 6), nw = gridDim.x * (NT / 64);
    for (int rb = gw; rb < T_ / 16; rb += nw) {
        const bf16_t* ap = p.H + (size_t)(rb * 16 + c) * 1024 + 8 * g4;
        dn_f32x4 acc = {0.f, 0.f, 0.f, 0.f};
#pragma unroll
        for (int kb = 0; kb < 2; ++kb) {
            dn_bf16x8 af[16];
#pragma unroll
            for (int ks = 0; ks < 16; ++ks) af[ks] = *(const dn_bf16x8*)(ap + 32 * (kb * 16 + ks));
#pragma unroll
            for (int ks = 0; ks < 16; ++ks) acc = dn_mfma(af[ks], *(const dn_bf16x8*)(Ws + c * RP + 32 * (kb * 16 + ks) + 8 * g4), acc);
        }
#pragma unroll
        for (int r = 0; r < 4; ++r) p.small[(size_t)(rb * 16 + 4 * g4 + r) * 16 + c] = acc[r];
    }
    __syncthreads();
}
__device__ __forceinline__ uint4 fx_knorm(uint4 v, const float* __restrict__ gp) {
    const float4 ga = *(const float4*)gp, gb = *(const float4*)(gp + 4); const float g[8] = {ga.x, ga.y, ga.z, ga.w, gb.x, gb.y, gb.z, gb.w};
    const unsigned u[4] = {v.x, v.y, v.z, v.w}; float f[8]; float ss = 0.f;
#pragma unroll
    for (int k = 0; k < 4; ++k) { f[2 * k] = __uint_as_float(u[k] << 16); f[2 * k + 1] = __uint_as_float(u[k] & 0xffff0000u); ss += f[2 * k] * f[2 * k] + f[2 * k + 1] * f[2 * k + 1]; }
    ss += dppf<0xB1>(ss); ss += dppf<0x4E>(ss); ss += dppf<0x141>(ss); ss += dppf<0x140>(ss);
    const float r = rsqrtf(ss * (1.f / 128.f) + 1e-6f);
    uint4 o; o.x = pk_bf16(f[0] * r * g[0], f[1] * r * g[1]); o.y = pk_bf16(f[2] * r * g[2], f[3] * r * g[3]); o.z = pk_bf16(f[4] * r * g[4], f[5] * r * g[5]); o.w = pk_bf16(f[6] * r * g[6], f[7] * r * g[7]);
    return o;
}
__device__ __forceinline__ void ph_foxpre(const int WV, CParams& p, const bf16_t* __restrict__ proj, bf16_t* __restrict__ fk, bf16_t* __restrict__ vt, unsigned char* smem) {
    const int tix_ = otid(WV);
    bf16_t* tile = (bf16_t*)smem;
    for (int item = blockIdx.x; item < 64 * 32; item += gridDim.x) {
        const int bh = item >> 5, st = item & 31, bb = bh >> 2, hd = bh & 3, t0 = bb * S_ + st * 64;
        __syncthreads();
#pragma unroll
        for (int i = 0; i < 2; ++i) { const int id = tix_ + i * NT, r = id >> 4, c16 = id & 15;
            const uint4 kv = *(const uint4*)(proj + (size_t)(t0 + r) * EVN + 2560 + hd * 128 + c16 * 8);
            *(uint4*)(fk + ((size_t)bh * S_ + st * 64 + r) * 128 + c16 * 8) = fx_knorm(kv, p.ev_knorm_g + c16 * 8); }
#pragma unroll
        for (int i = 0; i < 2; ++i) { const int id = tix_ + i * NT, r = id >> 4, c16 = id & 15;
            const uint4 v = *(const uint4*)(proj + (size_t)(t0 + r) * EVN + 3072 + hd * 128 + c16 * 8);
            unsigned* d = (unsigned*)(tile + r * 130 + c16 * 8); d[0] = v.x; d[1] = v.y; d[2] = v.z; d[3] = v.w; }
        __syncthreads();
        { const int d = tix_ >> 2, qt = tix_ & 3; unsigned w[8];
#pragma unroll
            for (int i = 0; i < 8; ++i) w[i] = (unsigned)tile[(qt * 16 + 2 * i) * 130 + d] | ((unsigned)tile[(qt * 16 + 2 * i + 1) * 130 + d] << 16);
            uint4* dst = (uint4*)(vt + ((size_t)bh * 128 + d) * S_ + st * 64 + qt * 16);
            dst[0] = make_uint4(w[0], w[1], w[2], w[3]); dst[1] = make_uint4(w[4], w[5], w[6], w[7]); }
    }
    __syncthreads();
}
__device__ __forceinline__ void ph_cumsum(const int WV, CParams& p, unsigned char* smem) {
    const int tix_ = otid(WV);
    const int lane = tix_ & 63, w = tix_ >> 6, wv = (blockIdx.x * NT + tix_) >> 6, nw = gridDim.x * (NT / 64);
    float* part = (float*)smem + w * 64;
    for (int bh = wv; bh < 64; bh += nw) {
        const int b = bh >> 2, h = bh & 3;
        float loc[32]; float run = 0.f;
#pragma unroll
        for (int i = 0; i < 32; ++i) { run += -softplus_fast(-(p.small[(size_t)(b * S_ + lane * 32 + i) * 16 + 8 + h] + p.ev_f_bias[h])); loc[i] = run; }
        asm volatile("s_waitcnt lgkmcnt(0)" ::: "memory");
        part[lane] = run;
        asm volatile("s_waitcnt lgkmcnt(0)" ::: "memory");
        float excl = 0.f;
        for (int i = 0; i < lane; ++i) excl += part[i];
#pragma unroll
        for (int i = 0; i < 32; ++i) p.cum[(size_t)(b * S_ + lane * 32 + i) * 4 + h] = loc[i] + excl;
    }
    __syncthreads();
}

typedef short fx_bf16x8 __attribute__((ext_vector_type(8)));
typedef float fx_f32x16 __attribute__((ext_vector_type(16)));
typedef float fx_f32x4 __attribute__((ext_vector_type(4)));
__device__ __forceinline__ unsigned fx_pk(float lo, float hi) { return pk_bf16(lo, hi); }
__device__ __forceinline__ void ph_fox_flash(const int WV, CParams& p, const bf16_t* __restrict__ proj, const bf16_t* __restrict__ fk, const bf16_t* __restrict__ vt, bf16_t* __restrict__ omix, unsigned char* smem) {
    const int tid = otid(WV), lane = tid & 63, w = tid >> 6, c = lane & 31, h5 = lane >> 5;
    constexpr int KB = 16384, VB = 128 * 136, OFF_V = 2 * KB, OFF_B = OFF_V + 2 * VB, OFF_I = OFF_B + 2 * 256;
    constexpr float C2 = 0.08838834764831845f * 1.4426950408889634f, NEG_INV_SCALE = -11.313708498984761f;
    int* itemw = (int*)(smem + OFF_I);
    for (;;) {
        __syncthreads();
        if (tid == 0) itemw[0] = atomicAdd(p.cnt + 32, 1);
        __syncthreads();
        const int idx = itemw[0];
        if (idx >= 512) break;
        const int qb = 7 - (idx >> 6), bh = idx & 63, b = bh >> 2, hd = bh & 3;
        const int q0 = qb * 256 + w * 32, ntiles = 4 * (qb + 1);
        fx_bf16x8 qf[8];
        { const bf16_t* qp = proj + ((size_t)(b * S_ + q0 + c)) * EVN + 2048 + hd * 128 + 8 * h5;
          float ssq = 0.f;
#pragma unroll
          for (int s = 0; s < 8; ++s) { qf[s] = *(const fx_bf16x8*)(qp + 16 * s);
#pragma unroll
              for (int j = 0; j < 8; ++j) { const float v = bf2f((bf16_t)qf[s][j]); ssq += v * v; } }
          { auto rr = __builtin_amdgcn_permlane32_swap(__float_as_uint(ssq), __float_as_uint(ssq), false, false); ssq = __uint_as_float(rr[0]) + __uint_as_float(rr[1]); }
          const float rq = rsqrtf(ssq * (1.f / 128.f) + 1e-6f);
#pragma unroll
          for (int s = 0; s < 8; ++s) { const float4 g0 = *(const float4*)(p.ev_qnorm_g + 16 * s + 8 * h5), g1 = *(const float4*)(p.ev_qnorm_g + 16 * s + 8 * h5 + 4);
              union { fx_bf16x8 v; unsigned u[4]; } t;
              t.u[0] = pk_bf16(bf2f((bf16_t)qf[s][0]) * rq * g0.x, bf2f((bf16_t)qf[s][1]) * rq * g0.y); t.u[1] = pk_bf16(bf2f((bf16_t)qf[s][2]) * rq * g0.z, bf2f((bf16_t)qf[s][3]) * rq * g0.w);
              t.u[2] = pk_bf16(bf2f((bf16_t)qf[s][4]) * rq * g1.x, bf2f((bf16_t)qf[s][5]) * rq * g1.y); t.u[3] = pk_bf16(bf2f((bf16_t)qf[s][6]) * rq * g1.z, bf2f((bf16_t)qf[s][7]) * rq * g1.w);
              qf[s] = t.v; } }
        fx_f32x16 o[4];
#pragma unroll
        for (int mb = 0; mb < 4; ++mb)
#pragma unroll
            for (int r = 0; r < 16; ++r) o[mb][r] = 0.f;
        float m = -1e30f, l = 0.f;
        const float ct2 = p.cum[(size_t)(b * S_ + q0 + c) * 4 + hd] * 1.4426950408889634f;
        const bf16_t* kg = fk + (size_t)bh * S_ * 128;
        const bf16_t* vg = vt + (size_t)bh * 128 * S_;
        uint4 kr0, kr1, vr0, vr1; float br = 0.f;
        const int idA = tid, idB = tid + NT;
        kr0 = *(const uint4*)(kg + (size_t)(idA >> 4) * 128 + (idA & 15) * 8); kr1 = *(const uint4*)(kg + (size_t)(idB >> 4) * 128 + (idB & 15) * 8);
        vr0 = *(const uint4*)(vg + (size_t)(idA >> 3) * S_ + (idA & 7) * 8); vr1 = *(const uint4*)(vg + (size_t)(idB >> 3) * S_ + (idB & 7) * 8);
        if (tid < 64) br = p.cum[(size_t)(b * S_ + tid) * 4 + hd] * NEG_INV_SCALE;
        { const int rA = idA >> 4, chA = idA & 15, rB = idB >> 4, chB = idB & 15;
          *(uint4*)(smem + rA * 256 + ((chA ^ (rA & 15)) << 4)) = kr0; *(uint4*)(smem + rB * 256 + ((chB ^ (rB & 15)) << 4)) = kr1;
          uint2* vd = (uint2*)(smem + OFF_V + (idA >> 3) * 136 + (idA & 7) * 16); vd[0] = make_uint2(vr0.x, vr0.y); vd[1] = make_uint2(vr0.z, vr0.w);
          vd = (uint2*)(smem + OFF_V + (idB >> 3) * 136 + (idB & 7) * 16); vd[0] = make_uint2(vr1.x, vr1.y); vd[1] = make_uint2(vr1.z, vr1.w); }
        if (tid < 64) ((float*)(smem + OFF_B))[tid] = br;
        __syncthreads();
        for (int t = 0; t < ntiles; ++t) {
            const int cur = t & 1;
            if (t + 1 < ntiles) {
                const int k0 = (t + 1) * 64;
                kr0 = *(const uint4*)(kg + (size_t)(k0 + (idA >> 4)) * 128 + (idA & 15) * 8); kr1 = *(const uint4*)(kg + (size_t)(k0 + (idB >> 4)) * 128 + (idB & 15) * 8);
                vr0 = *(const uint4*)(vg + (size_t)(idA >> 3) * S_ + k0 + (idA & 7) * 8); vr1 = *(const uint4*)(vg + (size_t)(idB >> 3) * S_ + k0 + (idB & 7) * 8);
                if (tid < 64) br = p.cum[(size_t)(b * S_ + k0 + tid) * 4 + hd] * NEG_INV_SCALE;
            }
            const int kbase = t * 64;
            if (kbase <= q0) {
                const unsigned char* Kt = smem + cur * KB; const unsigned char* Vt = smem + OFF_V + cur * VB; const float* Bt = (const float*)(smem + OFF_B + cur * 256);
                const bool two = (kbase + 32 <= q0);
                fx_f32x16 sA, sB;
#pragma unroll
                for (int g = 0; g < 4; ++g) { const fx_f32x4 bv = *(const fx_f32x4*)(Bt + 8 * g + 4 * h5);
                    sA[4 * g] = bv[0]; sA[4 * g + 1] = bv[1]; sA[4 * g + 2] = bv[2]; sA[4 * g + 3] = bv[3]; }
#pragma unroll
                for (int s = 0; s < 8; ++s) { const fx_bf16x8 ka = *(const fx_bf16x8*)(Kt + c * 256 + (((2 * s + h5) ^ (c & 15)) << 4));
                    sA = __builtin_amdgcn_mfma_f32_32x32x16_bf16(ka, qf[s], sA, 0, 0, 0); }
                if (two) {
#pragma unroll
                    for (int g = 0; g < 4; ++g) { const fx_f32x4 bv = *(const fx_f32x4*)(Bt + 32 + 8 * g + 4 * h5);
                        sB[4 * g] = bv[0]; sB[4 * g + 1] = bv[1]; sB[4 * g + 2] = bv[2]; sB[4 * g + 3] = bv[3]; }
#pragma unroll
                    for (int s = 0; s < 8; ++s) { const fx_bf16x8 ka = *(const fx_bf16x8*)(Kt + (32 + c) * 256 + (((2 * s + h5) ^ (c & 15)) << 4));
                        sB = __builtin_amdgcn_mfma_f32_32x32x16_bf16(ka, qf[s], sB, 0, 0, 0); }
                } else {
#pragma unroll
                    for (int r = 0; r < 16; ++r) sB[r] = -__builtin_inff();
                }
                if (kbase + 31 > q0) { const int d0 = kbase - q0 + 4 * h5 - c;
#pragma unroll
                    for (int r = 0; r < 16; ++r) if (d0 + (r & 3) + 8 * (r >> 2) > 0) sA[r] = -__builtin_inff(); }
                if (two && kbase + 63 > q0) { const int d0 = kbase + 32 - q0 + 4 * h5 - c;
#pragma unroll
                    for (int r = 0; r < 16; ++r) if (d0 + (r & 3) + 8 * (r >> 2) > 0) sB[r] = -__builtin_inff(); }
                float mx = sA[0];
#pragma unroll
                for (int r = 1; r < 16; ++r) mx = fmaxf(mx, sA[r]);
#pragma unroll
                for (int r = 0; r < 16; ++r) mx = fmaxf(mx, sB[r]);
                { auto rr = __builtin_amdgcn_permlane32_swap(__float_as_uint(mx), __float_as_uint(mx), false, false); mx = fmaxf(__uint_as_float(rr[0]), __uint_as_float(rr[1])); }
                const float mc = fmaf(mx, C2, ct2);
                if (!__all(mc - m <= 8.f)) {
                    const float mn = fmaxf(m, mc); const float alpha = __builtin_amdgcn_exp2f(m - mn); m = mn; l *= alpha;
#pragma unroll
                    for (int mb = 0; mb < 4; ++mb)
#pragma unroll
                        for (int r = 0; r < 16; ++r) o[mb][r] *= alpha;
                }
                const float dm = ct2 - m;
                float ps = 0.f;
#pragma unroll
                for (int r = 0; r < 16; ++r) { sA[r] = __builtin_amdgcn_exp2f(fmaf(sA[r], C2, dm)); ps += sA[r]; }
#pragma unroll
                for (int r = 0; r < 16; ++r) { sB[r] = __builtin_amdgcn_exp2f(fmaf(sB[r], C2, dm)); ps += sB[r]; }
                l += ps;
#pragma unroll
                for (int s2 = 0; s2 < 2; ++s2) {
                    union { fx_bf16x8 v; unsigned u[4]; } pb;
#pragma unroll
                    for (int j = 0; j < 4; ++j) pb.u[j] = fx_pk(sA[8 * s2 + 2 * j], sA[8 * s2 + 2 * j + 1]);
#pragma unroll
                    for (int mb = 0; mb < 4; ++mb) { const unsigned char* vp = Vt + (mb * 32 + c) * 136 + (16 * s2 + 4 * h5) * 2;
                        union { fx_bf16x8 v; uint2 q[2]; } va; va.q[0] = *(const uint2*)vp; va.q[1] = *(const uint2*)(vp + 16);
                        o[mb] = __builtin_amdgcn_mfma_f32_32x32x16_bf16(va.v, pb.v, o[mb], 0, 0, 0); }
                }
                if (two) {
#pragma unroll
                    for (int s2 = 0; s2 < 2; ++s2) {
                        union { fx_bf16x8 v; unsigned u[4]; } pb;
#pragma unroll
                        for (int j = 0; j < 4; ++j) pb.u[j] = fx_pk(sB[8 * s2 + 2 * j], sB[8 * s2 + 2 * j + 1]);
#pragma unroll
                        for (int mb = 0; mb < 4; ++mb) { const unsigned char* vp = Vt + (mb * 32 + c) * 136 + (32 + 16 * s2 + 4 * h5) * 2;
                            union { fx_bf16x8 v; uint2 q[2]; } va; va.q[0] = *(const uint2*)vp; va.q[1] = *(const uint2*)(vp + 16);
                            o[mb] = __builtin_amdgcn_mfma_f32_32x32x16_bf16(va.v, pb.v, o[mb], 0, 0, 0); }
                    }
                }
            }
            if (t + 1 < ntiles) {
                const int nb = cur ^ 1; const int rA = idA >> 4, chA = idA & 15, rB = idB >> 4, chB = idB & 15;
                *(uint4*)(smem + nb * KB + rA * 256 + ((chA ^ (rA & 15)) << 4)) = kr0; *(uint4*)(smem + nb * KB + rB * 256 + ((chB ^ (rB & 15)) << 4)) = kr1;
                uint2* vd = (uint2*)(smem + OFF_V + nb * VB + (idA >> 3) * 136 + (idA & 7) * 16); vd[0] = make_uint2(vr0.x, vr0.y); vd[1] = make_uint2(vr0.z, vr0.w);
                vd = (uint2*)(smem + OFF_V + nb * VB + (idB >> 3) * 136 + (idB & 7) * 16); vd[0] = make_uint2(vr1.x, vr1.y); vd[1] = make_uint2(vr1.z, vr1.w);
                if (tid < 64) ((float*)(smem + OFF_B + nb * 256))[tid] = br;
            }
            __syncthreads();
        }
        { auto rr = __builtin_amdgcn_permlane32_swap(__float_as_uint(l), __float_as_uint(l), false, false); l = __uint_as_float(rr[0]) + __uint_as_float(rr[1]); }
        const float inv = 1.f / l;
        bf16_t* op = omix + (size_t)(b * S_ + q0 + c) * 1024 + 512 + hd * 128 + 4 * h5;
#pragma unroll
        for (int mb = 0; mb < 4; ++mb)
#pragma unroll
            for (int g = 0; g < 4; ++g) { uint2 ov; ov.x = fx_pk(o[mb][4 * g] * inv, o[mb][4 * g + 1] * inv); ov.y = fx_pk(o[mb][4 * g + 2] * inv, o[mb][4 * g + 3] * inv);
                *(uint2*)(op + mb * 32 + 8 * g) = ov; }
    }
}

__device__ __forceinline__ void ph_route(const int WV, CParams& p, const bf16_t* __restrict__ x, const float* __restrict__ g, const float* __restrict__ sc, const float* __restrict__ sh, bf16_t* __restrict__ h2, unsigned char* smem) {
    const int tix_ = otid(WV);
    const int lane = tix_ & 63, w = tix_ >> 6, c = lane & 15, g4 = lane >> 4;
    constexpr int RP = 1032;
    bf16_t* Rhi = (bf16_t*)smem;
    bf16_t* Rlo = Rhi + 16 * RP;
    float* mv = (float*)(smem + 2 * 16 * RP * 2);
    float* sv = mv + 1024;
    float* lgs = sv + 1024;
    int* selE = (int*)(lgs + 128 * 16);
    float* selW = (float*)(selE + 128);
    int* lcnt = (int*)(selW + 256);
    int* lbase = lcnt + 16;
    __syncthreads();
    for (int i = tix_; i < 16384; i += NT) { const int k = i >> 4, e = i & 15; const float r = p.router_w[i]; const bf16_t hi = f2bf(r); Rhi[e * RP + k] = hi; Rlo[e * RP + k] = f2bf(r - bf2f(hi)); }
    for (int chunk = blockIdx.x; chunk < T_ / 128; chunk += gridDim.x) {
        const int b = (chunk * 128) >> 11;
        __syncthreads();
        for (int k = tix_; k < 1024; k += NT) { mv[k] = g[k] * (1.f + sc[b * 6144 + k]); sv[k] = sh[b * 6144 + k]; }
        if (tix_ < 16) lcnt[tix_] = 0;
        __syncthreads();
        const int t = chunk * 128 + w * 16 + c;
        const bf16_t* xr = x + (size_t)t * 1024 + 8 * g4;
        float ss = 0.f;
#pragma unroll 8
        for (int s = 0; s < 32; ++s) { const uint4 xw = *(const uint4*)(xr + 32 * s); const unsigned u[4] = {xw.x, xw.y, xw.z, xw.w};
#pragma unroll
            for (int q = 0; q < 4; ++q) { const float a = __uint_as_float(u[q] << 16), bq = __uint_as_float(u[q] & 0xffff0000u); ss += a * a + bq * bq; } }
        { auto r = __builtin_amdgcn_permlane16_swap(__float_as_uint(ss), __float_as_uint(ss), false, false); ss = __uint_as_float(r[0]) + __uint_as_float(r[1]); }
        { auto r = __builtin_amdgcn_permlane32_swap(__float_as_uint(ss), __float_as_uint(ss), false, false); ss = __uint_as_float(r[0]) + __uint_as_float(r[1]); }
        const float rstd = rsqrtf(ss * (1.f / 1024.f) + 1e-6f);
        dn_f32x4 acc = {0.f, 0.f, 0.f, 0.f};
#pragma unroll 4
        for (int s = 0; s < 32; ++s) {
            const int k0 = 32 * s + 8 * g4;
            const uint4 xw = *(const uint4*)(xr + 32 * s); const unsigned u[4] = {xw.x, xw.y, xw.z, xw.w};
            const float4 m0 = *(const float4*)(mv + k0), m1 = *(const float4*)(mv + k0 + 4), s0 = *(const float4*)(sv + k0), s1 = *(const float4*)(sv + k0 + 4);
            float hv[8];
            hv[0] = __uint_as_float(u[0] << 16) * rstd * m0.x + s0.x; hv[1] = __uint_as_float(u[0] & 0xffff0000u) * rstd * m0.y + s0.y;
            hv[2] = __uint_as_float(u[1] << 16) * rstd * m0.z + s0.z; hv[3] = __uint_as_float(u[1] & 0xffff0000u) * rstd * m0.w + s0.w;
            hv[4] = __uint_as_float(u[2] << 16) * rstd * m1.x + s1.x; hv[5] = __uint_as_float(u[2] & 0xffff0000u) * rstd * m1.y + s1.y;
            hv[6] = __uint_as_float(u[3] << 16) * rstd * m1.z + s1.z; hv[7] = __uint_as_float(u[3] & 0xffff0000u) * rstd * m1.w + s1.w;
            union { dn_bf16x8 v; unsigned q[4]; uint4 w4; } ahi, alo;
#pragma unroll
            for (int q = 0; q < 4; ++q) { ahi.q[q] = pk_bf16(hv[2 * q], hv[2 * q + 1]);
                alo.q[q] = pk_bf16(hv[2 * q] - __uint_as_float(ahi.q[q] << 16), hv[2 * q + 1] - __uint_as_float(ahi.q[q] & 0xffff0000u)); }
            *(uint4*)(h2 + (size_t)t * 1024 + k0) = ahi.w4;
            const dn_bf16x8 bhi = *(const dn_bf16x8*)(Rhi + c * RP + k0), blo = *(const dn_bf16x8*)(Rlo + c * RP + k0);
            acc = dn_mfma(ahi.v, bhi, acc); acc = dn_mfma(ahi.v, blo, acc); acc = dn_mfma(alo.v, bhi, acc);
        }
#pragma unroll
        for (int r = 0; r < 4; ++r) lgs[(w * 16 + 4 * g4 + r) * 16 + c] = acc[r];
        asm volatile("s_waitcnt lgkmcnt(0)" ::: "memory");
        if (lane < 16) {
            const int kt = lane; float lgv[16];
#pragma unroll
            for (int q = 0; q < 4; ++q) { const float4 v = *(const float4*)(lgs + (w * 16 + kt) * 16 + 4 * q); lgv[4 * q] = v.x; lgv[4 * q + 1] = v.y; lgv[4 * q + 2] = v.z; lgv[4 * q + 3] = v.w; }
            float mx = lgv[0];
#pragma unroll
            for (int e = 1; e < 16; ++e) mx = fmaxf(mx, lgv[e]);
            float pr[16]; float den = 0.f;
#pragma unroll
            for (int e = 0; e < 16; ++e) { pr[e] = __expf(lgv[e] - mx); den += pr[e]; }
            const float inv = 1.f / den;
            float sel[16];
#pragma unroll
            for (int e = 0; e < 16; ++e) { pr[e] *= inv; sel[e] = pr[e] + p.router_b[e]; }
            int bg = 0; float bgs = -1e30f;
#pragma unroll
            for (int gi = 0; gi < 4; ++gi) { float m1 = -1e30f, m2 = -1e30f;
#pragma unroll
                for (int q = 0; q < 4; ++q) { const float sv2 = sel[gi * 4 + q]; if (sv2 > m1) { m2 = m1; m1 = sv2; } else if (sv2 > m2) m2 = sv2; }
                const float gs = m1 + m2; if (gs > bgs) { bgs = gs; bg = gi; } }
            int e1 = 0, e2 = 0; float s1 = -1e30f, s2 = -1e30f, p1 = 0.f, p2 = 0.f;
#pragma unroll
            for (int gi = 0; gi < 4; ++gi) if (gi == bg) {
#pragma unroll
                for (int q = 0; q < 4; ++q) { const float sv2 = sel[gi * 4 + q], pv = pr[gi * 4 + q];
                    if (sv2 > s1) { s2 = s1; e2 = e1; p2 = p1; s1 = sv2; e1 = gi * 4 + q; p1 = pv; } else if (sv2 > s2) { s2 = sv2; e2 = gi * 4 + q; p2 = pv; } } }
            const float wn = 1.f / (p1 + p2);
            selE[w * 16 + kt] = e1 | (e2 << 8); selW[2 * (w * 16 + kt)] = p1 * wn; selW[2 * (w * 16 + kt) + 1] = p2 * wn;
        }
        __syncthreads();
        int myE = 0, myR = 0;
        if (tix_ < 256) { const int ee = selE[tix_ >> 1]; myE = (tix_ & 1) ? (ee >> 8) : (ee & 255); myR = atomicAdd(&lcnt[myE], 1); }
        __syncthreads();
        if (tix_ < 16) lbase[tix_] = atomicAdd(&p.cnt[tix_], lcnt[tix_]);
        __syncthreads();
        if (tix_ < 256) { const int pair = chunk * 256 + tix_; p.list[myE * T_ + lbase[myE] + myR] = pair; p.gw[pair] = selW[tix_]; }
    }
    __syncthreads();
}

__device__ __forceinline__ void ph_lru(const int WV, CParams& p, const bf16_t* __restrict__ proj2, bf16_t* __restrict__ omix, unsigned char* smem) {
    const int tid = otid(WV), lane = tid & 63, w = tid >> 6, c = lane & 15, g4 = lane >> 4;
    bf16_t* xcs = (bf16_t*)smem;
    float* As = (float*)(smem + 34816);
    float* Bs = As + 128 * 33;
    float* segA = Bs + 128 * 33;
    float* segB = segA + 512;
    float* cin = segB + 512;
    for (int item = blockIdx.x; item < 256; item += gridDim.x) {
        const int b = item >> 4, hb = (item >> 2) & 3, q = item & 3;
        dn_bf16x8 wrf[2][4], wif[2][4];
#pragma unroll
        for (int nb = 0; nb < 2; ++nb)
#pragma unroll
            for (int ks = 0; ks < 4; ++ks) { const size_t o = ((size_t)hb * 128 + q * 32 + 16 * nb + c) * 128 + 32 * ks + 8 * g4;
                wrf[nb][ks] = *(const dn_bf16x8*)(p.W_lr + o); wif[nb][ks] = *(const dn_bf16x8*)(p.W_li + o); }
        float brj[2], bij[2], spn[2];
#pragma unroll
        for (int nb = 0; nb < 2; ++nb) { const int ch = hb * 128 + q * 32 + 16 * nb + c; brj[nb] = p.od_br[ch]; bij[nb] = p.od_bi[ch]; spn[nb] = -8.f * softplusf_(-p.od_lam[ch]); }
        const int cp = tid & 63, rg = tid >> 6, cch = hb * 128 + cp * 2;
        const float wa0 = p.od_conv_w[cch], wa1 = p.od_conv_w[512 + cch], wa2 = p.od_conv_w[1024 + cch], wa3 = p.od_conv_w[1536 + cch], ba = p.od_conv_b[cch];
        const float wb0 = p.od_conv_w[cch + 1], wb1 = p.od_conv_w[512 + cch + 1], wb2 = p.od_conv_w[1024 + cch + 1], wb3 = p.od_conv_w[1536 + cch + 1], bb2 = p.od_conv_b[cch + 1];
        float h_in = 0.f;
        unsigned raw[19];
        { const bf16_t* src = proj2 + (size_t)(b * S_ + rg * 16) * 2048 + cch;
#pragma unroll
          for (int r = 0; r < 19; ++r) raw[r] = (rg == 0 && r < 3) ? 0u : *(const unsigned*)(src + (ptrdiff_t)(r - 3) * 2048); }
        for (int ti = 0; ti < 16; ++ti) {
            const int t0 = b * S_ + ti * 128;
            {
                float a0 = __uint_as_float(raw[0] << 16), b0 = __uint_as_float(raw[0] & 0xffff0000u), a1 = __uint_as_float(raw[1] << 16), b1 = __uint_as_float(raw[1] & 0xffff0000u), a2 = __uint_as_float(raw[2] << 16), b2 = __uint_as_float(raw[2] & 0xffff0000u);
                if (ti == 0 && rg == 0) { a0 = a1 = a2 = b0 = b1 = b2 = 0.f; }
#pragma unroll
                for (int r = 0; r < 16; ++r) { const unsigned pv = raw[3 + r];
                    const float a3 = __uint_as_float(pv << 16), b3 = __uint_as_float(pv & 0xffff0000u);
                    *(unsigned*)(xcs + (rg * 16 + r) * 136 + cp * 2) = pk_bf16(ba + wa0 * a0 + wa1 * a1 + wa2 * a2 + wa3 * a3, bb2 + wb0 * b0 + wb1 * b1 + wb2 * b2 + wb3 * b3);
                    a0 = a1; a1 = a2; a2 = a3; b0 = b1; b1 = b2; b2 = b3; }
                if (ti + 1 < 16) { const bf16_t* src = proj2 + (size_t)(t0 + 128 + rg * 16) * 2048 + cch;
#pragma unroll
                    for (int r = 0; r < 19; ++r) raw[r] = *(const unsigned*)(src + (ptrdiff_t)(r - 3) * 2048); }
            }
            __syncthreads();
            {
                dn_bf16x8 af[4];
#pragma unroll
                for (int ks = 0; ks < 4; ++ks) af[ks] = *(const dn_bf16x8*)(xcs + (16 * w + c) * 136 + 32 * ks + 8 * g4);
#pragma unroll
                for (int nb = 0; nb < 2; ++nb) { dn_f32x4 ar = {0.f, 0.f, 0.f, 0.f}, ai = {0.f, 0.f, 0.f, 0.f};
#pragma unroll
                    for (int ks = 0; ks < 4; ++ks) { ar = dn_mfma(af[ks], wrf[nb][ks], ar); ai = dn_mfma(af[ks], wif[nb][ks], ai); }
#pragma unroll
                    for (int r = 0; r < 4; ++r) { const int t = 16 * w + 4 * g4 + r, jl = 16 * nb + c;
                        const float rr = sigm(ar[r] + brj[nb]), ig = sigm(ai[r] + bij[nb]);
                        const float log_a = spn[nb] * rr, av = __expf(log_a), x = bf2f(xcs[t * 136 + q * 32 + jl]);
                        As[t * 33 + jl] = av; Bs[t * 33 + jl] = sqrtf(fmaxf(0.f, (1.f - av) * (1.f + av))) * ig * x; } }
            }
            __syncthreads();
            const int j = tid & 31, seg = tid >> 5;
            { float A = 1.f, Bc = 0.f;
#pragma unroll
                for (int k = 0; k < 8; ++k) { const float av = As[(8 * seg + k) * 33 + j], bv = Bs[(8 * seg + k) * 33 + j]; A = av * A; Bc = av * Bc + bv; }
                segA[seg * 32 + j] = A; segB[seg * 32 + j] = Bc; }
            __syncthreads();
            if (tid < 32) { float sa[16], sb[16];
#pragma unroll
                for (int sg = 0; sg < 16; ++sg) { sa[sg] = segA[sg * 32 + tid]; sb[sg] = segB[sg * 32 + tid]; }
                float h = h_in;
#pragma unroll
                for (int sg = 0; sg < 16; ++sg) { cin[sg * 32 + tid] = h; h = sa[sg] * h + sb[sg]; }
                h_in = h; }
            __syncthreads();
            { float h = cin[seg * 32 + j]; const int cg = hb * 128 + q * 32 + j;
#pragma unroll
                for (int k = 0; k < 8; ++k) { const int t = 8 * seg + k; h = As[t * 33 + j] * h + Bs[t * 33 + j];
                    omix[(size_t)(t0 + t) * 1024 + cg] = f2bf(h * bf2f(proj2[(size_t)(t0 + t) * 2048 + 512 + cg])); } }
        }
        __syncthreads();
    }
}
typedef unsigned short sg_u16x4 __attribute__((ext_vector_type(4)));
__device__ __forceinline__ unsigned sgu_off(unsigned row, unsigned ch) { return 256u * row + 16u * (ch ^ (((row & 3u) << 2) | ((row >> 2) & 3u))); }
__device__ __forceinline__ void ph_sgu(const int WV, CParams& p, const bf16_t* __restrict__ proj2, bf16_t* __restrict__ omix, unsigned char* smem) {
    const int tid = otid(WV), lane = tid & 63, w = tid >> 6, c = lane & 15, g4 = lane >> 4;
    float* rstd = (float*)(smem + 32768);
    const unsigned ldsb = (unsigned)(size_t)(PG8_LAS unsigned char*)smem;
    const unsigned q4 = (unsigned)(lane & 15) >> 2, p4 = (unsigned)lane & 3u;
    for (int item = blockIdx.x; item < 256; item += gridDim.x) {
        const int t0 = item * 128;
        __syncthreads();
#pragma unroll 4
        for (int rr = 0; rr < 16; ++rr) { const int sI = 16 * w + rr; const uint4 v = *(const uint4*)(proj2 + (size_t)(t0 + sI) * 2048 + 1536 + lane * 8);
            const unsigned u[4] = {v.x, v.y, v.z, v.w}; float ss = 0.f;
#pragma unroll
            for (int k = 0; k < 4; ++k) { const float x0 = __uint_as_float(u[k] << 16), x1 = __uint_as_float(u[k] & 0xffff0000u); ss += x0 * x0 + x1 * x1; }
            ss = wave_sum(ss);
            if (lane == 0) rstd[sI] = rsqrtf(ss * (1.f / 512.f) + 1e-6f); }
        __syncthreads();
        for (int g = 0; g < 4; ++g) {
#pragma unroll
            for (int i = 0; i < 4; ++i) { const int id = tid + i * NT, sI = id >> 4, c16 = id & 15;
                const uint4 v = *(const uint4*)(proj2 + (size_t)(t0 + sI) * 2048 + 1536 + g * 128 + c16 * 8);
                const float rs = rstd[sI]; const float4 g0 = *(const float4*)(p.od_sgu_g + g * 128 + c16 * 8), g1 = *(const float4*)(p.od_sgu_g + g * 128 + c16 * 8 + 4);
                uint4 o;
                o.x = pk_bf16(__uint_as_float(v.x << 16) * rs * g0.x, __uint_as_float(v.x & 0xffff0000u) * rs * g0.y); o.y = pk_bf16(__uint_as_float(v.y << 16) * rs * g0.z, __uint_as_float(v.y & 0xffff0000u) * rs * g0.w);
                o.z = pk_bf16(__uint_as_float(v.z << 16) * rs * g1.x, __uint_as_float(v.z & 0xffff0000u) * rs * g1.y); o.w = pk_bf16(__uint_as_float(v.w << 16) * rs * g1.z, __uint_as_float(v.w & 0xffff0000u) * rs * g1.w);
                *(uint4*)(smem + sgu_off((unsigned)sI, (unsigned)c16)) = o; }
            __syncthreads();
            {
                const int nks = (16 * w + 15) / 32 + 1, t = 16 * w + c;
                dn_bf16x8 wf[4];
#pragma unroll
                for (int ks = 0; ks < 4; ++ks) wf[ks] = *(const dn_bf16x8*)(p.W_sgu + ((size_t)(g * 128 + t)) * 128 + 32 * ks + 8 * g4);
                const float bias = p.od_sgu_b[g * 128 + t];
#pragma unroll
                for (int db = 0; db < 8; ++db) {
                    union { dn_bf16x8 v; sg_u16x4 h[2]; } va[4];
                    {
                        unsigned ad[8];
#pragma unroll
                        for (int ks = 0; ks < 4; ++ks)
#pragma unroll
                            for (int tt = 0; tt < 2; ++tt) ad[2 * ks + tt] = ldsb + sgu_off(32u * ks + 8u * (unsigned)g4 + 4u * tt + q4, 2u * db + (p4 >> 1)) + 8u * (p4 & 1u);
                        asm volatile("ds_read_b64_tr_b16 %0, %8\n\tds_read_b64_tr_b16 %1, %9\n\tds_read_b64_tr_b16 %2, %10\n\tds_read_b64_tr_b16 %3, %11\n\t"
                                     "ds_read_b64_tr_b16 %4, %12\n\tds_read_b64_tr_b16 %5, %13\n\tds_read_b64_tr_b16 %6, %14\n\tds_read_b64_tr_b16 %7, %15\n\ts_waitcnt lgkmcnt(0)"
                                     : "=&v"(va[0].h[0]), "=&v"(va[0].h[1]), "=&v"(va[1].h[0]), "=&v"(va[1].h[1]), "=&v"(va[2].h[0]), "=&v"(va[2].h[1]), "=&v"(va[3].h[0]), "=&v"(va[3].h[1])
                                     : "v"(ad[0]), "v"(ad[1]), "v"(ad[2]), "v"(ad[3]), "v"(ad[4]), "v"(ad[5]), "v"(ad[6]), "v"(ad[7]) : "memory");
                    }
                    dn_f32x4 acc = {0.f, 0.f, 0.f, 0.f};
#pragma unroll
                    for (int ks = 0; ks < 4; ++ks) if (ks < nks) acc = dn_mfma(va[ks].v, wf[ks], acc);
                    const size_t go = (size_t)(t0 + t);
                    const uint2 uu = *(const uint2*)(proj2 + go * 2048 + 1024 + g * 128 + 16 * db + 4 * g4);
                    uint2 o; o.x = pk_bf16(__uint_as_float(uu.x << 16) * (acc[0] + bias), __uint_as_float(uu.x & 0xffff0000u) * (acc[1] + bias));
                    o.y = pk_bf16(__uint_as_float(uu.y << 16) * (acc[2] + bias), __uint_as_float(uu.y & 0xffff0000u) * (acc[3] + bias));
                    *(uint2*)(omix + go * 1024 + 512 + g * 128 + 16 * db + 4 * g4) = o; }
            }
            __syncthreads();
        }
    }
}

namespace pg8 {
typedef short bf16x8 __attribute__((ext_vector_type(8)));
typedef float f32x4 __attribute__((ext_vector_type(4)));
typedef unsigned u32x4 __attribute__((ext_vector_type(4)));
typedef unsigned u32x2 __attribute__((ext_vector_type(2)));
constexpr int BM = 256, BK = 64, HALF = 128, HTB = HALF * BK * 2, STAGE_BYTES = 8 * HTB, NXCD = 8, WGM = 8;
__device__ __forceinline__ int lds_byte(int r, int c) { const int st = (r >> 4) * 2 + (c >> 5), rr = r & 15, cc = c & 31, ob = rr * 64 + cc * 2; return st * 1024 + (ob ^ (((ob >> 9) & 1) << 5)); }
__device__ __forceinline__ void stage_rc(int b, int& R, int& C) { const int st = b / 1024, sb = b % 1024, swz = sb ^ (((sb >> 9) & 1) << 5); R = (st >> 1) * 16 + swz / 64; C = (st & 1) * 32 + (swz % 64) / 2; }
__device__ __forceinline__ int perm32(int rho) { const int n = rho >> 4, i = rho & 15; return 8 * (i >> 2) + 4 * n + (i & 3); }
struct Unit { int pm, pn, e, nvalid, gt; };
struct Gemm { const bf16_t* A; const bf16_t* Bt; size_t wstride; int K; int pad_; };

struct StaticOrder {
    static constexpr bool GATHER = false; static constexpr int SHIFT = 0, SIG = 0;
    int nM, nN, nwg, G, c;
    __device__ __forceinline__ int rowid(const Unit&, int) const { return 0; }
    __device__ void init(int M, int N, int G_, int c_) { nM = M / BM; nN = N / BM; nwg = nM * nN; G = G_; c = c_; }
    __device__ bool next(int i, Unit& u) const {
        const long L = (long)i * G + c; if (L >= nwg) return false;
        int wgid = (int)L; { const int q = nwg / NXCD, r = nwg % NXCD, xcd = wgid % NXCD, off = wgid / NXCD; wgid = (xcd < r ? xcd * (q + 1) : r * (q + 1) + (xcd - r) * q) + off; }
        const int nig = WGM * nN, gid = wgid / nig, fm = gid * WGM, gsz = (nM - fm) < WGM ? (nM - fm) : WGM;
        u.pm = fm + ((wgid % nig) % gsz); u.pn = (wgid % nig) / gsz; u.e = 0; u.nvalid = 256; u.gt = 0; return true;
    }
};
template <int NN, int SHIFT_, int SIG_>
struct MoeOrder {
    static constexpr bool GATHER = true; static constexpr int SHIFT = SHIFT_, SIG = SIG_;
    const int* cnt; const int* list; int G, c; int cntv;
    int* flag; int rounds, extra;
    __device__ __forceinline__ int rowid(const Unit& u, int r) const { return list[u.e * T_ + u.pm * 256 + min(r, u.nvalid - 1)]; }
    __device__ bool next(int i, Unit& u) const {
        int L;
        if constexpr (SIG == 1) { if (i >= rounds) return false; L = i * G + c; }
        else if constexpr (SIG == 3) { if (i > 0 || c >= extra) return false; L = rounds * G + c; }
        else if constexpr (SIG == 2) L = (c < extra) ? (i + 2) * G + c - 2 * extra : (i == 0 ? c - extra : i * G + c - 2 * extra);
        else L = i * G + c;
        int rt = L / NN; u.pn = L % NN; u.gt = rt;
        int e = 0, cc = 0;
        for (; e < 16; ++e) { cc = __builtin_amdgcn_readlane(cntv, e); const int ntile = (cc + 255) >> 8; if (rt < ntile) break; rt -= ntile; }
        if (e == 16) return false;
        u.e = e; u.pm = rt; u.nvalid = min(256, cc - rt * 256);
        if constexpr (SIG == 2) {
            const int need = (2 * u.gt >= rounds * G ? 1 : 0) + (2 * u.gt + 1 >= rounds * G ? 1 : 0);
            if (need > 0) { while (__hip_atomic_load(flag + u.gt, __ATOMIC_RELAXED, __HIP_MEMORY_SCOPE_AGENT) < need) __builtin_amdgcn_s_sleep(2); __builtin_amdgcn_fence(__ATOMIC_ACQUIRE, "agent"); }
        }
        return true;
    }
};
__device__ __forceinline__ unsigned cvt_pk_bf16(float lo, float hi) { return pk_bf16(lo, hi); }

template <int KC, class Epi, class Sched>
__device__ __forceinline__ void gemm_phase(const int WV, PG8_LAS unsigned char* lds, const Gemm g, const Sched& S, const Epi& E) {
    const int tid = otid(WV), wid = __builtin_amdgcn_readfirstlane(tid >> 6), lane = tid & 63, wr = wid >> 2, wc = wid & 3, fr = lane & 15, fq = lane >> 4;
    constexpr int K = KC, nt = K / BK;
    unsigned voffB[2];
#pragma unroll
    for (int i = 0; i < 2; ++i) { int R, C; stage_rc(tid * 16 + i * 8192, R, C); const int Rb = Epi::PERM ? ((R & ~31) + perm32(R & 31)) : R; voffB[i] = (unsigned)(Rb * K + C) * 2u; }
    constexpr unsigned kstep = BK * 2, hstep = HALF * K * 2, tstep = 2 * hstep;
    const __amdgpu_buffer_rsrc_t rsA = __builtin_amdgcn_make_buffer_rsrc((void*)g.A, 0, 0x7fffffff, 0x00020000);
    const __amdgpu_buffer_rsrc_t rsB = __builtin_amdgcn_make_buffer_rsrc((void*)g.Bt, 0, 0x7fffffff, 0x00020000);
    const unsigned ldsw = (unsigned)wid * 1024u;
    const int aoff = lds_byte(wr * 64 + fr, fq * 8), boff = lds_byte(wc * 32 + fr, fq * 8);
#define PG8_SA(b, h) (((b) * 2 + (h)) * HTB)
#define PG8_SB(b, h) ((4 + (b) * 2 + (h)) * HTB)
#define PG8_STAGE(bufoff, rsrc, soff, voff) do { _Pragma("unroll") for (int _i = 0; _i < 2; ++_i) \
        __builtin_amdgcn_raw_ptr_buffer_load_lds(rsrc, (PG8_LAS unsigned*)(lds + (bufoff) + ldsw + _i * 8192), 16, (voff)[_i], (soff), 0, 0); } while (0)
#define PG8_LDA(dst, b, h) do { _Pragma("unroll") for (int m = 0; m < 4; ++m) _Pragma("unroll") for (int k = 0; k < 2; ++k) dst[m][k] = *(const PG8_LAS bf16x8*)(lds + PG8_SA(b, h) + aoff + m * 2048 + k * 1024); } while (0)
#define PG8_LDB(dst, b, h) do { _Pragma("unroll") for (int n = 0; n < 2; ++n) _Pragma("unroll") for (int k = 0; k < 2; ++k) dst[n][k] = *(const PG8_LAS bf16x8*)(lds + PG8_SB(b, h) + boff + n * 2048 + k * 1024); } while (0)
#define PG8_MMA(ai, bj, At, Bt) do { __builtin_amdgcn_s_setprio(1); _Pragma("unroll") for (int m = 0; m < 4; ++m) _Pragma("unroll") for (int n = 0; n < 2; ++n) _Pragma("unroll") for (int k = 0; k < 2; ++k) \
        acc[ai][bj][m][n] = __builtin_amdgcn_mfma_f32_16x16x32_bf16(Bt[n][k], At[m][k], acc[ai][bj][m][n], 0, 0, 0); __builtin_amdgcn_s_setprio(0); } while (0)
#define PG8_WAIT_V(n) asm volatile("s_waitcnt vmcnt(" #n ")" ::: "memory")
#define PG8_WAIT_L(n) asm volatile("s_waitcnt lgkmcnt(" #n ")" ::: "memory")
#define PG8_BAR __builtin_amdgcn_s_barrier()
#define PG8_SCHED __builtin_amdgcn_sched_barrier(0)
    Unit cur, nxt; int ui = 0;
    if (!S.next(0, cur)) return;
    f32x4 acc[2][2][4][2];
#pragma unroll
    for (int a = 0; a < 2; ++a)
#pragma unroll
        for (int b = 0; b < 2; ++b)
#pragma unroll
            for (int m = 0; m < 4; ++m)
#pragma unroll
                for (int n = 0; n < 2; ++n) acc[a][b][m][n] = (f32x4){0.f, 0.f, 0.f, 0.f};
    bf16x8 At[4][2], B0[2][2], B1[2][2];
    unsigned vA0[2], vA1[2];
    PG8_LAS int* rows = (PG8_LAS int*)(lds + STAGE_BYTES);
    if constexpr (Sched::GATHER) { if (tid < 256) rows[tid] = S.rowid(cur, tid); __syncthreads(); }
#pragma unroll
    for (int i = 0; i < 2; ++i) { int R, C; stage_rc(tid * 16 + i * 8192, R, C);
        const int r0 = Sched::GATHER ? (rows[R] >> Sched::SHIFT) : cur.pm * BM + R, r1 = Sched::GATHER ? (rows[HALF + R] >> Sched::SHIFT) : cur.pm * BM + HALF + R;
        vA0[i] = ((unsigned)r0 * (unsigned)K + (unsigned)C) * 2u; vA1[i] = ((unsigned)r1 * (unsigned)K + (unsigned)C) * 2u; }
    unsigned cB = (unsigned)cur.e * (unsigned)(g.wstride * 2) + (unsigned)cur.pn * tstep;
    PG8_STAGE(PG8_SB(0, 0), rsB, cB, voffB); PG8_STAGE(PG8_SA(0, 0), rsA, 0u, vA0); PG8_STAGE(PG8_SB(0, 1), rsB, cB + hstep, voffB); PG8_STAGE(PG8_SA(0, 1), rsA, 0u, vA1);
    if (wr == 1) PG8_BAR;
    PG8_WAIT_V(4); PG8_BAR;
    PG8_STAGE(PG8_SB(1, 0), rsB, cB + kstep, voffB); PG8_STAGE(PG8_SA(1, 0), rsA, kstep, vA0); PG8_STAGE(PG8_SB(1, 1), rsB, cB + hstep + kstep, voffB);
    PG8_WAIT_V(6); PG8_BAR;
    for (;;) {
        const bool has_next = S.next(ui + 1, nxt);
        if constexpr (Sched::GATHER) { if (has_next) { const int t3 = otid(WV); if (t3 < 256) rows[((ui + 1) % 3) * 256 + t3] = S.rowid(nxt, t3); } }
        const unsigned nB = has_next ? (unsigned)nxt.e * (unsigned)(g.wstride * 2) + (unsigned)nxt.pn * tstep : cB;
        for (int t = 0; t < nt; t += 2) {
            const bool last = (t == nt - 2);
            const unsigned a1 = (unsigned)(t + 1) * kstep;
            const unsigned a2 = last ? 0u : (unsigned)(t + 2) * kstep, b2 = last ? nB : cB + (unsigned)(t + 2) * kstep;
            const unsigned a3 = a2 + kstep, b3 = b2 + kstep;
            PG8_LDB(B0, 0, 0); PG8_SCHED; PG8_LDA(At, 0, 0); PG8_STAGE(PG8_SA(1, 1), rsA, a1, vA1);
            if (last && has_next) {
                const int t3 = otid(WV); PG8_LAS const int* rn = rows + ((ui + 1) % 3) * 256;
#pragma unroll
                for (int i = 0; i < 2; ++i) { int R, C; stage_rc(t3 * 16 + i * 8192, R, C);
                    const int r0 = Sched::GATHER ? (rn[R] >> Sched::SHIFT) : nxt.pm * BM + R, r1 = Sched::GATHER ? (rn[HALF + R] >> Sched::SHIFT) : nxt.pm * BM + HALF + R;
                    vA0[i] = ((unsigned)r0 * (unsigned)K + (unsigned)C) * 2u; vA1[i] = ((unsigned)r1 * (unsigned)K + (unsigned)C) * 2u; }
            }
            PG8_WAIT_L(8); PG8_BAR; PG8_WAIT_L(0); PG8_MMA(0, 0, At, B0); PG8_BAR; PG8_SCHED;
            PG8_LDB(B1, 0, 1); PG8_STAGE(PG8_SB(0, 0), rsB, b2, voffB);
            PG8_BAR; PG8_WAIT_L(0); PG8_MMA(0, 1, At, B1); PG8_BAR;
            PG8_LDA(At, 0, 1); PG8_STAGE(PG8_SA(0, 0), rsA, a2, vA0);
            PG8_BAR; PG8_WAIT_L(0); PG8_MMA(1, 0, At, B0); PG8_BAR; PG8_SCHED;
            PG8_STAGE(PG8_SB(0, 1), rsB, b2 + hstep, voffB);
            PG8_WAIT_V(6); PG8_BAR; PG8_MMA(1, 1, At, B1); PG8_BAR;
            PG8_LDB(B0, 1, 0); PG8_SCHED; PG8_LDA(At, 1, 0); PG8_STAGE(PG8_SA(0, 1), rsA, a2, vA1);
            PG8_WAIT_L(8); PG8_BAR; PG8_WAIT_L(0); PG8_MMA(0, 0, At, B0); PG8_BAR; PG8_SCHED;
            PG8_LDB(B1, 1, 1); PG8_STAGE(PG8_SB(1, 0), rsB, b3, voffB);
            PG8_BAR; PG8_WAIT_L(0); PG8_MMA(0, 1, At, B1); PG8_BAR;
            PG8_LDA(At, 1, 1); PG8_STAGE(PG8_SA(1, 0), rsA, a3, vA0);
            PG8_BAR; PG8_WAIT_L(0); PG8_MMA(1, 0, At, B0); PG8_BAR; PG8_SCHED;
            PG8_STAGE(PG8_SB(1, 1), rsB, b3 + hstep, voffB);
            PG8_WAIT_V(6); PG8_BAR; PG8_MMA(1, 1, At, B1); PG8_BAR;
        }
        { const int t2 = otid(WV), w2 = __builtin_amdgcn_readfirstlane(t2 >> 6), l2 = t2 & 63; E(acc, cur, w2 >> 2, w2 & 3, l2 & 15, l2 >> 4, rows + (ui % 3) * 256); }
        if constexpr (Sched::SIG == 3) {
            PG8_WAIT_V(0); PG8_BAR; PG8_BAR;
            if (otid(WV) == 0) { __builtin_amdgcn_fence(__ATOMIC_RELEASE, "agent"); (void)__hip_atomic_fetch_add(S.flag + cur.gt, 1, __ATOMIC_RELAXED, __HIP_MEMORY_SCOPE_AGENT); }
        }
        if (!has_next) break;
#pragma unroll
        for (int a = 0; a < 2; ++a)
#pragma unroll
            for (int b = 0; b < 2; ++b)
#pragma unroll
                for (int m = 0; m < 4; ++m)
#pragma unroll
                    for (int n = 0; n < 2; ++n) acc[a][b][m][n] = (f32x4){0.f, 0.f, 0.f, 0.f};
        cur = nxt; cB = nB; ++ui;
    }
    PG8_WAIT_V(0);
    if (wr == 0) PG8_BAR;
    PG8_BAR;
#undef PG8_SA
#undef PG8_SB
#undef PG8_STAGE
#undef PG8_LDA
#undef PG8_LDB
#undef PG8_MMA
#undef PG8_WAIT_V
#undef PG8_WAIT_L
#undef PG8_BAR
#undef PG8_SCHED
}

struct EpiBf16 {
    static constexpr bool PERM = true;
    bf16_t* O; int ldo, gelu_from;
    __device__ __forceinline__ void operator()(const f32x4 (&acc)[2][2][4][2], const Unit& u, int wr, int wc, int fr, int fq, PG8_LAS const int* rows) const {
        const int row0 = u.pm * BM + wr * 64 + fr, col0 = u.pn * BM + wc * 32 + 8 * fq; const bool gl = u.pn >= gelu_from;
#pragma unroll
        for (int ai = 0; ai < 2; ++ai)
#pragma unroll
            for (int m = 0; m < 4; ++m) { bf16_t* rowp = O + (size_t)(row0 + ai * HALF + m * 16) * ldo + col0;
#pragma unroll
                for (int bj = 0; bj < 2; ++bj) { f32x4 v0 = acc[ai][bj][m][0], v1 = acc[ai][bj][m][1];
                    if (gl) {
#pragma unroll
                        for (int j = 0; j < 4; ++j) { v0[j] = geluf_(v0[j]); v1[j] = geluf_(v1[j]); } }
                    u32x4 w; w.x = cvt_pk_bf16(v0[0], v0[1]); w.y = cvt_pk_bf16(v0[2], v0[3]); w.z = cvt_pk_bf16(v1[0], v1[1]); w.w = cvt_pk_bf16(v1[2], v1[3]);
                    *(u32x4*)(rowp + bj * HALF) = w; } }
    }
};
struct EpiRes {
    static constexpr bool PERM = false;
    const float* xin; float* xout; const float* gt;
    __device__ __forceinline__ void operator()(const f32x4 (&acc)[2][2][4][2], const Unit& u, int wr, int wc, int fr, int fq, PG8_LAS const int* rows) const {
        const int row0 = u.pm * BM + wr * 64 + fr, col0 = u.pn * BM + wc * 32 + 4 * fq;
#pragma unroll
        for (int ai = 0; ai < 2; ++ai)
#pragma unroll
            for (int m = 0; m < 4; ++m) { const int r = row0 + ai * HALF + m * 16; const float* gp = gt + (r >> 11) * 6144 + col0; const size_t off = (size_t)r * 1024 + col0;
#pragma unroll
                for (int bj = 0; bj < 2; ++bj)
#pragma unroll
                    for (int n = 0; n < 2; ++n) { const int cc = bj * HALF + n * 16; const f32x4 xv = *(const f32x4*)(xin + off + cc); const f32x4 gv = *(const f32x4*)(gp + cc);
                        *(f32x4*)(xout + off + cc) = xv + gv * acc[ai][bj][m][n]; }
                if (m & 1) asm volatile("" ::: "memory"); }
    }
};
template <bool XIN16>
struct EpiRes16 {
    static constexpr bool PERM = true;
    const void* xin; bf16_t* xout; const float* gt;
    __device__ __forceinline__ void operator()(const f32x4 (&acc)[2][2][4][2], const Unit& u, int wr, int wc, int fr, int fq, PG8_LAS const int* rows) const {
        const int row0 = u.pm * BM + wr * 64 + fr, col0 = u.pn * BM + wc * 32 + 8 * fq;
        const float* gp = gt + (row0 >> 11) * 6144 + col0;
        f32x4 gv[2][2];
#pragma unroll
        for (int bj = 0; bj < 2; ++bj) { gv[bj][0] = *(const f32x4*)(gp + bj * HALF); gv[bj][1] = *(const f32x4*)(gp + bj * HALF + 4); }
        u32x4 xb[2][2]; f32x4 xf[2][2][2];
#define ER_LOAD(it_) do { const size_t off_ = (size_t)(row0 + ((it_) >> 2) * HALF + ((it_) & 3) * 16) * 1024 + col0; _Pragma("unroll") for (int bj = 0; bj < 2; ++bj) { \
            if (XIN16) xb[(it_) & 1][bj] = *(const u32x4*)((const bf16_t*)xin + off_ + bj * HALF); \
            else { xf[(it_) & 1][bj][0] = *(const f32x4*)((const float*)xin + off_ + bj * HALF); xf[(it_) & 1][bj][1] = *(const f32x4*)((const float*)xin + off_ + bj * HALF + 4); } } } while (0)
        ER_LOAD(0);
#pragma unroll
        for (int it = 0; it < 8; ++it) { const int ai = it >> 2, m = it & 3;
            if (it + 1 < 8) ER_LOAD(it + 1);
            const size_t off = (size_t)(row0 + ai * HALF + m * 16) * 1024 + col0;
#pragma unroll
            for (int bj = 0; bj < 2; ++bj) { const int cc = bj * HALF;
                f32x4 x0, x1;
                if (XIN16) { const u32x4 q = xb[it & 1][bj];
                    x0 = (f32x4){__uint_as_float(q.x << 16), __uint_as_float(q.x & 0xffff0000u), __uint_as_float(q.y << 16), __uint_as_float(q.y & 0xffff0000u)};
                    x1 = (f32x4){__uint_as_float(q.z << 16), __uint_as_float(q.z & 0xffff0000u), __uint_as_float(q.w << 16), __uint_as_float(q.w & 0xffff0000u)}; }
                else { x0 = xf[it & 1][bj][0]; x1 = xf[it & 1][bj][1]; }
                const f32x4 v0 = x0 + gv[bj][0] * acc[ai][bj][m][0], v1 = x1 + gv[bj][1] * acc[ai][bj][m][1];
                u32x4 w; w.x = cvt_pk_bf16(v0[0], v0[1]); w.y = cvt_pk_bf16(v0[2], v0[3]); w.z = cvt_pk_bf16(v1[0], v1[1]); w.w = cvt_pk_bf16(v1[2], v1[3]);
                *(u32x4*)(xout + off + cc) = w; }
            asm volatile("" ::: "memory"); }
#undef ER_LOAD
    }
};
struct EpiG1 {
    static constexpr bool PERM = true;
    bf16_t* act; const int* list; const float* gw;
    __device__ __forceinline__ void operator()(const f32x4 (&acc)[2][2][4][2], const Unit& u, int wr, int wc, int fr, int fq, PG8_LAS const int* rows) const {
        int pv[8]; float wv[8];
#pragma unroll
        for (int it = 0; it < 8; ++it) pv[it] = rows[(it >> 2) * HALF + wr * 64 + (it & 3) * 16 + fr];
#pragma unroll
        for (int it = 0; it < 8; ++it) wv[it] = gw[pv[it]];
#pragma unroll
        for (int it = 0; it < 8; ++it) { const int ai = it >> 2, m = it & 3; const int rr = ai * HALF + wr * 64 + m * 16 + fr;
                if (rr < u.nvalid) { const int p = pv[it]; const float w = wv[it];
#pragma unroll
                    for (int bj = 0; bj < 2; ++bj) { const int c = u.pn * BM + bj * HALF + wc * 32 + 8 * fq; const f32x4 v0 = acc[ai][bj][m][0], v1 = acc[ai][bj][m][1];
                        u32x2 o; o.x = cvt_pk_bf16(siluf(v0[0]) * v0[1] * w, siluf(v0[2]) * v0[3] * w); o.y = cvt_pk_bf16(siluf(v1[0]) * v1[1] * w, siluf(v1[2]) * v1[3] * w);
                        *(u32x2*)(act + (size_t)p * 256 + (c >> 1)) = o; } }
                asm volatile("" ::: "memory"); }
    }
};
struct EpiG2 {
    static constexpr bool PERM = true;
    bf16_t* y; const int* list;
    __device__ __forceinline__ void operator()(const f32x4 (&acc)[2][2][4][2], const Unit& u, int wr, int wc, int fr, int fq, PG8_LAS const int* rows) const {
#pragma unroll
        for (int ai = 0; ai < 2; ++ai)
#pragma unroll
            for (int m = 0; m < 4; ++m) { const int rr = ai * HALF + wr * 64 + m * 16 + fr;
                if (rr < u.nvalid) { const int p = rows[rr];
#pragma unroll
                    for (int bj = 0; bj < 2; ++bj) { const int c = u.pn * BM + bj * HALF + wc * 32 + 8 * fq; const f32x4 v0 = acc[ai][bj][m][0], v1 = acc[ai][bj][m][1];
                        u32x4 w; w.x = cvt_pk_bf16(v0[0], v0[1]); w.y = cvt_pk_bf16(v0[2], v0[3]); w.z = cvt_pk_bf16(v1[0], v1[1]); w.w = cvt_pk_bf16(v1[2], v1[3]);
                        *(u32x4*)(y + (size_t)p * 1024 + c) = w; } }
                asm volatile("" ::: "memory"); }
    }
};
}

__device__ __forceinline__ void run_gemm_dense_bf16(const int WV, PG8_LAS unsigned char* lds, const bf16_t* A, const bf16_t* Bt, int M, int N, int K, bf16_t* O, int ldo, int gelu_from) {
    pg8::Gemm g; g.A = A; g.Bt = Bt; g.wstride = 0; g.K = K; g.pad_ = 0;
    pg8::StaticOrder S; S.init(M, N, gridDim.x, blockIdx.x); pg8::EpiBf16 E{O, ldo, gelu_from}; pg8::gemm_phase<1024>(WV, lds, g, S, E);
}
template <bool XIN16>
__device__ __forceinline__ void run_gemm_dense_res(const int WV, PG8_LAS unsigned char* lds, const bf16_t* A, const bf16_t* Bt, int M, int N, int K, const void* xin, bf16_t* xout, const float* gt) {
    pg8::Gemm g; g.A = A; g.Bt = Bt; g.wstride = 0; g.K = K; g.pad_ = 0;
    pg8::StaticOrder S; S.init(M, N, gridDim.x, blockIdx.x); pg8::EpiRes16<XIN16> E{xin, xout, gt}; pg8::gemm_phase<1024>(WV, lds, g, S, E);
}
template <int SIG>
__device__ __forceinline__ void run_gemm_g1(const int WV, PG8_LAS unsigned char* lds, CParams& p, const bf16_t* A, const bf16_t* Bt, bf16_t* act) {
    pg8::Gemm g; g.A = A; g.Bt = Bt; g.wstride = (size_t)512 * 1024; g.K = 1024; g.pad_ = 0;
    const int l16 = otid(WV) & 63; const int cv = (l16 < 16) ? __hip_atomic_load(p.cnt + l16, __ATOMIC_RELAXED, __HIP_MEMORY_SCOPE_AGENT) : 0;
    int ntile = 0;
    for (int e = 0; e < 16; ++e) ntile += (__builtin_amdgcn_readlane(cv, e) + 255) >> 8;
    pg8::MoeOrder<2, 1, SIG> S{p.cnt, p.list, (int)gridDim.x, (int)blockIdx.x, cv, p.cnt + 64, (2 * ntile) / (int)gridDim.x, (2 * ntile) % (int)gridDim.x}; pg8::EpiG1 E{act, p.list, p.gw}; pg8::gemm_phase<1024>(WV, lds, g, S, E);
}
__device__ __forceinline__ void run_gemm_g2(const int WV, PG8_LAS unsigned char* lds, CParams& p, const bf16_t* A, const bf16_t* Bt, bf16_t* y) {
    pg8::Gemm g; g.A = A; g.Bt = Bt; g.wstride = (size_t)1024 * 256; g.K = 256; g.pad_ = 0;
    const int l16 = otid(WV) & 63; const int cv = (l16 < 16) ? __hip_atomic_load(p.cnt + l16, __ATOMIC_RELAXED, __HIP_MEMORY_SCOPE_AGENT) : 0;
    int ntile = 0;
    for (int e = 0; e < 16; ++e) ntile += (__builtin_amdgcn_readlane(cv, e) + 255) >> 8;
    pg8::MoeOrder<4, 0, 2> S{p.cnt, p.list, (int)gridDim.x, (int)blockIdx.x, cv, p.cnt + 64, (2 * ntile) / (int)gridDim.x, (2 * ntile) % (int)gridDim.x}; pg8::EpiG2 E{y, p.list}; pg8::gemm_phase<256>(WV, lds, g, S, E);
}

__device__ __forceinline__ CParams* kparams() { CParams* q = (CParams*)__builtin_amdgcn_kernarg_segment_ptr(); asm volatile("" : "+s"(q)); return q; }
#define KP (*kparams())

#define XB_TMO      128
#define XB_XCNT(j)  (256  + 64 * (j))
#define XB_XSUB(j)  (1280 + 64 * (j))
#define XB_XGEN(j)  (2304 + 64 * (j))
#define XB_TOP      3328
#define XB_TOPGEN   3392
#define XCD_BAR_WORDS 3456
#define XB_SPIN_CAP (1u << 22)
__device__ __forceinline__ unsigned xb_ld(unsigned* p)              { return __hip_atomic_load(p, __ATOMIC_RELAXED, __HIP_MEMORY_SCOPE_AGENT); }
__device__ __forceinline__ unsigned xb_add(unsigned* p, unsigned v) { return __hip_atomic_fetch_add(p, v, __ATOMIC_RELAXED, __HIP_MEMORY_SCOPE_AGENT); }
__device__ __forceinline__ unsigned xb_xcc_id() { return (unsigned)__builtin_amdgcn_s_getreg((3 << 11) | 20) & 0xFu; }
#define XB_SPIN(cond, bar) do { unsigned _sp = 0; while (cond) { __builtin_amdgcn_s_sleep(1); \
    if ((++_sp & 255u) == 0u) { if (xb_ld(&(bar)[XB_TMO])) break; if (_sp > XB_SPIN_CAP) { atomicAdd(&(bar)[XB_TMO], 1u); break; } } } } while (0)
__device__ __forceinline__ void xcd_barrier_complete(unsigned* bar, unsigned x, unsigned& nloc, unsigned& nx) {
    const unsigned G = gridDim.x;
    unsigned sum, cnt, mine, sp = 0u;
    for (;;) {
        sum = 0u; cnt = 0u; mine = 0u;
#pragma unroll
        for (unsigned j = 0; j < 16; ++j) { const unsigned c = xb_ld(&bar[XB_XCNT(j)]); sum += c; cnt += (c > 0u) ? 1u : 0u; mine = (j == x) ? c : mine; }
        if (sum == G) break;
        __builtin_amdgcn_s_sleep(1);
        if ((++sp & 255u) == 0u) { if (xb_ld(&bar[XB_TMO])) break; if (sp > XB_SPIN_CAP) { atomicAdd(&bar[XB_TMO], 1u); break; } }
    }
    nloc = mine > 0u ? mine : 1u; nx = cnt > 0u ? cnt : 1u;
}
__device__ __forceinline__ void xcd_barrier(const int WV, unsigned* bar, volatile PG8_LAS unsigned* st) {
    asm volatile("s_waitcnt vmcnt(0)" ::: "memory");
    __syncthreads();
    if (otid(WV) == 0) {
        __builtin_amdgcn_s_waitcnt(0);
        const unsigned x = xb_xcc_id();
        unsigned nloc = st[0], nx = st[1];
        if (nloc == 0u) { xcd_barrier_complete(bar, x, nloc, nx); st[0] = nloc; st[1] = nx; }
        const unsigned old = xb_add(&bar[XB_XSUB(x)], 1u);
        const unsigned gen = old / nloc;
        if (old + 1u == (gen + 1u) * nloc) {
            __builtin_amdgcn_fence(__ATOMIC_RELEASE, "agent");
            asm volatile("s_waitcnt vmcnt(0)" ::: "memory");
            const unsigned og = xb_add(&bar[XB_TOP], 1u);
            const unsigned tg = og / nx;
            if (og + 1u == (tg + 1u) * nx) xb_add(&bar[XB_TOPGEN], 1u);
            else XB_SPIN(xb_ld(&bar[XB_TOPGEN]) == tg, bar);
            __builtin_amdgcn_fence(__ATOMIC_ACQUIRE, "agent");
            xb_add(&bar[XB_XGEN(x)], 1u);
            asm volatile("s_waitcnt vmcnt(0)" ::: "memory");
        } else {
            XB_SPIN(xb_ld(&bar[XB_XGEN(x)]) == gen, bar);
            __builtin_amdgcn_fence(__ATOMIC_ACQUIRE, "agent");
            asm volatile("s_waitcnt vmcnt(0)" ::: "memory");
        }
    }
    __syncthreads();
}
__global__ __launch_bounds__(512) void k_mega(Params p_unused) {
    extern __shared__ __attribute__((aligned(16))) unsigned char smem[];
    PG8_LAS unsigned char* lds = (PG8_LAS unsigned char*)smem;
    cg::grid_group grid = cg::this_grid();
    const int WV = __builtin_amdgcn_readfirstlane(threadIdx.x >> 6);
    volatile PG8_LAS unsigned* xb_st = (volatile PG8_LAS unsigned*)(lds + (LDS_BYTES - 16));
    { unsigned* bar0 = KP.bar; if (threadIdx.x == 0) { xb_st[0] = 0u; xb_st[1] = 0u; (void)xb_add(&bar0[XB_XCNT(xb_xcc_id())], 1u); } }
    __syncthreads();
#define GSYNC() xcd_barrier(WV, KP.bar, xb_st)
#define MOD0 (KP.mod)
#define MOD1 (KP.mod + 16 * 6144)
#define PROJB ((bf16_t*)KP.PROJ)
#define ACTB ((bf16_t*)KP.PROJ)
#define YB ((bf16_t*)KP.PROJ + (size_t)2 * T_ * 256)
#define XA16(p_) ((bf16_t*)(p_).PROJ + (size_t)2 * T_ * 256 + (size_t)2 * T_ * 1024)
    ph_tcvt<MapEv>(WV, KP.ev_w_in, 3596, 1024, KP.W_evin, 0, 0, 1, smem);
    ph_tcvt<MapId>(WV, KP.ev_w_out, 1024, 1024, KP.W_evout, 0, 0, 1, smem);
    ph_tcvt<MapId>(WV, KP.od_w_in, 2048, 1024, KP.W_odin, 0, 0, 1, smem);
    ph_tcvt<MapId>(WV, KP.od_w_out, 1024, 1024, KP.W_odout, 0, 0, 1, smem);
    ph_tcvt<MapEven>(WV, KP.moe_wg, 256, 1024, KP.W_moe1, (size_t)1024 * 256, (size_t)512 * 1024, 32, smem);
    ph_tcvt<MapOdd>(WV, KP.moe_wu, 256, 1024, KP.W_moe1, (size_t)1024 * 256, (size_t)512 * 1024, 32, smem);
    ph_tcvt<MapId>(WV, KP.moe_wd, 1024, 256, KP.W_moe2, (size_t)256 * 1024, (size_t)1024 * 256, 32, smem);
    ph_tcvt<MapId>(WV, KP.od_wr, 128, 128, KP.W_lr, (size_t)128 * 128, (size_t)128 * 128, 4, smem);
    ph_tcvt<MapId>(WV, KP.od_wi, 128, 128, KP.W_li, (size_t)128 * 128, (size_t)128 * 128, 4, smem);
    { CParams& p = KP; ph_misc(WV, p); }
    { CParams& p = KP; ph_mod(WV, p, smem); }
    if (KP.bar == nullptr) grid.sync();
    GSYNC();
    { CParams& p = KP; ph_norm<false, false>(WV, p, p.x, nullptr, nullptr, nullptr, p.norm1_g, p.mod + 1024, p.mod + 0, p.H, smem); }
    GSYNC();
    { CParams& p = KP; ph_small_gemm(WV, p, smem); }
    run_gemm_dense_bf16(WV, lds, KP.H, KP.W_evin, T_, EVN, 1024, PROJB, EVN, 1 << 20);
    GSYNC();
    { CParams& p = KP; bf16_t* fx = (bf16_t*)p.out; const DnBufs d{p.H, p.H + (size_t)T_ * 512, p.VN, fx + (size_t)3 * T_ * 512, p.DNQK, p.DNGL}; ph_dn_prep(WV, p, (const bf16_t*)p.PROJ, d, smem); }
    { CParams& p = KP; ph_cumsum(WV, p, smem); }
    { CParams& p = KP; bf16_t* fx = (bf16_t*)p.out; ph_foxpre(WV, p, (const bf16_t*)p.PROJ, fx, fx + (size_t)2 * T_ * 512, smem); }
    GSYNC();
    { CParams& p = KP; bf16_t* fx = (bf16_t*)p.out; const DnBufs d{p.H, p.H + (size_t)T_ * 512, p.VN, fx + (size_t)3 * T_ * 512, p.DNQK, p.DNGL}; ph_dn_scan(WV, p, (const bf16_t*)p.PROJ, d, p.OMIX, smem); }
    { CParams& p = KP; const bf16_t* fx = (const bf16_t*)p.out; ph_fox_flash(WV, p, (const bf16_t*)p.PROJ, fx, fx + (size_t)2 * T_ * 512, p.OMIX, smem); }
    GSYNC();
    { CParams& p = KP; run_gemm_dense_res<false>(WV, lds, p.OMIX, p.W_evout, T_, 1024, 1024, p.x, XA16(p), p.mod + 2048); }
    GSYNC();
    { CParams& p = KP; ph_route(WV, p, XA16(p), p.norm2_g, p.mod + 4096, p.mod + 3072, p.H, smem); }
    GSYNC();
    { CParams& p = KP; run_gemm_g1<1>(WV, lds, p, p.H, p.W_moe1, (bf16_t*)p.PROJ); }
    GSYNC();
    { CParams& p = KP; run_gemm_g1<3>(WV, lds, p, p.H, p.W_moe1, (bf16_t*)p.PROJ); }
    { CParams& p = KP; run_gemm_g2(WV, lds, p, (const bf16_t*)p.PROJ, p.W_moe2, (bf16_t*)p.PROJ + (size_t)2 * T_ * 256); }
    GSYNC();
    { CParams& p = KP; ph_norm<true, true>(WV, p, XA16(p), (const bf16_t*)p.PROJ + (size_t)2 * T_ * 256, p.mod + 5120, XA16(p), p.norm1_g + 1024, p.mod + 16 * 6144 + 1024, p.mod + 16 * 6144, p.H, smem);
      { const int t0 = otid(WV); if (blockIdx.x == 0 && t0 < 512) p.cnt[t0] = 0; } }
    GSYNC();
    run_gemm_dense_bf16(WV, lds, KP.H, KP.W_odin, T_, 2048, 1024, PROJB, 2048, 2);
    GSYNC();
    { CParams& p = KP; ph_lru(WV, p, (const bf16_t*)p.PROJ, p.OMIX, smem); }
    { CParams& p = KP; ph_sgu(WV, p, (const bf16_t*)p.PROJ, p.OMIX, smem); }
    GSYNC();
    { CParams& p = KP; run_gemm_dense_res<true>(WV, lds, p.OMIX, p.W_odout, T_, 1024, 1024, XA16(p), XA16(p), p.mod + 16 * 6144 + 2048); }
    GSYNC();
    { CParams& p = KP; ph_route(WV, p, XA16(p), p.norm2_g + 1024, p.mod + 16 * 6144 + 4096, p.mod + 16 * 6144 + 3072, p.H, smem); }
    GSYNC();
    { CParams& p = KP; run_gemm_g1<1>(WV, lds, p, p.H, p.W_moe1 + (size_t)16 * 512 * 1024, (bf16_t*)p.PROJ); }
    GSYNC();
    { CParams& p = KP; run_gemm_g1<3>(WV, lds, p, p.H, p.W_moe1 + (size_t)16 * 512 * 1024, (bf16_t*)p.PROJ); }
    { CParams& p = KP; run_gemm_g2(WV, lds, p, (const bf16_t*)p.PROJ, p.W_moe2 + (size_t)16 * 1024 * 256, (bf16_t*)p.PROJ + (size_t)2 * T_ * 256); }
    GSYNC();
    { CParams& p = KP; ph_norm<true, false>(WV, p, XA16(p), (const bf16_t*)p.PROJ + (size_t)2 * T_ * 256, p.mod + 16 * 6144 + 5120, p.out, nullptr, nullptr, nullptr, nullptr, smem); }
}

static inline size_t al(size_t x) { return (x + 255) & ~(size_t)255; }

extern "C" void kernel_launch(void* const* d_in, const int* in_sizes, int n_in, void* d_out, int out_size, void* d_ws, size_t ws_size, hipStream_t stream) {
    Params p; memset(&p, 0, sizeof(p));
    const float** pin = (const float**)&p;
    for (int i = 0; i < 32; ++i) pin[i] = (const float*)d_in[i];
    p.out = (float*)d_out;
    unsigned char* ws = (unsigned char*)d_ws; size_t off = 0;
    auto take = [&](size_t bytes) { unsigned char* q = ws + off; off += al(bytes); return q; };
    p.W_evin = (bf16_t*)take((size_t)3600 * 1024 * 2);
    p.W_evout = (bf16_t*)take((size_t)1024 * 1024 * 2);
    p.W_odin = (bf16_t*)take((size_t)2048 * 1024 * 2);
    p.W_odout = (bf16_t*)take((size_t)1024 * 1024 * 2);
    p.W_moe1 = (bf16_t*)take((size_t)2 * 16 * 512 * 1024 * 2);
    p.W_moe2 = (bf16_t*)take((size_t)2 * 16 * 1024 * 256 * 2);
    p.W_lr = (bf16_t*)take((size_t)4 * 128 * 128 * 2);
    p.W_li = (bf16_t*)take((size_t)4 * 128 * 128 * 2);
    p.W_sgu = (bf16_t*)take((size_t)4 * 128 * 128 * 2);
    p.mod = (float*)take((size_t)2 * 16 * 6144 * 4);
    p.cnt = (int*)take(2048);
    p.bar = (unsigned*)take(16384);
    p.list = (int*)take((size_t)16 * T_ * 4);
    p.gw = (float*)take((size_t)2 * T_ * 4);
    p.gdec = (float*)take((size_t)T_ * 4 * 4);
    p.beta = (float*)take((size_t)T_ * 4 * 4);
    p.lf = (float*)take((size_t)T_ * 4 * 4);
    p.cum = (float*)take((size_t)T_ * 4 * 4);
    p.H = (bf16_t*)take((size_t)T_ * 1024 * 2);
    p.PROJ = take((size_t)T_ * 3600 * 2);
    p.OMIX = (bf16_t*)take((size_t)T_ * 1024 * 2);
    p.VN = (bf16_t*)take((size_t)T_ * 512 * 2);
    p.DNQK = (bf16_t*)take((size_t)4096 * 1024 * 2);
    p.DNGL = (float*)take((size_t)4096 * 4);
    p.small = (float*)take((size_t)T_ * 16 * 4);
    (void)ws_size; (void)n_in; (void)in_sizes; (void)out_size;

    static int grid_blocks = 0;
    if (!grid_blocks) {
        (void)hipFuncSetAttribute((const void*)k_mega, hipFuncAttributeMaxDynamicSharedMemorySize, LDS_BYTES);
        int dev = 0, cus = 0, per_cu = 0; (void)hipGetDevice(&dev); (void)hipDeviceGetAttribute(&cus, hipDeviceAttributeMultiprocessorCount, dev);
        (void)hipOccupancyMaxActiveBlocksPerMultiprocessor(&per_cu, k_mega, NT, LDS_BYTES);
        if (per_cu > 1) per_cu = 1;
        grid_blocks = cus * per_cu;
    }
    (void)hipMemsetAsync(p.bar, 0, 16384, stream);
    void* args[] = {&p};
    (void)hipLaunchCooperativeKernel((const void*)k_mega, dim3(grid_blocks), dim3(NT), args, LDS_BYTES, stream);
}
```

```cpp
#include <hip/hip_runtime.h>
#include <hip/hip_cooperative_groups.h>
#include <stdint.h>
#include <string.h>
namespace cg = cooperative_groups;

#define PG8_LAS __attribute__((address_space(3)))
typedef unsigned short bf16_t;
constexpr int B_ = 16, S_ = 2048, D_ = 1024, T_ = B_ * S_;
constexpr int EVN = 3584;
constexpr int NT = 512;
constexpr int LDS_BYTES = 139264;

__device__ __forceinline__ float bf2f(bf16_t b) { return __uint_as_float(((unsigned)b) << 16); }
__device__ __forceinline__ bf16_t f2bf(float f) { unsigned u = __float_as_uint(f); u += 0x7FFFu + ((u >> 16) & 1u); return (bf16_t)(u >> 16); }
typedef __bf16 pk_bf16x2_t __attribute__((ext_vector_type(2)));
typedef float pk_f32x2_t __attribute__((ext_vector_type(2)));
__device__ __forceinline__ unsigned pk_bf16(float lo, float hi) { pk_f32x2_t f = {lo, hi}; pk_bf16x2_t b = __builtin_convertvector(f, pk_bf16x2_t); return __builtin_bit_cast(unsigned, b); }
__device__ __forceinline__ float sigm(float x) { return __builtin_amdgcn_rcpf(1.f + __builtin_amdgcn_exp2f(-1.4426950408889634f * x)); }
__device__ __forceinline__ float siluf(float x) { return x * sigm(x); }
__device__ __forceinline__ float softplusf_(float x) { return x > 20.f ? x : log1pf(__expf(x)); }
__device__ __forceinline__ float softplus_fast(float x) { return x > 15.f ? x : __logf(1.f + __expf(x)); }
__device__ __forceinline__ float geluf_(float x) { const float x2 = x * x; const float t = x * fmaf(x2, -0.10294324f, -2.3022082f); return x * __builtin_amdgcn_rcpf(1.f + __builtin_amdgcn_exp2f(t)); }
template <int CTRL> __device__ __forceinline__ float dppf(float v) { return __int_as_float(__builtin_amdgcn_update_dpp(0, __float_as_int(v), CTRL, 0xf, 0xf, false)); }
__device__ __forceinline__ float red8_sum(float v) { v += dppf<0xB1>(v); v += dppf<0x4E>(v); v += dppf<0x141>(v); return v; }
__device__ __forceinline__ float wave_sum(float v) {
    v += dppf<0xB1>(v); v += dppf<0x4E>(v); v += dppf<0x141>(v); v += dppf<0x140>(v);
    { auto r = __builtin_amdgcn_permlane16_swap(__float_as_uint(v), __float_as_uint(v), false, false); v = __uint_as_float(r[0]) + __uint_as_float(r[1]); }
    { auto r = __builtin_amdgcn_permlane32_swap(__float_as_uint(v), __float_as_uint(v), false, false); v = __uint_as_float(r[0]) + __uint_as_float(r[1]); }
    return v;
}
__device__ __forceinline__ float wave_max(float v) {
    v = fmaxf(v, dppf<0xB1>(v)); v = fmaxf(v, dppf<0x4E>(v)); v = fmaxf(v, dppf<0x141>(v)); v = fmaxf(v, dppf<0x140>(v));
    { auto r = __builtin_amdgcn_permlane16_swap(__float_as_uint(v), __float_as_uint(v), false, false); v = fmaxf(__uint_as_float(r[0]), __uint_as_float(r[1])); }
    { auto r = __builtin_amdgcn_permlane32_swap(__float_as_uint(v), __float_as_uint(v), false, false); v = fmaxf(__uint_as_float(r[0]), __uint_as_float(r[1])); }
    return v;
}
__device__ __forceinline__ int otid(const int WV) { int l; asm volatile("v_mbcnt_lo_u32_b32 %0, -1, 0\n\tv_mbcnt_hi_u32_b32 %0, -1, %0" : "=v"(l)); return WV * 64 + l; }

struct Params {
    const float *x, *c, *ada_w, *ada_b, *norm1_g, *norm2_g, *ev_w_in, *ev_conv_w, *ev_a_log, *ev_dt_bias, *ev_onorm_g, *ev_f_bias, *ev_qnorm_g, *ev_knorm_g, *ev_w_out;
    const float *od_w_in, *od_conv_w, *od_conv_b, *od_wr, *od_br, *od_wi, *od_bi, *od_lam, *od_sgu_g, *od_sgu_w, *od_sgu_b, *od_w_out, *router_w, *router_b, *moe_wg, *moe_wu, *moe_wd;
    float* out;
    bf16_t *W_evin, *W_evout, *W_odin, *W_odout, *W_moe1, *W_moe2, *W_lr, *W_li, *W_sgu;
    float* mod; int* cnt; unsigned* bar; int* list; float* gw; float* gdec; float* beta; float* lf; float* cum;
    bf16_t* H; unsigned char* PROJ; bf16_t* OMIX; bf16_t* VN; bf16_t* DNQK; float* DNGL; float* small;
};
static_assert(sizeof(Params) % 8 == 0, "params");
typedef const __attribute__((address_space(4))) Params CParams;

struct MapEv { __device__ int operator()(int j) const { if (j < 2048) return j; if (j < 2056) return 3584 + (j - 2048); if (j < 3592) return j - 8; return j; } };
struct MapId { __device__ int operator()(int j) const { return j; } };
struct MapEven { __device__ int operator()(int j) const { return 2 * j; } };
struct MapOdd { __device__ int operator()(int j) const { return 2 * j + 1; } };
template <class F>
__device__ __forceinline__ void ph_tcvt(const int WV, const float* __restrict__ src0, int nsrc, int K, bf16_t* __restrict__ dst0, size_t sstride, size_t dstride, int nz, unsigned char* smem) {
    const int tix_ = otid(WV);
    float (*tile)[64][65] = (float (*)[64][65])smem; F rowmap;
    const int half = tix_ >> 8, tid = tix_ & 255, tx4 = tid & 15, ty4 = tid >> 4;
    const int nj = (nsrc + 63) >> 6, nk = K >> 6, ntiles = nj * nk * nz;
    float4 v[4];
    auto ldtile = [&](int vt) {
        const int z = vt / (nj * nk), rem = vt % (nj * nk), j0 = (rem % nj) * 64, k0 = (rem / nj) * 64;
        const float* src = src0 + (size_t)z * sstride;
#pragma unroll
        for (int ps = 0; ps < 4; ++ps) { v[ps] = make_float4(0.f, 0.f, 0.f, 0.f); if (j0 + 4 * tx4 < nsrc) v[ps] = *(const float4*)(src + (size_t)(k0 + ty4 + 16 * ps) * nsrc + j0 + 4 * tx4); }
    };
    int base = blockIdx.x * 2;
    if (base + half < ntiles) ldtile(base + half);
    for (; base < ntiles; base += gridDim.x * 2) {
        const int vt = base + half; const bool valid = vt < ntiles;
        const int z = vt / (nj * nk), rem = vt % (nj * nk), j0 = (rem % nj) * 64, k0 = (rem / nj) * 64;
        bf16_t* dst = dst0 + (size_t)z * dstride;
        __syncthreads();
        if (valid) {
#pragma unroll
            for (int ps = 0; ps < 4; ++ps) { const int kk = ty4 + 16 * ps; tile[half][kk][4 * tx4] = v[ps].x; tile[half][kk][4 * tx4 + 1] = v[ps].y; tile[half][kk][4 * tx4 + 2] = v[ps].z; tile[half][kk][4 * tx4 + 3] = v[ps].w; } }
        __syncthreads();
        { const int nvt = vt + gridDim.x * 2; if (nvt < ntiles) ldtile(nvt); }
        if (valid) { const int kq = tid & 15, jr = tid >> 4;
#pragma unroll
            for (int ps = 0; ps < 4; ++ps) { const int jj = jr + 16 * ps; if (j0 + jj < nsrc) { const int r = rowmap(j0 + jj);
                if (r >= 0) { uint2 o; o.x = pk_bf16(tile[half][4 * kq][jj], tile[half][4 * kq + 1][jj]); o.y = pk_bf16(tile[half][4 * kq + 2][jj], tile[half][4 * kq + 3][jj]);
                    *(uint2*)(dst + (size_t)r * K + k0 + 4 * kq) = o; } } } }
    }
    __syncthreads();
}
__device__ __forceinline__ void ph_misc(const int WV, CParams& p) {
    const int tix_ = otid(WV);
    const int gtid = blockIdx.x * NT + tix_, gn = gridDim.x * NT;
    for (int i = gtid; i < 4 * 128 * 128; i += gn) { const int s = i & 127, t = (i >> 7) & 127; p.W_sgu[i] = f2bf(s <= t ? p.od_sgu_w[i] : 0.f); }
    if (gtid < 512) p.cnt[gtid] = 0;
    for (int i = gtid; i < 4 * 1024 / 2; i += gn) ((unsigned*)(p.W_evin + (size_t)3596 * 1024))[i] = 0u;
}

__device__ __forceinline__ void ph_mod(const int WV, CParams& p, unsigned char* smem) {
    const int tix_ = otid(WV);
    const int lane = tix_ & 63, w = tix_ >> 6;
    float* ca = (float*)smem;
    float* red = ca + 16384;
    __syncthreads();
#pragma unroll 8
    for (int i = tix_; i < 16384; i += NT) { const int b = i >> 10, k = i & 1023; ca[k * 16 + b] = siluf(p.c[i]); }
    __syncthreads();
    for (int item = blockIdx.x; item < 256; item += gridDim.x) {
        const int cidx = item * 48 + min(lane, 47), l = cidx / 6144, j = cidx % 6144;
        float acc[16];
#pragma unroll
        for (int b = 0; b < 16; ++b) acc[b] = 0.f;
        const float* wp = p.ada_w + ((size_t)l * 1024 + 128 * w) * 6144 + j;
#pragma unroll 1
        for (int kb = 0; kb < 128; kb += 32) {
            float wv[32];
#pragma unroll
            for (int kk = 0; kk < 32; ++kk) wv[kk] = wp[(size_t)(kb + kk) * 6144];
#pragma unroll
            for (int kk = 0; kk < 32; ++kk) { const float4* cp = (const float4*)(ca + (128 * w + kb + kk) * 16);
                const float4 c0 = cp[0], c1 = cp[1], c2 = cp[2], c3 = cp[3]; const float x = wv[kk];
                acc[0] += c0.x * x; acc[1] += c0.y * x; acc[2] += c0.z * x; acc[3] += c0.w * x; acc[4] += c1.x * x; acc[5] += c1.y * x; acc[6] += c1.z * x; acc[7] += c1.w * x;
                acc[8] += c2.x * x; acc[9] += c2.y * x; acc[10] += c2.z * x; acc[11] += c2.w * x; acc[12] += c3.x * x; acc[13] += c3.y * x; acc[14] += c3.z * x; acc[15] += c3.w * x; }
        }
#pragma unroll
        for (int b = 0; b < 16; ++b) red[(w * 16 + b) * 64 + lane] = acc[b];
        __syncthreads();
#pragma unroll
        for (int i = 0; i < 2; ++i) { const int o = tix_ + i * NT, b = o >> 6, cl = o & 63; float sum = 0.f;
#pragma unroll
            for (int ww = 0; ww < 8; ++ww) sum += red[(ww * 16 + b) * 64 + cl];
            const int ci2 = item * 48 + cl, l2 = ci2 / 6144, j2 = ci2 % 6144;
            if (cl < 48) p.mod[((size_t)l2 * 16 + b) * 6144 + j2] = sum + p.ada_b[l2 * 6144 + j2]; }
        __syncthreads();
    }
}

__device__ __forceinline__ float4 ld_res4(const void* p, size_t idx, bool is16) {
    if (is16) { const uint2 v = *(const uint2*)((const bf16_t*)p + idx); return make_float4(__uint_as_float(v.x << 16), __uint_as_float(v.x & 0xffff0000u), __uint_as_float(v.y << 16), __uint_as_float(v.y & 0xffff0000u)); }
    return *(const float4*)((const float*)p + idx);
}
template <bool XIN16, bool XOUT16>
__device__ __forceinline__ void ph_norm(const int WV, CParams& p, const void* xin, const bf16_t* __restrict__ y, const float* __restrict__ gt2, void* xout,
                        const float* __restrict__ g, const float* __restrict__ sc, const float* __restrict__ sh, bf16_t* __restrict__ hout, unsigned char* smem) {
    const int tix_ = otid(WV);
    const int lane = tix_ & 63, wv = (blockIdx.x * NT + tix_) >> 6, nw = gridDim.x * (NT / 64);
    constexpr int U = 2;
    for (int tb = wv * U; tb < T_; tb += nw * U) {
        const int b = tb >> 11;
        float4 xv[U][4]; float ss[U];
#pragma unroll
        for (int u = 0; u < U; ++u)
#pragma unroll
            for (int i = 0; i < 4; ++i) xv[u][i] = ld_res4(xin, (size_t)(tb + u) * 1024 + i * 256 + lane * 4, XIN16);
        if (y) {
#pragma unroll
            for (int i = 0; i < 4; ++i) { const int col = i * 256 + lane * 4; const float4 gv = *(const float4*)(gt2 + b * 6144 + col);
#pragma unroll
                for (int u = 0; u < U; ++u) { const bf16_t* y0 = y + (size_t)(2 * (tb + u)) * 1024 + col; const uint2 a0 = *(const uint2*)y0, a1 = *(const uint2*)(y0 + 1024);
                    float4 v = xv[u][i];
                    v.x += gv.x * (__uint_as_float(a0.x << 16) + __uint_as_float(a1.x << 16)); v.y += gv.y * (__uint_as_float(a0.x & 0xffff0000u) + __uint_as_float(a1.x & 0xffff0000u));
                    v.z += gv.z * (__uint_as_float(a0.y << 16) + __uint_as_float(a1.y << 16)); v.w += gv.w * (__uint_as_float(a0.y & 0xffff0000u) + __uint_as_float(a1.y & 0xffff0000u));
                    xv[u][i] = v;
                    if (XOUT16) { uint2 o; o.x = pk_bf16(v.x, v.y); o.y = pk_bf16(v.z, v.w); *(uint2*)((bf16_t*)xout + (size_t)(tb + u) * 1024 + col) = o; }
                    else *(float4*)((float*)xout + (size_t)(tb + u) * 1024 + col) = v; } }
        }
        if (!hout) continue;
#pragma unroll
        for (int u = 0; u < U; ++u) { float a = 0.f;
#pragma unroll
            for (int i = 0; i < 4; ++i) a += xv[u][i].x * xv[u][i].x + xv[u][i].y * xv[u][i].y + xv[u][i].z * xv[u][i].z + xv[u][i].w * xv[u][i].w;
            ss[u] = rsqrtf(wave_sum(a) * (1.f / 1024.f) + 1e-6f); }
#pragma unroll
        for (int i = 0; i < 4; ++i) {
            const int col = i * 256 + lane * 4;
            const float4 gv = *(const float4*)(g + col), scv = *(const float4*)(sc + b * 6144 + col), shv = *(const float4*)(sh + b * 6144 + col);
            const float m0 = gv.x * (1.f + scv.x), m1 = gv.y * (1.f + scv.y), m2 = gv.z * (1.f + scv.z), m3 = gv.w * (1.f + scv.w);
#pragma unroll
            for (int u = 0; u < U; ++u) { const float r = ss[u];
                uint2 o; o.x = pk_bf16(xv[u][i].x * r * m0 + shv.x, xv[u][i].y * r * m1 + shv.y); o.y = pk_bf16(xv[u][i].z * r * m2 + shv.z, xv[u][i].w * r * m3 + shv.w);
                *(uint2*)(hout + (size_t)(tb + u) * 1024 + col) = o; }
        }
    }
}

typedef short dn_bf16x8 __attribute__((ext_vector_type(8)));
typedef float dn_f32x4 __attribute__((ext_vector_type(4)));
struct DnBufs { bf16_t* Wp; bf16_t* QDp; bf16_t* KDTp; bf16_t* UTp; bf16_t* QKp; float* GL; };
__device__ __forceinline__ dn_f32x4 dn_mfma(dn_bf16x8 a, dn_bf16x8 b, dn_f32x4 c) { return __builtin_amdgcn_mfma_f32_16x16x32_bf16(a, b, c, 0, 0, 0); }
__device__ __forceinline__ unsigned dn_pk(float lo, float hi) { return pk_bf16(lo, hi); }
#define DN_LFENCE() asm volatile("s_waitcnt lgkmcnt(0)" ::: "memory")

__device__ __forceinline__ void dn_conv_tile(const bf16_t* __restrict__ proj, const float* __restrict__ cw, int t0, int s0, int ten, int hd, int lane, bf16_t* tile) {
    const int col = ten * 512 + hd * 128 + lane * 2;
    const float wa0 = cw[0 * 1536 + col], wa1 = cw[1 * 1536 + col], wa2 = cw[2 * 1536 + col], wa3 = cw[3 * 1536 + col];
    const float wb0 = cw[0 * 1536 + col + 1], wb1 = cw[1 * 1536 + col + 1], wb2 = cw[2 * 1536 + col + 1], wb3 = cw[3 * 1536 + col + 1];
    const bf16_t* src = proj + (size_t)t0 * EVN + col;
    float a0 = 0.f, a1 = 0.f, a2 = 0.f, b0 = 0.f, b1 = 0.f, b2 = 0.f;
    if (s0 > 0) {
        const unsigned p0 = *(const unsigned*)(src - 3 * EVN), p1 = *(const unsigned*)(src - 2 * EVN), p2 = *(const unsigned*)(src - 1 * EVN);
        a0 = __uint_as_float(p0 << 16); b0 = __uint_as_float(p0 & 0xffff0000u); a1 = __uint_as_float(p1 << 16); b1 = __uint_as_float(p1 & 0xffff0000u); a2 = __uint_as_float(p2 << 16); b2 = __uint_as_float(p2 & 0xffff0000u);
    }
#pragma unroll
    for (int rb = 0; rb < 2; ++rb) {
        unsigned pv[16];
#pragma unroll
        for (int r = 0; r < 16; ++r) pv[r] = *(const unsigned*)(src + (size_t)(rb * 16 + r) * EVN);
#pragma unroll
        for (int r = 0; r < 16; ++r) {
            const float a3 = __uint_as_float(pv[r] << 16), b3 = __uint_as_float(pv[r] & 0xffff0000u);
            const float oa = siluf(wa0 * a0 + wa1 * a1 + wa2 * a2 + wa3 * a3), ob = siluf(wb0 * b0 + wb1 * b1 + wb2 * b2 + wb3 * b3);
            *(unsigned*)(tile + (rb * 16 + r) * 136 + lane * 2) = dn_pk(oa, ob);
            a0 = a1; a1 = a2; a2 = a3; b0 = b1; b1 = b2; b2 = b3;
        }
    }
}

__device__ __forceinline__ void ph_dn_prep(const int WV, CParams& p, const bf16_t* __restrict__ proj, const DnBufs d, unsigned char* smem) {
    const int tid = otid(WV), lane = tid & 63, w = tid >> 6, c = lane & 15, g = lane >> 4;
    unsigned char* base = smem + w * 16896;
    bf16_t* tile = (bf16_t*)base; float* Lm = (float*)(base + 8704); bf16_t* Tm = (bf16_t*)(base + 13312); float* tab = (float*)(base + 15872);
    float* t_gc = tab, *t_be = tab + 32, *t_ek = tab + 64, *t_dk = tab + 96, *t_rk = tab + 128, *t_rq = tab + 160;
    const int gw = blockIdx.x * (NT / 64) + w, nw = gridDim.x * (NT / 64);
    for (int ci = gw; ci < 64 * 64; ci += nw) {
        const int bh = ci >> 6, ch = ci & 63, b = bh >> 2, hd = bh & 3, s0 = ch * 32, t0 = b * S_ + s0;
        DN_LFENCE();
        if (lane < 32) { const float* sp = p.small + (size_t)(t0 + lane) * 16; t_gc[lane] = -__expf(p.ev_a_log[hd]) * softplus_fast(sp[hd] + p.ev_dt_bias[hd]); t_be[lane] = sigm(sp[4 + hd]); }
        DN_LFENCE();
        float gcs = 0.f;
        if (lane < 32) { for (int i = 0; i <= lane; ++i) gcs += t_gc[i]; }
        DN_LFENCE();
        if (lane < 32) { t_gc[lane] = gcs; t_ek[lane] = __expf(gcs); }
        DN_LFENCE();
        const float gc31 = t_gc[31];
        if (lane < 32) t_dk[lane] = __expf(gc31 - gcs);
        dn_conv_tile(proj, p.ev_conv_w, t0, s0, 1, hd, lane, tile);
        DN_LFENCE();
        dn_bf16x8 Kr[2][4];
#pragma unroll
        for (int mi = 0; mi < 2; ++mi)
#pragma unroll
            for (int s = 0; s < 4; ++s) Kr[mi][s] = *(const dn_bf16x8*)(tile + (16 * mi + c) * 136 + 32 * s + 8 * g);
        union U8 { dn_bf16x8 v; unsigned short e[8]; unsigned u[4]; };
        U8 KT[8];
#pragma unroll
        for (int mb = 0; mb < 8; ++mb)
#pragma unroll
            for (int jj = 0; jj < 8; ++jj) KT[mb].e[jj] = tile[(16 * (jj >> 2) + 4 * g + (jj & 3)) * 136 + 16 * mb + c];
        dn_f32x4 ak[2][2];
#pragma unroll
        for (int mi = 0; mi < 2; ++mi)
#pragma unroll
            for (int nj = 0; nj < 2; ++nj) { dn_f32x4 a = {0.f, 0.f, 0.f, 0.f};
#pragma unroll
                for (int s = 0; s < 4; ++s) a = dn_mfma(Kr[mi][s], Kr[nj][s], a);
                ak[mi][nj] = a; }
#pragma unroll
        for (int mi = 0; mi < 2; ++mi)
#pragma unroll
            for (int r = 0; r < 4; ++r) if (g == (c >> 2) && (c & 3) == r) t_rk[16 * mi + c] = rsqrtf(ak[mi][mi][r] + 1e-6f);
        DN_LFENCE();
#pragma unroll
        for (int mi = 0; mi < 2; ++mi)
#pragma unroll
            for (int nj = 0; nj < 2; ++nj)
#pragma unroll
                for (int r = 0; r < 4; ++r) { const int i = 16 * mi + 4 * g + r, j = 16 * nj + c;
                    const float v = (i > j) ? t_be[i] * t_rk[i] * t_rk[j] * ak[mi][nj][r] * __expf(t_gc[i] - t_gc[j]) : 0.f;
                    Lm[i * 36 + j] = v; }
        DN_LFENCE();
        {
            const int cc = lane & 31;
            float T[32];
#pragma unroll
            for (int i = 0; i < 32; ++i) {
                float acc = (i == cc) ? 1.f : 0.f;
#pragma unroll
                for (int j4 = 0; j4 < (i + 3) / 4; ++j4) { const dn_f32x4 lv = *(const dn_f32x4*)(Lm + i * 36 + 4 * j4);
#pragma unroll
                    for (int q = 0; q < 4; ++q) if (4 * j4 + q < i) acc -= lv[q] * T[4 * j4 + q]; }
                T[i] = acc;
            }
            if (lane < 32) {
#pragma unroll
                for (int i = 0; i < 32; ++i) Tm[i * 40 + cc] = f2bf(T[i]);
            }
        }
        DN_LFENCE();
        U8 Tr[2];
#pragma unroll
        for (int mi = 0; mi < 2; ++mi) { const uint2 lo = *(const uint2*)(Tm + (16 * mi + c) * 40 + 4 * g), hi = *(const uint2*)(Tm + (16 * mi + c) * 40 + 16 + 4 * g);
            Tr[mi].u[0] = lo.x; Tr[mi].u[1] = lo.y; Tr[mi].u[2] = hi.x; Tr[mi].u[3] = hi.y; }
        dn_conv_tile(proj, p.ev_conv_w, t0, s0, 0, hd, lane, tile);
        DN_LFENCE();
        dn_f32x4 as_[2][2];
        {
            dn_bf16x8 Qr[2][4];
#pragma unroll
            for (int ni = 0; ni < 2; ++ni)
#pragma unroll
                for (int s = 0; s < 4; ++s) Qr[ni][s] = *(const dn_bf16x8*)(tile + (16 * ni + c) * 136 + 32 * s + 8 * g);
#pragma unroll
            for (int mj = 0; mj < 2; ++mj)
#pragma unroll
                for (int ni = 0; ni < 2; ++ni) { dn_f32x4 a = {0.f, 0.f, 0.f, 0.f};
#pragma unroll
                    for (int s = 0; s < 4; ++s) a = dn_mfma(Kr[mj][s], Qr[ni][s], a);
                    as_[mj][ni] = a; }
#pragma unroll
            for (int ni = 0; ni < 2; ++ni) { dn_f32x4 a = {0.f, 0.f, 0.f, 0.f};
#pragma unroll
                for (int s = 0; s < 4; ++s) a = dn_mfma(Qr[ni][s], Qr[ni][s], a);
#pragma unroll
                for (int r = 0; r < 4; ++r) if (g == (c >> 2) && (c & 3) == r) t_rq[16 * ni + c] = rsqrtf(a[r] + 1e-6f) * 0.08838834764831845f; }
        }
        DN_LFENCE();
        { bf16_t* qo = d.QDp + (size_t)ci * 4096;
#pragma unroll
            for (int it = 0; it < 8; ++it) { const int id = it * 64 + lane, i = id >> 4, s = (id >> 2) & 3, gg = id & 3;
                const uint2 lo = *(const uint2*)(tile + i * 136 + 32 * s + 4 * gg), hi = *(const uint2*)(tile + i * 136 + 32 * s + 16 + 4 * gg);
                const float f = t_rq[i] * t_ek[i];
                uint4 o; o.x = dn_pk(__uint_as_float(lo.x << 16) * f, __uint_as_float(lo.x & 0xffff0000u) * f); o.y = dn_pk(__uint_as_float(lo.y << 16) * f, __uint_as_float(lo.y & 0xffff0000u) * f);
                o.z = dn_pk(__uint_as_float(hi.x << 16) * f, __uint_as_float(hi.x & 0xffff0000u) * f); o.w = dn_pk(__uint_as_float(hi.y << 16) * f, __uint_as_float(hi.y & 0xffff0000u) * f);
                *(uint4*)(qo + i * 128 + 32 * s + 8 * gg) = o; } }
        DN_LFENCE();
        dn_conv_tile(proj, p.ev_conv_w, t0, s0, 2, hd, lane, tile);
        DN_LFENCE();
        float bej[8], fwj[8], fkj[8];
#pragma unroll
        for (int jj = 0; jj < 8; ++jj) { const int j = 16 * (jj >> 2) + 4 * g + (jj & 3); const float rk = t_rk[j]; bej[jj] = t_be[j]; fwj[jj] = bej[jj] * rk * t_ek[j]; fkj[jj] = rk * t_dk[j]; }
        U8 VT[8];
#pragma unroll
        for (int nb = 0; nb < 8; ++nb) {
            float tv[8];
#pragma unroll
            for (int jj = 0; jj < 8; ++jj) tv[jj] = bf2f(tile[(16 * (jj >> 2) + 4 * g + (jj & 3)) * 136 + 16 * nb + c]) * bej[jj];
#pragma unroll
            for (int q = 0; q < 4; ++q) VT[nb].u[q] = dn_pk(tv[2 * q], tv[2 * q + 1]);
        }
        { bf16_t* uo = d.UTp + (size_t)ci * 4096;
#pragma unroll
            for (int nb = 0; nb < 8; ++nb)
#pragma unroll
                for (int mi = 0; mi < 2; ++mi) { const dn_f32x4 z4 = {0.f, 0.f, 0.f, 0.f}; const dn_f32x4 a = dn_mfma(Tr[mi].v, VT[nb].v, z4);
                    uint2 o; o.x = dn_pk(a[0], a[1]); o.y = dn_pk(a[2], a[3]); *(uint2*)(uo + (16 * nb + c) * 32 + 16 * mi + 4 * g) = o; } }
        { bf16_t* ko = d.KDTp + (size_t)ci * 4096; bf16_t* wo = d.Wp + (size_t)ci * 4096;
#pragma unroll
            for (int s = 0; s < 4; ++s) {
                U8 kw[2];
#pragma unroll
                for (int hf = 0; hf < 2; ++hf) { const int mb = 2 * s + hf; float kv[8];
#pragma unroll
                    for (int jj = 0; jj < 8; ++jj) kv[jj] = bf2f(KT[mb].e[jj]);
                    uint4 o; o.x = dn_pk(kv[0] * fkj[0], kv[1] * fkj[1]); o.y = dn_pk(kv[2] * fkj[2], kv[3] * fkj[3]); o.z = dn_pk(kv[4] * fkj[4], kv[5] * fkj[5]); o.w = dn_pk(kv[6] * fkj[6], kv[7] * fkj[7]);
                    *(uint4*)(ko + (16 * mb + c) * 32 + 8 * g) = o;
#pragma unroll
                    for (int q = 0; q < 4; ++q) kw[hf].u[q] = dn_pk(kv[2 * q] * fwj[2 * q], kv[2 * q + 1] * fwj[2 * q + 1]); }
#pragma unroll
                for (int ni = 0; ni < 2; ++ni) { const dn_f32x4 z4 = {0.f, 0.f, 0.f, 0.f};
                    const dn_f32x4 c0 = dn_mfma(kw[0].v, Tr[ni].v, z4), c1 = dn_mfma(kw[1].v, Tr[ni].v, z4);
                    uint4 o; o.x = dn_pk(c0[0], c0[1]); o.y = dn_pk(c0[2], c0[3]); o.z = dn_pk(c1[0], c1[1]); o.w = dn_pk(c1[2], c1[3]);
                    *(uint4*)(wo + (16 * ni + c) * 128 + 32 * s + 8 * g) = o; }
            } }
        { bf16_t* qo = d.QKp + (size_t)ci * 1024;
#pragma unroll
            for (int ni = 0; ni < 2; ++ni) { const int i = 16 * ni + c; const float rq = t_rq[i], gi = t_gc[i]; float v[8];
#pragma unroll
                for (int mj = 0; mj < 2; ++mj)
#pragma unroll
                    for (int r = 0; r < 4; ++r) { const int j = 16 * mj + 4 * g + r; v[4 * mj + r] = (i >= j) ? as_[mj][ni][r] * rq * t_rk[j] * __expf(gi - t_gc[j]) : 0.f; }
                uint4 o; o.x = dn_pk(v[0], v[1]); o.y = dn_pk(v[2], v[3]); o.z = dn_pk(v[4], v[5]); o.w = dn_pk(v[6], v[7]);
                *(uint4*)(qo + i * 32 + 8 * g) = o; } }
        if (lane == 0) d.GL[ci] = __expf(gc31);
    }
    __syncthreads();
}

#define DN_DECL(R) uint4 R##w, R##qd, R##kdt, R##ut, R##qk, R##z; float R##gl
#define DN_LOAD(R, ci_, trow_) do { const size_t _ci = (ci_); \
    R##w = *(const uint4*)(d.Wp + _ci * 4096 + tid * 8); R##qd = *(const uint4*)(d.QDp + _ci * 4096 + tid * 8); R##kdt = *(const uint4*)(d.KDTp + _ci * 4096 + tid * 8); \
    R##ut = *(const uint4*)(d.UTp + _ci * 4096 + tid * 8); R##qk = *(const uint4*)(d.QKp + _ci * 1024 + (tid & 127) * 8); R##gl = d.GL[_ci]; \
    R##z = *(const uint4*)(proj + (size_t)(trow_) * EVN + 1536 + hd * 128 + (tid & 15) * 8); } while (0)
#define DN_WRITE(R, bb_) do { unsigned char* _bb = (bb_); \
    *(uint4*)(_bb + (tid >> 4) * 272 + (tid & 15) * 16) = R##w; *(uint4*)(_bb + 8704 + (tid >> 4) * 272 + (tid & 15) * 16) = R##qd; \
    *(uint4*)(_bb + 17408 + tid * 16) = R##kdt; *(uint4*)(_bb + 25600 + tid * 16) = R##ut; if (tid < 128) *(uint4*)(_bb + 33792 + tid * 16) = R##qk; } while (0)
__device__ __forceinline__ void dn_step_compute(dn_f32x4 (&Sf)[8], const unsigned char* bb, float* Ot, float gl, int w, int c, int g) {
    union U8 { dn_bf16x8 v; unsigned u[4]; };
    U8 Sb[4];
#pragma unroll
    for (int s = 0; s < 4; ++s) { Sb[s].u[0] = dn_pk(Sf[2 * s][0], Sf[2 * s][1]); Sb[s].u[1] = dn_pk(Sf[2 * s][2], Sf[2 * s][3]); Sb[s].u[2] = dn_pk(Sf[2 * s + 1][0], Sf[2 * s + 1][1]); Sb[s].u[3] = dn_pk(Sf[2 * s + 1][2], Sf[2 * s + 1][3]); }
    dn_f32x4 vn[2], O[2];
#pragma unroll
    for (int mi = 0; mi < 2; ++mi) {
        dn_f32x4 P = {0.f, 0.f, 0.f, 0.f}, Oa = {0.f, 0.f, 0.f, 0.f};
#pragma unroll
        for (int s = 0; s < 4; ++s) { const dn_bf16x8 wa = *(const dn_bf16x8*)(bb + (16 * mi + c) * 272 + 64 * s + 16 * g); P = dn_mfma(wa, Sb[s].v, P);
            const dn_bf16x8 qa = *(const dn_bf16x8*)(bb + 8704 + (16 * mi + c) * 272 + 64 * s + 16 * g); Oa = dn_mfma(qa, Sb[s].v, Oa); }
        const uint2 uu = *(const uint2*)(bb + 25600 + (16 * w + c) * 64 + (16 * mi + 4 * g) * 2);
        vn[mi][0] = __uint_as_float(uu.x << 16) - P[0]; vn[mi][1] = __uint_as_float(uu.x & 0xffff0000u) - P[1]; vn[mi][2] = __uint_as_float(uu.y << 16) - P[2]; vn[mi][3] = __uint_as_float(uu.y & 0xffff0000u) - P[3];
        O[mi] = Oa;
    }
    U8 Vb; Vb.u[0] = dn_pk(vn[0][0], vn[0][1]); Vb.u[1] = dn_pk(vn[0][2], vn[0][3]); Vb.u[2] = dn_pk(vn[1][0], vn[1][1]); Vb.u[3] = dn_pk(vn[1][2], vn[1][3]);
#pragma unroll
    for (int mi = 0; mi < 2; ++mi) { const dn_bf16x8 qk = *(const dn_bf16x8*)(bb + 33792 + (16 * mi + c) * 64 + 16 * g); O[mi] = dn_mfma(qk, Vb.v, O[mi]);
#pragma unroll
        for (int r = 0; r < 4; ++r) Ot[(16 * mi + 4 * g + r) * 132 + 16 * w + c] = O[mi][r]; }
#pragma unroll
    for (int mb = 0; mb < 8; ++mb) { const dn_bf16x8 ka = *(const dn_bf16x8*)(bb + 17408 + (16 * mb + c) * 64 + 16 * g); Sf[mb] = dn_mfma(ka, Vb.v, Sf[mb] * gl); }
}
__device__ __forceinline__ void dn_step_norm(const float* Ot, uint4 zz, const float4 g0, const float4 g1, bf16_t* __restrict__ omix, size_t t, int hd, int tid) {
    const int row = tid >> 4, sub = tid & 15;
    const dn_f32x4 o0 = *(const dn_f32x4*)(Ot + row * 132 + sub * 8), o1 = *(const dn_f32x4*)(Ot + row * 132 + sub * 8 + 4);
    float ss = o0[0] * o0[0] + o0[1] * o0[1] + o0[2] * o0[2] + o0[3] * o0[3] + o1[0] * o1[0] + o1[1] * o1[1] + o1[2] * o1[2] + o1[3] * o1[3];
    ss += dppf<0xB1>(ss); ss += dppf<0x4E>(ss); ss += dppf<0x141>(ss); ss += dppf<0x140>(ss);
    const float rstd = rsqrtf(ss * (1.f / 128.f) + 1e-6f);
    uint4 ov;
    ov.x = dn_pk(o0[0] * rstd * g0.x * siluf(__uint_as_float(zz.x << 16)), o0[1] * rstd * g0.y * siluf(__uint_as_float(zz.x & 0xffff0000u)));
    ov.y = dn_pk(o0[2] * rstd * g0.z * siluf(__uint_as_float(zz.y << 16)), o0[3] * rstd * g0.w * siluf(__uint_as_float(zz.y & 0xffff0000u)));
    ov.z = dn_pk(o1[0] * rstd * g1.x * siluf(__uint_as_float(zz.z << 16)), o1[1] * rstd * g1.y * siluf(__uint_as_float(zz.z & 0xffff0000u)));
    ov.w = dn_pk(o1[2] * rstd * g1.z * siluf(__uint_as_float(zz.w << 16)), o1[3] * rstd * g1.w * siluf(__uint_as_float(zz.w & 0xffff0000u)));
    *(uint4*)(omix + (t + row) * 1024 + hd * 128 + sub * 8) = ov;
}
__device__ __forceinline__ void ph_dn_scan(const int WV, CParams& p, const bf16_t* __restrict__ proj, const DnBufs d, bf16_t* __restrict__ omix, unsigned char* smem) {
    const int tid = otid(WV), lane = tid & 63, w = tid >> 6, c = lane & 15, g = lane >> 4;
    constexpr int BUF = 35840, OFF_O = 2 * BUF, OSZ = 32 * 132 * 4;
    for (int bh = blockIdx.x; bh < 64; bh += gridDim.x) {
        const int b = bh >> 2, hd = bh & 3; const size_t ci0 = (size_t)bh * 64, tr0 = (size_t)b * S_ + (tid >> 4);
        dn_f32x4 Sf[8];
#pragma unroll
        for (int mb = 0; mb < 8; ++mb) Sf[mb] = (dn_f32x4){0.f, 0.f, 0.f, 0.f};
        const float4 og0 = *(const float4*)(p.ev_onorm_g + (tid & 15) * 8), og1 = *(const float4*)(p.ev_onorm_g + (tid & 15) * 8 + 4);
        DN_DECL(R0); DN_DECL(R1);
        DN_LOAD(R0, ci0, tr0);
        DN_LOAD(R1, ci0 + 1, tr0 + 32);
        __syncthreads();
        DN_WRITE(R0, smem);
        float gl0 = R0gl; uint4 z0 = R0z;
        __syncthreads();
        for (int ch = 0; ch < 64; ch += 2) {
            const int n2 = min(ch + 2, 63), n3 = min(ch + 3, 63);
            DN_LOAD(R0, ci0 + n2, tr0 + (size_t)n2 * 32);
            dn_step_compute(Sf, smem, (float*)(smem + OFF_O), gl0, w, c, g);
            DN_WRITE(R1, smem + BUF);
            const float gl1 = R1gl; const uint4 z1 = R1z;
            __syncthreads();
            dn_step_norm((const float*)(smem + OFF_O), z0, og0, og1, omix, (size_t)b * S_ + ch * 32, hd, tid);
            DN_LOAD(R1, ci0 + n3, tr0 + (size_t)n3 * 32);
            dn_step_compute(Sf, smem + BUF, (float*)(smem + OFF_O + OSZ), gl1, w, c, g);
            DN_WRITE(R0, smem); gl0 = R0gl; z0 = R0z;
            __syncthreads();
            dn_step_norm((const float*)(smem + OFF_O + OSZ), z1, og0, og1, omix, (size_t)b * S_ + (ch + 1) * 32, hd, tid);
        }
        __syncthreads();
    }
}

__device__ __forceinline__ void ph_small_gemm(const int WV, CParams& p, unsigned char* smem) {
    const int tid = otid(WV), lane = tid & 63, c = lane & 15, g4 = lane >> 4;
    constexpr int RP = 1032;
    bf16_t* Ws = (bf16_t*)smem;
    __syncthreads();
    for (int i = tid; i < 16 * 128; i += NT) { const int r = i >> 7, ch = i & 127; *(uint4*)(Ws + r * RP + ch * 8) = *(const uint4*)(p.W_evin + (size_t)(3584 + r) * 1024 + ch * 8); }
    __syncthreads();
    const int gw = blockIdx.x * (NT / 64) + (tid >> 6), nw = gridDim.x * (NT / 64);
    for (int rb = gw; rb < T_ / 16; rb += nw) {
        const bf16_t* ap = p.H + (size_t)(rb * 16 + c) * 1024 + 8 * g4;
        dn_f32x4 acc = {0.f, 0.f, 0.f, 0.f};
#pragma unroll
        for (int kb = 0; kb < 2; ++kb) {
            dn_bf16x8 af[16];
#pragma unroll
            for (int ks = 0; ks < 16; ++ks) af[ks] = *(const dn_bf16x8*)(ap + 32 * (kb * 16 + ks));
#pragma unroll
            for (int ks = 0; ks < 16; ++ks) acc = dn_mfma(af[ks], *(const dn_bf16x8*)(Ws + c * RP + 32 * (kb * 16 + ks) + 8 * g4), acc);
        }
#pragma unroll
        for (int r = 0; r < 4; ++r) p.small[(size_t)(rb * 16 + 4 * g4 + r) * 16 + c] = acc[r];
    }
    __syncthreads();
}
__device__ __forceinline__ uint4 fx_knorm(uint4 v, const float* __restrict__ gp) {
    const float4 ga = *(const float4*)gp, gb = *(const float4*)(gp + 4); const float g[8] = {ga.x, ga.y, ga.z, ga.w, gb.x, gb.y, gb.z, gb.w};
    const unsigned u[4] = {v.x, v.y, v.z, v.w}; float f[8]; float ss = 0.f;
#pragma unroll
    for (int k = 0; k < 4; ++k) { f[2 * k] = __uint_as_float(u[k] << 16); f[2 * k + 1] = __uint_as_float(u[k] & 0xffff0000u); ss += f[2 * k] * f[2 * k] + f[2 * k + 1] * f[2 * k + 1]; }
    ss += dppf<0xB1>(ss); ss += dppf<0x4E>(ss); ss += dppf<0x141>(ss); ss += dppf<0x140>(ss);
    const float r = rsqrtf(ss * (1.f / 128.f) + 1e-6f);
    uint4 o; o.x = pk_bf16(f[0] * r * g[0], f[1] * r * g[1]); o.y = pk_bf16(f[2] * r * g[2], f[3] * r * g[3]); o.z = pk_bf16(f[4] * r * g[4], f[5] * r * g[5]); o.w = pk_bf16(f[6] * r * g[6], f[7] * r * g[7]);
    return o;
}
__device__ __forceinline__ void ph_foxpre(const int WV, CParams& p, const bf16_t* __restrict__ proj, bf16_t* __restrict__ fk, bf16_t* __restrict__ vt, unsigned char* smem) {
    const int tix_ = otid(WV);
    bf16_t* tile = (bf16_t*)smem;
    for (int item = blockIdx.x; item < 64 * 32; item += gridDim.x) {
        const int bh = item >> 5, st = item & 31, bb = bh >> 2, hd = bh & 3, t0 = bb * S_ + st * 64;
        __syncthreads();
#pragma unroll
        for (int i = 0; i < 2; ++i) { const int id = tix_ + i * NT, r = id >> 4, c16 = id & 15;
            const uint4 kv = *(const uint4*)(proj + (size_t)(t0 + r) * EVN + 2560 + hd * 128 + c16 * 8);
            *(uint4*)(fk + ((size_t)bh * S_ + st * 64 + r) * 128 + c16 * 8) = fx_knorm(kv, p.ev_knorm_g + c16 * 8); }
#pragma unroll
        for (int i = 0; i < 2; ++i) { const int id = tix_ + i * NT, r = id >> 4, c16 = id & 15;
            const uint4 v = *(const uint4*)(proj + (size_t)(t0 + r) * EVN + 3072 + hd * 128 + c16 * 8);
            unsigned* d = (unsigned*)(tile + r * 130 + c16 * 8); d[0] = v.x; d[1] = v.y; d[2] = v.z; d[3] = v.w; }
        __syncthreads();
        { const int d = tix_ >> 2, qt = tix_ & 3; unsigned w[8];
#pragma unroll
            for (int i = 0; i < 8; ++i) w[i] = (unsigned)tile[(qt * 16 + 2 * i) * 130 + d] | ((unsigned)tile[(qt * 16 + 2 * i + 1) * 130 + d] << 16);
            uint4* dst = (uint4*)(vt + ((size_t)bh * 128 + d) * S_ + st * 64 + qt * 16);
            dst[0] = make_uint4(w[0], w[1], w[2], w[3]); dst[1] = make_uint4(w[4], w[5], w[6], w[7]); }
    }
    __syncthreads();
}
__device__ __forceinline__ void ph_cumsum(const int WV, CParams& p, unsigned char* smem) {
    const int tix_ = otid(WV);
    const int lane = tix_ & 63, w = tix_ >> 6, wv = (blockIdx.x * NT + tix_) >> 6, nw = gridDim.x * (NT / 64);
    float* part = (float*)smem + w * 64;
    for (int bh = wv; bh < 64; bh += nw) {
        const int b = bh >> 2, h = bh & 3;
        float loc[32]; float run = 0.f;
#pragma unroll
        for (int i = 0; i < 32; ++i) { run += -softplus_fast(-(p.small[(size_t)(b * S_ + lane * 32 + i) * 16 + 8 + h] + p.ev_f_bias[h])); loc[i] = run; }
        asm volatile("s_waitcnt lgkmcnt(0)" ::: "memory");
        part[lane] = run;
        asm volatile("s_waitcnt lgkmcnt(0)" ::: "memory");
        float excl = 0.f;
        for (int i = 0; i < lane; ++i) excl += part[i];
#pragma unroll
        for (int i = 0; i < 32; ++i) p.cum[(size_t)(b * S_ + lane * 32 + i) * 4 + h] = loc[i] + excl;
    }
    __syncthreads();
}

typedef short fx_bf16x8 __attribute__((ext_vector_type(8)));
typedef float fx_f32x16 __attribute__((ext_vector_type(16)));
typedef float fx_f32x4 __attribute__((ext_vector_type(4)));
__device__ __forceinline__ unsigned fx_pk(float lo, float hi) { return pk_bf16(lo, hi); }
__device__ __forceinline__ void ph_fox_flash(const int WV, CParams& p, const bf16_t* __restrict__ proj, const bf16_t* __restrict__ fk, const bf16_t* __restrict__ vt, bf16_t* __restrict__ omix, unsigned char* smem) {
    const int tid = otid(WV), lane = tid & 63, w = tid >> 6, c = lane & 31, h5 = lane >> 5;
    constexpr int KB = 16384, VB = 128 * 136, OFF_V = 2 * KB, OFF_B = OFF_V + 2 * VB, OFF_I = OFF_B + 2 * 256;
    constexpr float C2 = 0.08838834764831845f * 1.4426950408889634f, NEG_INV_SCALE = -11.313708498984761f;
    int* itemw = (int*)(smem + OFF_I);
    for (;;) {
        __syncthreads();
        if (tid == 0) itemw[0] = atomicAdd(p.cnt + 32, 1);
        __syncthreads();
        const int idx = itemw[0];
        if (idx >= 512) break;
        const int qb = 7 - (idx >> 6), bh = idx & 63, b = bh >> 2, hd = bh & 3;
        const int q0 = qb * 256 + w * 32, ntiles = 4 * (qb + 1);
        fx_bf16x8 qf[8];
        { const bf16_t* qp = proj + ((size_t)(b * S_ + q0 + c)) * EVN + 2048 + hd * 128 + 8 * h5;
          float ssq = 0.f;
#pragma unroll
          for (int s = 0; s < 8; ++s) { qf[s] = *(const fx_bf16x8*)(qp + 16 * s);
#pragma unroll
              for (int j = 0; j < 8; ++j) { const float v = bf2f((bf16_t)qf[s][j]); ssq += v * v; } }
          { auto rr = __builtin_amdgcn_permlane32_swap(__float_as_uint(ssq), __float_as_uint(ssq), false, false); ssq = __uint_as_float(rr[0]) + __uint_as_float(rr[1]); }
          const float rq = rsqrtf(ssq * (1.f / 128.f) + 1e-6f);
#pragma unroll
          for (int s = 0; s < 8; ++s) { const float4 g0 = *(const float4*)(p.ev_qnorm_g + 16 * s + 8 * h5), g1 = *(const float4*)(p.ev_qnorm_g + 16 * s + 8 * h5 + 4);
              union { fx_bf16x8 v; unsigned u[4]; } t;
              t.u[0] = pk_bf16(bf2f((bf16_t)qf[s][0]) * rq * g0.x, bf2f((bf16_t)qf[s][1]) * rq * g0.y); t.u[1] = pk_bf16(bf2f((bf16_t)qf[s][2]) * rq * g0.z, bf2f((bf16_t)qf[s][3]) * rq * g0.w);
              t.u[2] = pk_bf16(bf2f((bf16_t)qf[s][4]) * rq * g1.x, bf2f((bf16_t)qf[s][5]) * rq * g1.y); t.u[3] = pk_bf16(bf2f((bf16_t)qf[s][6]) * rq * g1.z, bf2f((bf16_t)qf[s][7]) * rq * g1.w);
              qf[s] = t.v; } }
        fx_f32x16 o[4];
#pragma unroll
        for (int mb = 0; mb < 4; ++mb)
#pragma unroll
            for (int r = 0; r < 16; ++r) o[mb][r] = 0.f;
        float m = -1e30f, l = 0.f;
        const float ct2 = p.cum[(size_t)(b * S_ + q0 + c) * 4 + hd] * 1.4426950408889634f;
        const bf16_t* kg = fk + (size_t)bh * S_ * 128;
        const bf16_t* vg = vt + (size_t)bh * 128 * S_;
        uint4 kr0, kr1, vr0, vr1; float br = 0.f;
        const int idA = tid, idB = tid + NT;
        kr0 = *(const uint4*)(kg + (size_t)(idA >> 4) * 128 + (idA & 15) * 8); kr1 = *(const uint4*)(kg + (size_t)(idB >> 4) * 128 + (idB & 15) * 8);
        vr0 = *(const uint4*)(vg + (size_t)(idA >> 3) * S_ + (idA & 7) * 8); vr1 = *(const uint4*)(vg + (size_t)(idB >> 3) * S_ + (idB & 7) * 8);
        if (tid < 64) br = p.cum[(size_t)(b * S_ + tid) * 4 + hd] * NEG_INV_SCALE;
        { const int rA = idA >> 4, chA = idA & 15, rB = idB >> 4, chB = idB & 15;
          *(uint4*)(smem + rA * 256 + ((chA ^ (rA & 15)) << 4)) = kr0; *(uint4*)(smem + rB * 256 + ((chB ^ (rB & 15)) << 4)) = kr1;
          uint2* vd = (uint2*)(smem + OFF_V + (idA >> 3) * 136 + (idA & 7) * 16); vd[0] = make_uint2(vr0.x, vr0.y); vd[1] = make_uint2(vr0.z, vr0.w);
          vd = (uint2*)(smem + OFF_V + (idB >> 3) * 136 + (idB & 7) * 16); vd[0] = make_uint2(vr1.x, vr1.y); vd[1] = make_uint2(vr1.z, vr1.w); }
        if (tid < 64) ((float*)(smem + OFF_B))[tid] = br;
        __syncthreads();
        for (int t = 0; t < ntiles; ++t) {
            const int cur = t & 1;
            if (t + 1 < ntiles) {
                const int k0 = (t + 1) * 64;
                kr0 = *(const uint4*)(kg + (size_t)(k0 + (idA >> 4)) * 128 + (idA & 15) * 8); kr1 = *(const uint4*)(kg + (size_t)(k0 + (idB >> 4)) * 128 + (idB & 15) * 8);
                vr0 = *(const uint4*)(vg + (size_t)(idA >> 3) * S_ + k0 + (idA & 7) * 8); vr1 = *(const uint4*)(vg + (size_t)(idB >> 3) * S_ + k0 + (idB & 7) * 8);
                if (tid < 64) br = p.cum[(size_t)(b * S_ + k0 + tid) * 4 + hd] * NEG_INV_SCALE;
            }
            const int kbase = t * 64;
            if (kbase <= q0) {
                const unsigned char* Kt = smem + cur * KB; const unsigned char* Vt = smem + OFF_V + cur * VB; const float* Bt = (const float*)(smem + OFF_B + cur * 256);
                const bool two = (kbase + 32 <= q0);
                fx_f32x16 sA, sB;
#pragma unroll
                for (int g = 0; g < 4; ++g) { const fx_f32x4 bv = *(const fx_f32x4*)(Bt + 8 * g + 4 * h5);
                    sA[4 * g] = bv[0]; sA[4 * g + 1] = bv[1]; sA[4 * g + 2] = bv[2]; sA[4 * g + 3] = bv[3]; }
#pragma unroll
                for (int s = 0; s < 8; ++s) { const fx_bf16x8 ka = *(const fx_bf16x8*)(Kt + c * 256 + (((2 * s + h5) ^ (c & 15)) << 4));
                    sA = __builtin_amdgcn_mfma_f32_32x32x16_bf16(ka, qf[s], sA, 0, 0, 0); }
                if (two) {
#pragma unroll
                    for (int g = 0; g < 4; ++g) { const fx_f32x4 bv = *(const fx_f32x4*)(Bt + 32 + 8 * g + 4 * h5);
                        sB[4 * g] = bv[0]; sB[4 * g + 1] = bv[1]; sB[4 * g + 2] = bv[2]; sB[4 * g + 3] = bv[3]; }
#pragma unroll
                    for (int s = 0; s < 8; ++s) { const fx_bf16x8 ka = *(const fx_bf16x8*)(Kt + (32 + c) * 256 + (((2 * s + h5) ^ (c & 15)) << 4));
                        sB = __builtin_amdgcn_mfma_f32_32x32x16_bf16(ka, qf[s], sB, 0, 0, 0); }
                } else {
#pragma unroll
                    for (int r = 0; r < 16; ++r) sB[r] = -__builtin_inff();
                }
                if (kbase + 31 > q0) { const int d0 = kbase - q0 + 4 * h5 - c;
#pragma unroll
                    for (int r = 0; r < 16; ++r) if (d0 + (r & 3) + 8 * (r >> 2) > 0) sA[r] = -__builtin_inff(); }
                if (two && kbase + 63 > q0) { const int d0 = kbase + 32 - q0 + 4 * h5 - c;
#pragma unroll
                    for (int r = 0; r < 16; ++r) if (d0 + (r & 3) + 8 * (r >> 2) > 0) sB[r] = -__builtin_inff(); }
                float mx = sA[0];
#pragma unroll
                for (int r = 1; r < 16; ++r) mx = fmaxf(mx, sA[r]);
#pragma unroll
                for (int r = 0; r < 16; ++r) mx = fmaxf(mx, sB[r]);
                { auto rr = __builtin_amdgcn_permlane32_swap(__float_as_uint(mx), __float_as_uint(mx), false, false); mx = fmaxf(__uint_as_float(rr[0]), __uint_as_float(rr[1])); }
                const float mc = fmaf(mx, C2, ct2);
                if (!__all(mc - m <= 8.f)) {
                    const float mn = fmaxf(m, mc); const float alpha = __builtin_amdgcn_exp2f(m - mn); m = mn; l *= alpha;
#pragma unroll
                    for (int mb = 0; mb < 4; ++mb)
#pragma unroll
                        for (int r = 0; r < 16; ++r) o[mb][r] *= alpha;
                }
                const float dm = ct2 - m;
                float ps = 0.f;
#pragma unroll
                for (int r = 0; r < 16; ++r) { sA[r] = __builtin_amdgcn_exp2f(fmaf(sA[r], C2, dm)); ps += sA[r]; }
#pragma unroll
                for (int r = 0; r < 16; ++r) { sB[r] = __builtin_amdgcn_exp2f(fmaf(sB[r], C2, dm)); ps += sB[r]; }
                l += ps;
#pragma unroll
                for (int s2 = 0; s2 < 2; ++s2) {
                    union { fx_bf16x8 v; unsigned u[4]; } pb;
#pragma unroll
                    for (int j = 0; j < 4; ++j) pb.u[j] = fx_pk(sA[8 * s2 + 2 * j], sA[8 * s2 + 2 * j + 1]);
#pragma unroll
                    for (int mb = 0; mb < 4; ++mb) { const unsigned char* vp = Vt + (mb * 32 + c) * 136 + (16 * s2 + 4 * h5) * 2;
                        union { fx_bf16x8 v; uint2 q[2]; } va; va.q[0] = *(const uint2*)vp; va.q[1] = *(const uint2*)(vp + 16);
                        o[mb] = __builtin_amdgcn_mfma_f32_32x32x16_bf16(va.v, pb.v, o[mb], 0, 0, 0); }
                }
                if (two) {
#pragma unroll
                    for (int s2 = 0; s2 < 2; ++s2) {
                        union { fx_bf16x8 v; unsigned u[4]; } pb;
#pragma unroll
                        for (int j = 0; j < 4; ++j) pb.u[j] = fx_pk(sB[8 * s2 + 2 * j], sB[8 * s2 + 2 * j + 1]);
#pragma unroll
                        for (int mb = 0; mb < 4; ++mb) { const unsigned char* vp = Vt + (mb * 32 + c) * 136 + (32 + 16 * s2 + 4 * h5) * 2;
                            union { fx_bf16x8 v; uint2 q[2]; } va; va.q[0] = *(const uint2*)vp; va.q[1] = *(const uint2*)(vp + 16);
                            o[mb] = __builtin_amdgcn_mfma_f32_32x32x16_bf16(va.v, pb.v, o[mb], 0, 0, 0); }
                    }
                }
            }
            if (t + 1 < ntiles) {
                const int nb = cur ^ 1; const int rA = idA >> 4, chA = idA & 15, rB = idB >> 4, chB = idB & 15;
                *(uint4*)(smem + nb * KB + rA * 256 + ((chA ^ (rA & 15)) << 4)) = kr0; *(uint4*)(smem + nb * KB + rB * 256 + ((chB ^ (rB & 15)) << 4)) = kr1;
                uint2* vd = (uint2*)(smem + OFF_V + nb * VB + (idA >> 3) * 136 + (idA & 7) * 16); vd[0] = make_uint2(vr0.x, vr0.y); vd[1] = make_uint2(vr0.z, vr0.w);
                vd = (uint2*)(smem + OFF_V + nb * VB + (idB >> 3) * 136 + (idB & 7) * 16); vd[0] = make_uint2(vr1.x, vr1.y); vd[1] = make_uint2(vr1.z, vr1.w);
                if (tid < 64) ((float*)(smem + OFF_B + nb * 256))[tid] = br;
            }
            __syncthreads();
        }
        { auto rr = __builtin_amdgcn_permlane32_swap(__float_as_uint(l), __float_as_uint(l), false, false); l = __uint_as_float(rr[0]) + __uint_as_float(rr[1]); }
        const float inv = 1.f / l;
        bf16_t* op = omix + (size_t)(b * S_ + q0 + c) * 1024 + 512 + hd * 128 + 4 * h5;
#pragma unroll
        for (int mb = 0; mb < 4; ++mb)
#pragma unroll
            for (int g = 0; g < 4; ++g) { uint2 ov; ov.x = fx_pk(o[mb][4 * g] * inv, o[mb][4 * g + 1] * inv); ov.y = fx_pk(o[mb][4 * g + 2] * inv, o[mb][4 * g + 3] * inv);
                *(uint2*)(op + mb * 32 + 8 * g) = ov; }
    }
}

__device__ __forceinline__ void ph_route(const int WV, CParams& p, const bf16_t* __restrict__ x, const float* __restrict__ g, const float* __restrict__ sc, const float* __restrict__ sh, bf16_t* __restrict__ h2, unsigned char* smem) {
    const int tix_ = otid(WV);
    const int lane = tix_ & 63, w = tix_ >> 6, c = lane & 15, g4 = lane >> 4;
    constexpr int RP = 1032;
    bf16_t* Rhi = (bf16_t*)smem;
    bf16_t* Rlo = Rhi + 16 * RP;
    float* mv = (float*)(smem + 2 * 16 * RP * 2);
    float* sv = mv + 1024;
    float* lgs = sv + 1024;
    int* selE = (int*)(lgs + 128 * 16);
    float* selW = (float*)(selE + 128);
    int* lcnt = (int*)(selW + 256);
    int* lbase = lcnt + 16;
    __syncthreads();
    for (int i = tix_; i < 16384; i += NT) { const int k = i >> 4, e = i & 15; const float r = p.router_w[i]; const bf16_t hi = f2bf(r); Rhi[e * RP + k] = hi; Rlo[e * RP + k] = f2bf(r - bf2f(hi)); }
    for (int chunk = blockIdx.x; chunk < T_ / 128; chunk += gridDim.x) {
        const int b = (chunk * 128) >> 11;
        __syncthreads();
        for (int k = tix_; k < 1024; k += NT) { mv[k] = g[k] * (1.f + sc[b * 6144 + k]); sv[k] = sh[b * 6144 + k]; }
        if (tix_ < 16) lcnt[tix_] = 0;
        __syncthreads();
        const int t = chunk * 128 + w * 16 + c;
        const bf16_t* xr = x + (size_t)t * 1024 + 8 * g4;
        float ss = 0.f;
#pragma unroll 8
        for (int s = 0; s < 32; ++s) { const uint4 xw = *(const uint4*)(xr + 32 * s); const unsigned u[4] = {xw.x, xw.y, xw.z, xw.w};
#pragma unroll
            for (int q = 0; q < 4; ++q) { const float a = __uint_as_float(u[q] << 16), bq = __uint_as_float(u[q] & 0xffff0000u); ss += a * a + bq * bq; } }
        { auto r = __builtin_amdgcn_permlane16_swap(__float_as_uint(ss), __float_as_uint(ss), false, false); ss = __uint_as_float(r[0]) + __uint_as_float(r[1]); }
        { auto r = __builtin_amdgcn_permlane32_swap(__float_as_uint(ss), __float_as_uint(ss), false, false); ss = __uint_as_float(r[0]) + __uint_as_float(r[1]); }
        const float rstd = rsqrtf(ss * (1.f / 1024.f) + 1e-6f);
        dn_f32x4 acc = {0.f, 0.f, 0.f, 0.f};
#pragma unroll 4
        for (int s = 0; s < 32; ++s) {
            const int k0 = 32 * s + 8 * g4;
            const uint4 xw = *(const uint4*)(xr + 32 * s); const unsigned u[4] = {xw.x, xw.y, xw.z, xw.w};
            const float4 m0 = *(const float4*)(mv + k0), m1 = *(const float4*)(mv + k0 + 4), s0 = *(const float4*)(sv + k0), s1 = *(const float4*)(sv + k0 + 4);
            float hv[8];
            hv[0] = __uint_as_float(u[0] << 16) * rstd * m0.x + s0.x; hv[1] = __uint_as_float(u[0] & 0xffff0000u) * rstd * m0.y + s0.y;
            hv[2] = __uint_as_float(u[1] << 16) * rstd * m0.z + s0.z; hv[3] = __uint_as_float(u[1] & 0xffff0000u) * rstd * m0.w + s0.w;
            hv[4] = __uint_as_float(u[2] << 16) * rstd * m1.x + s1.x; hv[5] = __uint_as_float(u[2] & 0xffff0000u) * rstd * m1.y + s1.y;
            hv[6] = __uint_as_float(u[3] << 16) * rstd * m1.z + s1.z; hv[7] = __uint_as_float(u[3] & 0xffff0000u) * rstd * m1.w + s1.w;
            union { dn_bf16x8 v; unsigned q[4]; uint4 w4; } ahi, alo;
#pragma unroll
            for (int q = 0; q < 4; ++q) { ahi.q[q] = pk_bf16(hv[2 * q], hv[2 * q + 1]);
                alo.q[q] = pk_bf16(hv[2 * q] - __uint_as_float(ahi.q[q] << 16), hv[2 * q + 1] - __uint_as_float(ahi.q[q] & 0xffff0000u)); }
            *(uint4*)(h2 + (size_t)t * 1024 + k0) = ahi.w4;
            const dn_bf16x8 bhi = *(const dn_bf16x8*)(Rhi + c * RP + k0), blo = *(const dn_bf16x8*)(Rlo + c * RP + k0);
            acc = dn_mfma(ahi.v, bhi, acc); acc = dn_mfma(ahi.v, blo, acc); acc = dn_mfma(alo.v, bhi, acc);
        }
#pragma unroll
        for (int r = 0; r < 4; ++r) lgs[(w * 16 + 4 * g4 + r) * 16 + c] = acc[r];
        asm volatile("s_waitcnt lgkmcnt(0)" ::: "memory");
        if (lane < 16) {
            const int kt = lane; float lgv[16];
#pragma unroll
            for (int q = 0; q < 4; ++q) { const float4 v = *(const float4*)(lgs + (w * 16 + kt) * 16 + 4 * q); lgv[4 * q] = v.x; lgv[4 * q + 1] = v.y; lgv[4 * q + 2] = v.z; lgv[4 * q + 3] = v.w; }
            float mx = lgv[0];
#pragma unroll
            for (int e = 1; e < 16; ++e) mx = fmaxf(mx, lgv[e]);
            float pr[16]; float den = 0.f;
#pragma unroll
            for (int e = 0; e < 16; ++e) { pr[e] = __expf(lgv[e] - mx); den += pr[e]; }
            const float inv = 1.f / den;
            float sel[16];
#pragma unroll
            for (int e = 0; e < 16; ++e) { pr[e] *= inv; sel[e] = pr[e] + p.router_b[e]; }
            int bg = 0; float bgs = -1e30f;
#pragma unroll
            for (int gi = 0; gi < 4; ++gi) { float m1 = -1e30f, m2 = -1e30f;
#pragma unroll
                for (int q = 0; q < 4; ++q) { const float sv2 = sel[gi * 4 + q]; if (sv2 > m1) { m2 = m1; m1 = sv2; } else if (sv2 > m2) m2 = sv2; }
                const float gs = m1 + m2; if (gs > bgs) { bgs = gs; bg = gi; } }
            int e1 = 0, e2 = 0; float s1 = -1e30f, s2 = -1e30f, p1 = 0.f, p2 = 0.f;
#pragma unroll
            for (int gi = 0; gi < 4; ++gi) if (gi == bg) {
#pragma unroll
                for (int q = 0; q < 4; ++q) { const float sv2 = sel[gi * 4 + q], pv = pr[gi * 4 + q];
                    if (sv2 > s1) { s2 = s1; e2 = e1; p2 = p1; s1 = sv2; e1 = gi * 4 + q; p1 = pv; } else if (sv2 > s2) { s2 = sv2; e2 = gi * 4 + q; p2 = pv; } } }
            const float wn = 1.f / (p1 + p2);
            selE[w * 16 + kt] = e1 | (e2 << 8); selW[2 * (w * 16 + kt)] = p1 * wn; selW[2 * (w * 16 + kt) + 1] = p2 * wn;
        }
        __syncthreads();
        int myE = 0, myR = 0;
        if (tix_ < 256) { const int ee = selE[tix_ >> 1]; myE = (tix_ & 1) ? (ee >> 8) : (ee & 255); myR = atomicAdd(&lcnt[myE], 1); }
        __syncthreads();
        if (tix_ < 16) lbase[tix_] = atomicAdd(&p.cnt[tix_], lcnt[tix_]);
        __syncthreads();
        if (tix_ < 256) { const int pair = chunk * 256 + tix_; p.list[myE * T_ + lbase[myE] + myR] = pair; p.gw[pair] = selW[tix_]; }
    }
    __syncthreads();
}

__device__ __forceinline__ void ph_lru(const int WV, CParams& p, const bf16_t* __restrict__ proj2, bf16_t* __restrict__ omix, unsigned char* smem) {
    const int tid = otid(WV), lane = tid & 63, w = tid >> 6, c = lane & 15, g4 = lane >> 4;
    bf16_t* xcs = (bf16_t*)smem;
    float* AB = (float*)(smem + 34816);
    constexpr int ABSZ = 2 * 128 * 33;
    float* segA = AB + 2 * ABSZ;
    float* segB = segA + 512;
    float* cin = segB + 512;
    for (int item = blockIdx.x; item < 256; item += gridDim.x) {
        const int b = item >> 4, hb = (item >> 2) & 3, q = item & 3;
        dn_bf16x8 wrf[2][4], wif[2][4];
#pragma unroll
        for (int nb = 0; nb < 2; ++nb)
#pragma unroll
            for (int ks = 0; ks < 4; ++ks) { const size_t o = ((size_t)hb * 128 + q * 32 + 16 * nb + c) * 128 + 32 * ks + 8 * g4;
                wrf[nb][ks] = *(const dn_bf16x8*)(p.W_lr + o); wif[nb][ks] = *(const dn_bf16x8*)(p.W_li + o); }
        float brj[2], bij[2], spn[2];
#pragma unroll
        for (int nb = 0; nb < 2; ++nb) { const int ch = hb * 128 + q * 32 + 16 * nb + c; brj[nb] = p.od_br[ch]; bij[nb] = p.od_bi[ch]; spn[nb] = -8.f * softplusf_(-p.od_lam[ch]); }
        const int cp = tid & 63, rg = tid >> 6, cch = hb * 128 + cp * 2;
        const float wa0 = p.od_conv_w[cch], wa1 = p.od_conv_w[512 + cch], wa2 = p.od_conv_w[1024 + cch], wa3 = p.od_conv_w[1536 + cch], ba = p.od_conv_b[cch];
        const float wb0 = p.od_conv_w[cch + 1], wb1 = p.od_conv_w[512 + cch + 1], wb2 = p.od_conv_w[1024 + cch + 1], wb3 = p.od_conv_w[1536 + cch + 1], bb2 = p.od_conv_b[cch + 1];
        float h_in = 0.f;
        unsigned raw[19];
        { const bf16_t* src = proj2 + (size_t)(b * S_ + rg * 16) * 2048 + cch;
#pragma unroll
          for (int r = 0; r < 19; ++r) raw[r] = (rg == 0 && r < 3) ? 0u : *(const unsigned*)(src + (ptrdiff_t)(r - 3) * 2048); }
        const int j = tid & 31, seg = tid >> 5, cg = hb * 128 + q * 32 + j;
        auto conv = [&](const int ti) __attribute__((always_inline)) {
            float a0 = __uint_as_float(raw[0] << 16), b0 = __uint_as_float(raw[0] & 0xffff0000u), a1 = __uint_as_float(raw[1] << 16), b1 = __uint_as_float(raw[1] & 0xffff0000u), a2 = __uint_as_float(raw[2] << 16), b2 = __uint_as_float(raw[2] & 0xffff0000u);
            if (ti == 0 && rg == 0) { a0 = a1 = a2 = b0 = b1 = b2 = 0.f; }
#pragma unroll
            for (int r = 0; r < 16; ++r) { const unsigned pv = raw[3 + r];
                const float a3 = __uint_as_float(pv << 16), b3 = __uint_as_float(pv & 0xffff0000u);
                *(unsigned*)(xcs + (rg * 16 + r) * 136 + cp * 2) = pk_bf16(ba + wa0 * a0 + wa1 * a1 + wa2 * a2 + wa3 * a3, bb2 + wb0 * b0 + wb1 * b1 + wb2 * b2 + wb3 * b3);
                a0 = a1; a1 = a2; a2 = a3; b0 = b1; b1 = b2; b2 = b3; }
            if (ti + 1 < 16) { const bf16_t* src = proj2 + (size_t)(b * S_ + (ti + 1) * 128 + rg * 16) * 2048 + cch;
#pragma unroll
                for (int r = 0; r < 19; ++r) raw[r] = *(const unsigned*)(src + (ptrdiff_t)(r - 3) * 2048); }
        };
        auto gates = [&](float* As, float* Bs) __attribute__((always_inline)) {
            dn_bf16x8 af[4];
#pragma unroll
            for (int ks = 0; ks < 4; ++ks) af[ks] = *(const dn_bf16x8*)(xcs + (16 * w + c) * 136 + 32 * ks + 8 * g4);
#pragma unroll
            for (int nb = 0; nb < 2; ++nb) { dn_f32x4 ar = {0.f, 0.f, 0.f, 0.f}, ai = {0.f, 0.f, 0.f, 0.f};
#pragma unroll
                for (int ks = 0; ks < 4; ++ks) { ar = dn_mfma(af[ks], wrf[nb][ks], ar); ai = dn_mfma(af[ks], wif[nb][ks], ai); }
#pragma unroll
                for (int r = 0; r < 4; ++r) { const int t = 16 * w + 4 * g4 + r, jl = 16 * nb + c;
                    const float rr = sigm(ar[r] + brj[nb]), ig = sigm(ai[r] + bij[nb]);
                    const float log_a = spn[nb] * rr, av = __expf(log_a), x = bf2f(xcs[t * 136 + q * 32 + jl]);
                    As[t * 33 + jl] = av; Bs[t * 33 + jl] = sqrtf(fmaxf(0.f, (1.f - av) * (1.f + av))) * ig * x; } }
        };
        conv(0);
        __syncthreads();
        gates(AB, AB + 128 * 33);
        __syncthreads();
        for (int ti = 0; ti < 16; ++ti) {
            const int t0 = b * S_ + ti * 128;
            float* As = AB + (ti & 1) * ABSZ; float* Bs = As + 128 * 33;
            float* An = AB + ((ti + 1) & 1) * ABSZ; float* Bn = An + 128 * 33;
            { float A = 1.f, Bc = 0.f;
#pragma unroll
                for (int k = 0; k < 8; ++k) { const float av = As[(8 * seg + k) * 33 + j], bv = Bs[(8 * seg + k) * 33 + j]; A = av * A; Bc = av * Bc + bv; }
                segA[seg * 32 + j] = A; segB[seg * 32 + j] = Bc; }
            if (ti + 1 < 16) conv(ti + 1);
            __syncthreads();
            unsigned short gz[8];
#pragma unroll
            for (int k = 0; k < 8; ++k) gz[k] = *(const unsigned short*)(proj2 + (size_t)(t0 + 8 * seg + k) * 2048 + 512 + cg);
            if (tid < 32) { float sa[16], sb[16];
#pragma unroll
                for (int sg = 0; sg < 16; ++sg) { sa[sg] = segA[sg * 32 + tid]; sb[sg] = segB[sg * 32 + tid]; }
                float h = h_in;
#pragma unroll
                for (int sg = 0; sg < 16; ++sg) { cin[sg * 32 + tid] = h; h = sa[sg] * h + sb[sg]; }
                h_in = h; }
            if (ti + 1 < 16) gates(An, Bn);
            __syncthreads();
            { float h = cin[seg * 32 + j];
#pragma unroll
                for (int k = 0; k < 8; ++k) { const int t = 8 * seg + k; h = As[t * 33 + j] * h + Bs[t * 33 + j];
                    omix[(size_t)(t0 + t) * 1024 + cg] = f2bf(h * __uint_as_float((unsigned)gz[k] << 16)); } }
        }
        __syncthreads();
    }
}
typedef unsigned short sg_u16x4 __attribute__((ext_vector_type(4)));
__device__ __forceinline__ unsigned sgu_off(unsigned row, unsigned ch) { return 256u * row + 16u * (ch ^ (((row & 3u) << 2) | ((row >> 2) & 3u))); }
__device__ __forceinline__ void ph_sgu(const int WV, CParams& p, const bf16_t* __restrict__ proj2, bf16_t* __restrict__ omix, unsigned char* smem) {
    const int tid = otid(WV), lane = tid & 63, w = tid >> 6, c = lane & 15, g4 = lane >> 4;
    float* rstd = (float*)(smem + 32768);
    const unsigned ldsb = (unsigned)(size_t)(PG8_LAS unsigned char*)smem;
    const unsigned q4 = (unsigned)(lane & 15) >> 2, p4 = (unsigned)lane & 3u;
    for (int item = blockIdx.x; item < 256; item += gridDim.x) {
        const int t0 = item * 128;
        __syncthreads();
#pragma unroll 4
        for (int rr = 0; rr < 16; ++rr) { const int sI = 16 * w + rr; const uint4 v = *(const uint4*)(proj2 + (size_t)(t0 + sI) * 2048 + 1536 + lane * 8);
            const unsigned u[4] = {v.x, v.y, v.z, v.w}; float ss = 0.f;
#pragma unroll
            for (int k = 0; k < 4; ++k) { const float x0 = __uint_as_float(u[k] << 16), x1 = __uint_as_float(u[k] & 0xffff0000u); ss += x0 * x0 + x1 * x1; }
            ss = wave_sum(ss);
            if (lane == 0) rstd[sI] = rsqrtf(ss * (1.f / 512.f) + 1e-6f); }
        __syncthreads();
        for (int g = 0; g < 4; ++g) {
#pragma unroll
            for (int i = 0; i < 4; ++i) { const int id = tid + i * NT, sI = id >> 4, c16 = id & 15;
                const uint4 v = *(const uint4*)(proj2 + (size_t)(t0 + sI) * 2048 + 1536 + g * 128 + c16 * 8);
                const float rs = rstd[sI]; const float4 g0 = *(const float4*)(p.od_sgu_g + g * 128 + c16 * 8), g1 = *(const float4*)(p.od_sgu_g + g * 128 + c16 * 8 + 4);
                uint4 o;
                o.x = pk_bf16(__uint_as_float(v.x << 16) * rs * g0.x, __uint_as_float(v.x & 0xffff0000u) * rs * g0.y); o.y = pk_bf16(__uint_as_float(v.y << 16) * rs * g0.z, __uint_as_float(v.y & 0xffff0000u) * rs * g0.w);
                o.z = pk_bf16(__uint_as_float(v.z << 16) * rs * g1.x, __uint_as_float(v.z & 0xffff0000u) * rs * g1.y); o.w = pk_bf16(__uint_as_float(v.w << 16) * rs * g1.z, __uint_as_float(v.w & 0xffff0000u) * rs * g1.w);
                *(uint4*)(smem + sgu_off((unsigned)sI, (unsigned)c16)) = o; }
            __syncthreads();
            {
                const int nks = (16 * w + 15) / 32 + 1, t = 16 * w + c;
                dn_bf16x8 wf[4];
#pragma unroll
                for (int ks = 0; ks < 4; ++ks) wf[ks] = *(const dn_bf16x8*)(p.W_sgu + ((size_t)(g * 128 + t)) * 128 + 32 * ks + 8 * g4);
                const float bias = p.od_sgu_b[g * 128 + t];
#pragma unroll
                for (int db = 0; db < 8; ++db) {
                    union { dn_bf16x8 v; sg_u16x4 h[2]; } va[4];
                    {
                        unsigned ad[8];
#pragma unroll
                        for (int ks = 0; ks < 4; ++ks)
#pragma unroll
                            for (int tt = 0; tt < 2; ++tt) ad[2 * ks + tt] = ldsb + sgu_off(32u * ks + 8u * (unsigned)g4 + 4u * tt + q4, 2u * db + (p4 >> 1)) + 8u * (p4 & 1u);
                        asm volatile("ds_read_b64_tr_b16 %0, %8\n\tds_read_b64_tr_b16 %1, %9\n\tds_read_b64_tr_b16 %2, %10\n\tds_read_b64_tr_b16 %3, %11\n\t"
                                     "ds_read_b64_tr_b16 %4, %12\n\tds_read_b64_tr_b16 %5, %13\n\tds_read_b64_tr_b16 %6, %14\n\tds_read_b64_tr_b16 %7, %15\n\ts_waitcnt lgkmcnt(0)"
                                     : "=&v"(va[0].h[0]), "=&v"(va[0].h[1]), "=&v"(va[1].h[0]), "=&v"(va[1].h[1]), "=&v"(va[2].h[0]), "=&v"(va[2].h[1]), "=&v"(va[3].h[0]), "=&v"(va[3].h[1])
                                     : "v"(ad[0]), "v"(ad[1]), "v"(ad[2]), "v"(ad[3]), "v"(ad[4]), "v"(ad[5]), "v"(ad[6]), "v"(ad[7]) : "memory");
                    }
                    dn_f32x4 acc = {0.f, 0.f, 0.f, 0.f};
#pragma unroll
                    for (int ks = 0; ks < 4; ++ks) if (ks < nks) acc = dn_mfma(va[ks].v, wf[ks], acc);
                    const size_t go = (size_t)(t0 + t);
                    const uint2 uu = *(const uint2*)(proj2 + go * 2048 + 1024 + g * 128 + 16 * db + 4 * g4);
                    uint2 o; o.x = pk_bf16(__uint_as_float(uu.x << 16) * (acc[0] + bias), __uint_as_float(uu.x & 0xffff0000u) * (acc[1] + bias));
                    o.y = pk_bf16(__uint_as_float(uu.y << 16) * (acc[2] + bias), __uint_as_float(uu.y & 0xffff0000u) * (acc[3] + bias));
                    *(uint2*)(omix + go * 1024 + 512 + g * 128 + 16 * db + 4 * g4) = o; }
            }
            __syncthreads();
        }
    }
}

namespace pg8 {
typedef short bf16x8 __attribute__((ext_vector_type(8)));
typedef float f32x4 __attribute__((ext_vector_type(4)));
typedef unsigned u32x4 __attribute__((ext_vector_type(4)));
typedef unsigned u32x2 __attribute__((ext_vector_type(2)));
constexpr int BM = 256, BK = 64, HALF = 128, HTB = HALF * BK * 2, STAGE_BYTES = 8 * HTB, NXCD = 8, WGM = 8;
__device__ __forceinline__ int lds_byte(int r, int c) { const int st = (r >> 4) * 2 + (c >> 5), rr = r & 15, cc = c & 31, ob = rr * 64 + cc * 2; return st * 1024 + (ob ^ (((ob >> 9) & 1) << 5)); }
__device__ __forceinline__ void stage_rc(int b, int& R, int& C) { const int st = b / 1024, sb = b % 1024, swz = sb ^ (((sb >> 9) & 1) << 5); R = (st >> 1) * 16 + swz / 64; C = (st & 1) * 32 + (swz % 64) / 2; }
__device__ __forceinline__ int perm32(int rho) { const int n = rho >> 4, i = rho & 15; return 8 * (i >> 2) + 4 * n + (i & 3); }
struct Unit { int pm, pn, e, nvalid, gt; };
struct Gemm { const bf16_t* A; const bf16_t* Bt; size_t wstride; int K; int pad_; };

struct StaticOrder {
    static constexpr bool GATHER = false; static constexpr int SHIFT = 0, SIG = 0;
    int nM, nN, nwg, G, c;
    __device__ __forceinline__ int rowid(const Unit&, int) const { return 0; }
    __device__ void init(int M, int N, int G_, int c_) { nM = M / BM; nN = N / BM; nwg = nM * nN; G = G_; c = c_; }
    __device__ bool next(int i, Unit& u) const {
        const long L = (long)i * G + c; if (L >= nwg) return false;
        int wgid = (int)L; { const int q = nwg / NXCD, r = nwg % NXCD, xcd = wgid % NXCD, off = wgid / NXCD; wgid = (xcd < r ? xcd * (q + 1) : r * (q + 1) + (xcd - r) * q) + off; }
        const int nig = WGM * nN, gid = wgid / nig, fm = gid * WGM, gsz = (nM - fm) < WGM ? (nM - fm) : WGM;
        u.pm = fm + ((wgid % nig) % gsz); u.pn = (wgid % nig) / gsz; u.e = 0; u.nvalid = 256; u.gt = 0; return true;
    }
};
template <int NN, int SHIFT_, int SIG_>
struct MoeOrder {
    static constexpr bool GATHER = true; static constexpr int SHIFT = SHIFT_, SIG = SIG_;
    const int* cnt; const int* list; int G, c; int cntv;
    int* flag; int rounds, extra;
    __device__ __forceinline__ int rowid(const Unit& u, int r) const { return list[u.e * T_ + u.pm * 256 + min(r, u.nvalid - 1)]; }
    __device__ bool next(int i, Unit& u) const {
        int L;
        if constexpr (SIG == 1) { if (i >= rounds) return false; L = i * G + c; }
        else if constexpr (SIG == 3) { if (i > 0 || c >= extra) return false; L = rounds * G + c; }
        else if constexpr (SIG == 2) { constexpr int SK = 3; const int iv = (c < extra) ? i + SK : i; L = iv * G + c - (iv < SK ? iv * extra + min(c, extra) : SK * extra); }
        else L = i * G + c;
        int rt = L / NN; u.pn = L % NN; u.gt = rt;
        int e = 0, cc = 0;
        for (; e < 16; ++e) { cc = __builtin_amdgcn_readlane(cntv, e); const int ntile = (cc + 255) >> 8; if (rt < ntile) break; rt -= ntile; }
        if (e == 16) return false;
        u.e = e; u.pm = rt; u.nvalid = min(256, cc - rt * 256);
        if constexpr (SIG == 2) {
            const int need = (2 * u.gt >= rounds * G ? 1 : 0) + (2 * u.gt + 1 >= rounds * G ? 1 : 0);
            if (need > 0) { while (__hip_atomic_load(flag + u.gt, __ATOMIC_RELAXED, __HIP_MEMORY_SCOPE_AGENT) < need) __builtin_amdgcn_s_sleep(2); __builtin_amdgcn_fence(__ATOMIC_ACQUIRE, "agent"); }
        }
        return true;
    }
};
__device__ __forceinline__ unsigned cvt_pk_bf16(float lo, float hi) { return pk_bf16(lo, hi); }

template <int KC, class Epi, class Sched>
__device__ __forceinline__ void gemm_phase(const int WV, PG8_LAS unsigned char* lds, const Gemm g, const Sched& S, const Epi& E) {
    const int tid = otid(WV), wid = __builtin_amdgcn_readfirstlane(tid >> 6), lane = tid & 63, wr = wid >> 2, wc = wid & 3, fr = lane & 15, fq = lane >> 4;
    constexpr int K = KC, nt = K / BK;
    unsigned voffB[2];
#pragma unroll
    for (int i = 0; i < 2; ++i) { int R, C; stage_rc(tid * 16 + i * 8192, R, C); const int Rb = Epi::PERM ? ((R & ~31) + perm32(R & 31)) : R; voffB[i] = (unsigned)(Rb * K + C) * 2u; }
    constexpr unsigned kstep = BK * 2, hstep = HALF * K * 2, tstep = 2 * hstep;
    const __amdgpu_buffer_rsrc_t rsA = __builtin_amdgcn_make_buffer_rsrc((void*)g.A, 0, 0x7fffffff, 0x00020000);
    const __amdgpu_buffer_rsrc_t rsB = __builtin_amdgcn_make_buffer_rsrc((void*)g.Bt, 0, 0x7fffffff, 0x00020000);
    const unsigned ldsw = (unsigned)wid * 1024u;
    const int aoff = lds_byte(wr * 64 + fr, fq * 8), boff = lds_byte(wc * 32 + fr, fq * 8);
#define PG8_SA(b, h) (((b) * 2 + (h)) * HTB)
#define PG8_SB(b, h) ((4 + (b) * 2 + (h)) * HTB)
#define PG8_STAGE(bufoff, rsrc, soff, voff) do { _Pragma("unroll") for (int _i = 0; _i < 2; ++_i) \
        __builtin_amdgcn_raw_ptr_buffer_load_lds(rsrc, (PG8_LAS unsigned*)(lds + (bufoff) + ldsw + _i * 8192), 16, (voff)[_i], (soff), 0, 0); } while (0)
#define PG8_LDA(dst, b, h) do { _Pragma("unroll") for (int m = 0; m < 4; ++m) _Pragma("unroll") for (int k = 0; k < 2; ++k) dst[m][k] = *(const PG8_LAS bf16x8*)(lds + PG8_SA(b, h) + aoff + m * 2048 + k * 1024); } while (0)
#define PG8_LDB(dst, b, h) do { _Pragma("unroll") for (int n = 0; n < 2; ++n) _Pragma("unroll") for (int k = 0; k < 2; ++k) dst[n][k] = *(const PG8_LAS bf16x8*)(lds + PG8_SB(b, h) + boff + n * 2048 + k * 1024); } while (0)
#define PG8_MMA(ai, bj, At, Bt) do { __builtin_amdgcn_s_setprio(1); _Pragma("unroll") for (int m = 0; m < 4; ++m) _Pragma("unroll") for (int n = 0; n < 2; ++n) _Pragma("unroll") for (int k = 0; k < 2; ++k) \
        acc[ai][bj][m][n] = __builtin_amdgcn_mfma_f32_16x16x32_bf16(Bt[n][k], At[m][k], acc[ai][bj][m][n], 0, 0, 0); __builtin_amdgcn_s_setprio(0); } while (0)
#define PG8_WAIT_V(n) asm volatile("s_waitcnt vmcnt(" #n ")" ::: "memory")
#define PG8_WAIT_L(n) asm volatile("s_waitcnt lgkmcnt(" #n ")" ::: "memory")
#define PG8_BAR __builtin_amdgcn_s_barrier()
#define PG8_SCHED __builtin_amdgcn_sched_barrier(0)
    Unit cur, nxt; int ui = 0;
    if (!S.next(0, cur)) return;
    f32x4 acc[2][2][4][2];
#pragma unroll
    for (int a = 0; a < 2; ++a)
#pragma unroll
        for (int b = 0; b < 2; ++b)
#pragma unroll
            for (int m = 0; m < 4; ++m)
#pragma unroll
                for (int n = 0; n < 2; ++n) acc[a][b][m][n] = (f32x4){0.f, 0.f, 0.f, 0.f};
    bf16x8 At[4][2], B0[2][2], B1[2][2];
    unsigned vA0[2], vA1[2];
    PG8_LAS int* rows = (PG8_LAS int*)(lds + STAGE_BYTES);
    if constexpr (Sched::GATHER) { if (tid < 256) rows[tid] = S.rowid(cur, tid); __syncthreads(); }
#pragma unroll
    for (int i = 0; i < 2; ++i) { int R, C; stage_rc(tid * 16 + i * 8192, R, C);
        const int r0 = Sched::GATHER ? (rows[R] >> Sched::SHIFT) : cur.pm * BM + R, r1 = Sched::GATHER ? (rows[HALF + R] >> Sched::SHIFT) : cur.pm * BM + HALF + R;
        vA0[i] = ((unsigned)r0 * (unsigned)K + (unsigned)C) * 2u; vA1[i] = ((unsigned)r1 * (unsigned)K + (unsigned)C) * 2u; }
    unsigned cB = (unsigned)cur.e * (unsigned)(g.wstride * 2) + (unsigned)cur.pn * tstep;
    PG8_STAGE(PG8_SB(0, 0), rsB, cB, voffB); PG8_STAGE(PG8_SA(0, 0), rsA, 0u, vA0); PG8_STAGE(PG8_SB(0, 1), rsB, cB + hstep, voffB); PG8_STAGE(PG8_SA(0, 1), rsA, 0u, vA1);
    if (wr == 1) PG8_BAR;
    PG8_WAIT_V(4); PG8_BAR;
    PG8_STAGE(PG8_SB(1, 0), rsB, cB + kstep, voffB); PG8_STAGE(PG8_SA(1, 0), rsA, kstep, vA0); PG8_STAGE(PG8_SB(1, 1), rsB, cB + hstep + kstep, voffB);
    PG8_WAIT_V(6); PG8_BAR;
    for (;;) {
        const bool has_next = S.next(ui + 1, nxt);
        if constexpr (Sched::GATHER) { if (has_next) { const int t3 = otid(WV); if (t3 < 256) rows[((ui + 1) % 3) * 256 + t3] = S.rowid(nxt, t3); } }
        const unsigned nB = has_next ? (unsigned)nxt.e * (unsigned)(g.wstride * 2) + (unsigned)nxt.pn * tstep : cB;
        for (int t = 0; t < nt; t += 2) {
            const bool last = (t == nt - 2);
            const unsigned a1 = (unsigned)(t + 1) * kstep;
            const unsigned a2 = last ? 0u : (unsigned)(t + 2) * kstep, b2 = last ? nB : cB + (unsigned)(t + 2) * kstep;
            const unsigned a3 = a2 + kstep, b3 = b2 + kstep;
            PG8_LDB(B0, 0, 0); PG8_SCHED; PG8_LDA(At, 0, 0); PG8_STAGE(PG8_SA(1, 1), rsA, a1, vA1);
            if (last && has_next) {
                const int t3 = otid(WV); PG8_LAS const int* rn = rows + ((ui + 1) % 3) * 256;
#pragma unroll
                for (int i = 0; i < 2; ++i) { int R, C; stage_rc(t3 * 16 + i * 8192, R, C);
                    const int r0 = Sched::GATHER ? (rn[R] >> Sched::SHIFT) : nxt.pm * BM + R, r1 = Sched::GATHER ? (rn[HALF + R] >> Sched::SHIFT) : nxt.pm * BM + HALF + R;
                    vA0[i] = ((unsigned)r0 * (unsigned)K + (unsigned)C) * 2u; vA1[i] = ((unsigned)r1 * (unsigned)K + (unsigned)C) * 2u; }
            }
            PG8_WAIT_L(8); PG8_BAR; PG8_WAIT_L(0); PG8_MMA(0, 0, At, B0); PG8_BAR; PG8_SCHED;
            PG8_LDB(B1, 0, 1); PG8_STAGE(PG8_SB(0, 0), rsB, b2, voffB);
            PG8_BAR; PG8_WAIT_L(0); PG8_MMA(0, 1, At, B1); PG8_BAR;
            PG8_LDA(At, 0, 1); PG8_STAGE(PG8_SA(0, 0), rsA, a2, vA0);
            PG8_BAR; PG8_WAIT_L(0); PG8_MMA(1, 0, At, B0); PG8_BAR; PG8_SCHED;
            PG8_STAGE(PG8_SB(0, 1), rsB, b2 + hstep, voffB);
            PG8_WAIT_V(6); PG8_BAR; PG8_MMA(1, 1, At, B1); PG8_BAR;
            PG8_LDB(B0, 1, 0); PG8_SCHED; PG8_LDA(At, 1, 0); PG8_STAGE(PG8_SA(0, 1), rsA, a2, vA1);
            PG8_WAIT_L(8); PG8_BAR; PG8_WAIT_L(0); PG8_MMA(0, 0, At, B0); PG8_BAR; PG8_SCHED;
            PG8_LDB(B1, 1, 1); PG8_STAGE(PG8_SB(1, 0), rsB, b3, voffB);
            PG8_BAR; PG8_WAIT_L(0); PG8_MMA(0, 1, At, B1); PG8_BAR;
            PG8_LDA(At, 1, 1); PG8_STAGE(PG8_SA(1, 0), rsA, a3, vA0);
            PG8_BAR; PG8_WAIT_L(0); PG8_MMA(1, 0, At, B0); PG8_BAR; PG8_SCHED;
            PG8_STAGE(PG8_SB(1, 1), rsB, b3 + hstep, voffB);
            PG8_WAIT_V(6); PG8_BAR; PG8_MMA(1, 1, At, B1); PG8_BAR;
        }
        { const int t2 = otid(WV), w2 = __builtin_amdgcn_readfirstlane(t2 >> 6), l2 = t2 & 63; E(acc, cur, w2 >> 2, w2 & 3, l2 & 15, l2 >> 4, rows + (ui % 3) * 256); }
        if constexpr (Sched::SIG == 3) {
            PG8_WAIT_V(0); PG8_BAR; PG8_BAR;
            if (otid(WV) == 0) { __builtin_amdgcn_fence(__ATOMIC_RELEASE, "agent"); (void)__hip_atomic_fetch_add(S.flag + cur.gt, 1, __ATOMIC_RELAXED, __HIP_MEMORY_SCOPE_AGENT); }
        }
        if (!has_next) break;
#pragma unroll
        for (int a = 0; a < 2; ++a)
#pragma unroll
            for (int b = 0; b < 2; ++b)
#pragma unroll
                for (int m = 0; m < 4; ++m)
#pragma unroll
                    for (int n = 0; n < 2; ++n) acc[a][b][m][n] = (f32x4){0.f, 0.f, 0.f, 0.f};
        cur = nxt; cB = nB; ++ui;
    }
    PG8_WAIT_V(0);
    if (wr == 0) PG8_BAR;
    PG8_BAR;
#undef PG8_SA
#undef PG8_SB
#undef PG8_STAGE
#undef PG8_LDA
#undef PG8_LDB
#undef PG8_MMA
#undef PG8_WAIT_V
#undef PG8_WAIT_L
#undef PG8_BAR
#undef PG8_SCHED
}

struct EpiBf16 {
    static constexpr bool PERM = true;
    bf16_t* O; int ldo, gelu_from;
    __device__ __forceinline__ void operator()(const f32x4 (&acc)[2][2][4][2], const Unit& u, int wr, int wc, int fr, int fq, PG8_LAS const int* rows) const {
        const int row0 = u.pm * BM + wr * 64 + fr, col0 = u.pn * BM + wc * 32 + 8 * fq; const bool gl = u.pn >= gelu_from;
#pragma unroll
        for (int ai = 0; ai < 2; ++ai)
#pragma unroll
            for (int m = 0; m < 4; ++m) { bf16_t* rowp = O + (size_t)(row0 + ai * HALF + m * 16) * ldo + col0;
#pragma unroll
                for (int bj = 0; bj < 2; ++bj) { f32x4 v0 = acc[ai][bj][m][0], v1 = acc[ai][bj][m][1];
                    if (gl) {
#pragma unroll
                        for (int j = 0; j < 4; ++j) { v0[j] = geluf_(v0[j]); v1[j] = geluf_(v1[j]); } }
                    u32x4 w; w.x = cvt_pk_bf16(v0[0], v0[1]); w.y = cvt_pk_bf16(v0[2], v0[3]); w.z = cvt_pk_bf16(v1[0], v1[1]); w.w = cvt_pk_bf16(v1[2], v1[3]);
                    *(u32x4*)(rowp + bj * HALF) = w; } }
    }
};
struct EpiRes {
    static constexpr bool PERM = false;
    const float* xin; float* xout; const float* gt;
    __device__ __forceinline__ void operator()(const f32x4 (&acc)[2][2][4][2], const Unit& u, int wr, int wc, int fr, int fq, PG8_LAS const int* rows) const {
        const int row0 = u.pm * BM + wr * 64 + fr, col0 = u.pn * BM + wc * 32 + 4 * fq;
#pragma unroll
        for (int ai = 0; ai < 2; ++ai)
#pragma unroll
            for (int m = 0; m < 4; ++m) { const int r = row0 + ai * HALF + m * 16; const float* gp = gt + (r >> 11) * 6144 + col0; const size_t off = (size_t)r * 1024 + col0;
#pragma unroll
                for (int bj = 0; bj < 2; ++bj)
#pragma unroll
                    for (int n = 0; n < 2; ++n) { const int cc = bj * HALF + n * 16; const f32x4 xv = *(const f32x4*)(xin + off + cc); const f32x4 gv = *(const f32x4*)(gp + cc);
                        *(f32x4*)(xout + off + cc) = xv + gv * acc[ai][bj][m][n]; }
                if (m & 1) asm volatile("" ::: "memory"); }
    }
};
template <bool XIN16>
struct EpiRes16 {
    static constexpr bool PERM = true;
    const void* xin; bf16_t* xout; const float* gt;
    __device__ __forceinline__ void operator()(const f32x4 (&acc)[2][2][4][2], const Unit& u, int wr, int wc, int fr, int fq, PG8_LAS const int* rows) const {
        const int row0 = u.pm * BM + wr * 64 + fr, col0 = u.pn * BM + wc * 32 + 8 * fq;
        const float* gp = gt + (row0 >> 11) * 6144 + col0;
        f32x4 gv[2][2];
#pragma unroll
        for (int bj = 0; bj < 2; ++bj) { gv[bj][0] = *(const f32x4*)(gp + bj * HALF); gv[bj][1] = *(const f32x4*)(gp + bj * HALF + 4); }
        u32x4 xb[2][2]; f32x4 xf[2][2][2];
#define ER_LOAD(it_) do { const size_t off_ = (size_t)(row0 + ((it_) >> 2) * HALF + ((it_) & 3) * 16) * 1024 + col0; _Pragma("unroll") for (int bj = 0; bj < 2; ++bj) { \
            if (XIN16) xb[(it_) & 1][bj] = *(const u32x4*)((const bf16_t*)xin + off_ + bj * HALF); \
            else { xf[(it_) & 1][bj][0] = *(const f32x4*)((const float*)xin + off_ + bj * HALF); xf[(it_) & 1][bj][1] = *(const f32x4*)((const float*)xin + off_ + bj * HALF + 4); } } } while (0)
        ER_LOAD(0);
#pragma unroll
        for (int it = 0; it < 8; ++it) { const int ai = it >> 2, m = it & 3;
            if (it + 1 < 8) ER_LOAD(it + 1);
            const size_t off = (size_t)(row0 + ai * HALF + m * 16) * 1024 + col0;
#pragma unroll
            for (int bj = 0; bj < 2; ++bj) { const int cc = bj * HALF;
                f32x4 x0, x1;
                if (XIN16) { const u32x4 q = xb[it & 1][bj];
                    x0 = (f32x4){__uint_as_float(q.x << 16), __uint_as_float(q.x & 0xffff0000u), __uint_as_float(q.y << 16), __uint_as_float(q.y & 0xffff0000u)};
                    x1 = (f32x4){__uint_as_float(q.z << 16), __uint_as_float(q.z & 0xffff0000u), __uint_as_float(q.w << 16), __uint_as_float(q.w & 0xffff0000u)}; }
                else { x0 = xf[it & 1][bj][0]; x1 = xf[it & 1][bj][1]; }
                const f32x4 v0 = x0 + gv[bj][0] * acc[ai][bj][m][0], v1 = x1 + gv[bj][1] * acc[ai][bj][m][1];
                u32x4 w; w.x = cvt_pk_bf16(v0[0], v0[1]); w.y = cvt_pk_bf16(v0[2], v0[3]); w.z = cvt_pk_bf16(v1[0], v1[1]); w.w = cvt_pk_bf16(v1[2], v1[3]);
                *(u32x4*)(xout + off + cc) = w; }
            asm volatile("" ::: "memory"); }
#undef ER_LOAD
    }
};
struct EpiG1 {
    static constexpr bool PERM = true;
    bf16_t* act; const int* list; const float* gw;
    __device__ __forceinline__ void operator()(const f32x4 (&acc)[2][2][4][2], const Unit& u, int wr, int wc, int fr, int fq, PG8_LAS const int* rows) const {
        int pv[8]; float wv[8];
#pragma unroll
        for (int it = 0; it < 8; ++it) pv[it] = rows[(it >> 2) * HALF + wr * 64 + (it & 3) * 16 + fr];
#pragma unroll
        for (int it = 0; it < 8; ++it) wv[it] = gw[pv[it]];
#pragma unroll
        for (int it = 0; it < 8; ++it) { const int ai = it >> 2, m = it & 3; const int rr = ai * HALF + wr * 64 + m * 16 + fr;
                if (rr < u.nvalid) { const int p = pv[it]; const float w = wv[it];
#pragma unroll
                    for (int bj = 0; bj < 2; ++bj) { const int c = u.pn * BM + bj * HALF + wc * 32 + 8 * fq; const f32x4 v0 = acc[ai][bj][m][0], v1 = acc[ai][bj][m][1];
                        u32x2 o; o.x = cvt_pk_bf16(siluf(v0[0]) * v0[1] * w, siluf(v0[2]) * v0[3] * w); o.y = cvt_pk_bf16(siluf(v1[0]) * v1[1] * w, siluf(v1[2]) * v1[3] * w);
                        *(u32x2*)(act + (size_t)p * 256 + (c >> 1)) = o; } }
                asm volatile("" ::: "memory"); }
    }
};
struct EpiG2 {
    static constexpr bool PERM = true;
    bf16_t* y; const int* list;
    __device__ __forceinline__ void operator()(const f32x4 (&acc)[2][2][4][2], const Unit& u, int wr, int wc, int fr, int fq, PG8_LAS const int* rows) const {
#pragma unroll
        for (int ai = 0; ai < 2; ++ai)
#pragma unroll
            for (int m = 0; m < 4; ++m) { const int rr = ai * HALF + wr * 64 + m * 16 + fr;
                if (rr < u.nvalid) { const int p = rows[rr];
#pragma unroll
                    for (int bj = 0; bj < 2; ++bj) { const int c = u.pn * BM + bj * HALF + wc * 32 + 8 * fq; const f32x4 v0 = acc[ai][bj][m][0], v1 = acc[ai][bj][m][1];
                        u32x4 w; w.x = cvt_pk_bf16(v0[0], v0[1]); w.y = cvt_pk_bf16(v0[2], v0[3]); w.z = cvt_pk_bf16(v1[0], v1[1]); w.w = cvt_pk_bf16(v1[2], v1[3]);
                        *(u32x4*)(y + (size_t)p * 1024 + c) = w; } }
                asm volatile("" ::: "memory"); }
    }
};
}

__device__ __forceinline__ void run_gemm_dense_bf16(const int WV, PG8_LAS unsigned char* lds, const bf16_t* A, const bf16_t* Bt, int M, int N, int K, bf16_t* O, int ldo, int gelu_from) {
    pg8::Gemm g; g.A = A; g.Bt = Bt; g.wstride = 0; g.K = K; g.pad_ = 0;
    pg8::StaticOrder S; S.init(M, N, gridDim.x, blockIdx.x); pg8::EpiBf16 E{O, ldo, gelu_from}; pg8::gemm_phase<1024>(WV, lds, g, S, E);
}
template <bool XIN16>
__device__ __forceinline__ void run_gemm_dense_res(const int WV, PG8_LAS unsigned char* lds, const bf16_t* A, const bf16_t* Bt, int M, int N, int K, const void* xin, bf16_t* xout, const float* gt) {
    pg8::Gemm g; g.A = A; g.Bt = Bt; g.wstride = 0; g.K = K; g.pad_ = 0;
    pg8::StaticOrder S; S.init(M, N, gridDim.x, blockIdx.x); pg8::EpiRes16<XIN16> E{xin, xout, gt}; pg8::gemm_phase<1024>(WV, lds, g, S, E);
}
template <int SIG>
__device__ __forceinline__ void run_gemm_g1(const int WV, PG8_LAS unsigned char* lds, CParams& p, const bf16_t* A, const bf16_t* Bt, bf16_t* act) {
    pg8::Gemm g; g.A = A; g.Bt = Bt; g.wstride = (size_t)512 * 1024; g.K = 1024; g.pad_ = 0;
    const int l16 = otid(WV) & 63; const int cv = (l16 < 16) ? __hip_atomic_load(p.cnt + l16, __ATOMIC_RELAXED, __HIP_MEMORY_SCOPE_AGENT) : 0;
    int ntile = 0;
    for (int e = 0; e < 16; ++e) ntile += (__builtin_amdgcn_readlane(cv, e) + 255) >> 8;
    pg8::MoeOrder<2, 1, SIG> S{p.cnt, p.list, (int)gridDim.x, (int)blockIdx.x, cv, p.cnt + 64, (2 * ntile) / (int)gridDim.x, (2 * ntile) % (int)gridDim.x}; pg8::EpiG1 E{act, p.list, p.gw}; pg8::gemm_phase<1024>(WV, lds, g, S, E);
}
__device__ __forceinline__ void run_gemm_g2(const int WV, PG8_LAS unsigned char* lds, CParams& p, const bf16_t* A, const bf16_t* Bt, bf16_t* y) {
    pg8::Gemm g; g.A = A; g.Bt = Bt; g.wstride = (size_t)1024 * 256; g.K = 256; g.pad_ = 0;
    const int l16 = otid(WV) & 63; const int cv = (l16 < 16) ? __hip_atomic_load(p.cnt + l16, __ATOMIC_RELAXED, __HIP_MEMORY_SCOPE_AGENT) : 0;
    int ntile = 0;
    for (int e = 0; e < 16; ++e) ntile += (__builtin_amdgcn_readlane(cv, e) + 255) >> 8;
    pg8::MoeOrder<4, 0, 2> S{p.cnt, p.list, (int)gridDim.x, (int)blockIdx.x, cv, p.cnt + 64, (2 * ntile) / (int)gridDim.x, (2 * ntile) % (int)gridDim.x}; pg8::EpiG2 E{y, p.list}; pg8::gemm_phase<256>(WV, lds, g, S, E);
}

__device__ __forceinline__ CParams* kparams() { CParams* q = (CParams*)__builtin_amdgcn_kernarg_segment_ptr(); asm volatile("" : "+s"(q)); return q; }
#define KP (*kparams())

#define XB_TMO      128
#define XB_XCNT(j)  (256  + 64 * (j))
#define XB_XSUB(j)  (1280 + 64 * (j))
#define XB_XGEN(j)  (2304 + 64 * (j))
#define XB_TOP      3328
#define XB_TOPGEN   3392
#define XCD_BAR_WORDS 3456
#define XB_SPIN_CAP (1u << 22)
__device__ __forceinline__ unsigned xb_ld(unsigned* p)              { return __hip_atomic_load(p, __ATOMIC_RELAXED, __HIP_MEMORY_SCOPE_AGENT); }
__device__ __forceinline__ unsigned xb_add(unsigned* p, unsigned v) { return __hip_atomic_fetch_add(p, v, __ATOMIC_RELAXED, __HIP_MEMORY_SCOPE_AGENT); }
__device__ __forceinline__ unsigned xb_xcc_id() { return (unsigned)__builtin_amdgcn_s_getreg((3 << 11) | 20) & 0xFu; }
#define XB_SPIN(cond, bar) do { unsigned _sp = 0; while (cond) { __builtin_amdgcn_s_sleep(1); \
    if ((++_sp & 255u) == 0u) { if (xb_ld(&(bar)[XB_TMO])) break; if (_sp > XB_SPIN_CAP) { atomicAdd(&(bar)[XB_TMO], 1u); break; } } } } while (0)
__device__ __forceinline__ void xcd_barrier_complete(unsigned* bar, unsigned x, unsigned& nloc, unsigned& nx) {
    const unsigned G = gridDim.x;
    unsigned sum, cnt, mine, sp = 0u;
    for (;;) {
        sum = 0u; cnt = 0u; mine = 0u;
#pragma unroll
        for (unsigned j = 0; j < 16; ++j) { const unsigned c = xb_ld(&bar[XB_XCNT(j)]); sum += c; cnt += (c > 0u) ? 1u : 0u; mine = (j == x) ? c : mine; }
        if (sum == G) break;
        __builtin_amdgcn_s_sleep(1);
        if ((++sp & 255u) == 0u) { if (xb_ld(&bar[XB_TMO])) break; if (sp > XB_SPIN_CAP) { atomicAdd(&bar[XB_TMO], 1u); break; } }
    }
    nloc = mine > 0u ? mine : 1u; nx = cnt > 0u ? cnt : 1u;
}
__device__ __forceinline__ void xcd_barrier(const int WV, unsigned* bar, volatile PG8_LAS unsigned* st) {
    asm volatile("s_waitcnt vmcnt(0)" ::: "memory");
    __syncthreads();
    if (otid(WV) == 0) {
        __builtin_amdgcn_s_waitcnt(0);
        const unsigned x = xb_xcc_id();
        unsigned nloc = st[0], nx = st[1];
        if (nloc == 0u) { xcd_barrier_complete(bar, x, nloc, nx); st[0] = nloc; st[1] = nx; }
        const unsigned old = xb_add(&bar[XB_XSUB(x)], 1u);
        const unsigned gen = old / nloc;
        if (old + 1u == (gen + 1u) * nloc) {
            __builtin_amdgcn_fence(__ATOMIC_RELEASE, "agent");
            asm volatile("s_waitcnt vmcnt(0)" ::: "memory");
            const unsigned og = xb_add(&bar[XB_TOP], 1u);
            const unsigned tg = og / nx;
            if (og + 1u == (tg + 1u) * nx) xb_add(&bar[XB_TOPGEN], 1u);
            else XB_SPIN(xb_ld(&bar[XB_TOPGEN]) == tg, bar);
            __builtin_amdgcn_fence(__ATOMIC_ACQUIRE, "agent");
            xb_add(&bar[XB_XGEN(x)], 1u);
            asm volatile("s_waitcnt vmcnt(0)" ::: "memory");
        } else {
            XB_SPIN(xb_ld(&bar[XB_XGEN(x)]) == gen, bar);
            __builtin_amdgcn_fence(__ATOMIC_ACQUIRE, "agent");
            asm volatile("s_waitcnt vmcnt(0)" ::: "memory");
        }
    }
    __syncthreads();
}
__global__ __launch_bounds__(512) void k_mega(Params p_unused) {
    extern __shared__ __attribute__((aligned(16))) unsigned char smem[];
    PG8_LAS unsigned char* lds = (PG8_LAS unsigned char*)smem;
    cg::grid_group grid = cg::this_grid();
    const int WV = __builtin_amdgcn_readfirstlane(threadIdx.x >> 6);
    volatile PG8_LAS unsigned* xb_st = (volatile PG8_LAS unsigned*)(lds + (LDS_BYTES - 16));
    { unsigned* bar0 = KP.bar; if (threadIdx.x == 0) { xb_st[0] = 0u; xb_st[1] = 0u; (void)xb_add(&bar0[XB_XCNT(xb_xcc_id())], 1u); } }
    __syncthreads();
#define GSYNC() xcd_barrier(WV, KP.bar, xb_st)
#define MOD0 (KP.mod)
#define MOD1 (KP.mod + 16 * 6144)
#define PROJB ((bf16_t*)KP.PROJ)
#define ACTB ((bf16_t*)KP.PROJ)
#define YB ((bf16_t*)KP.PROJ + (size_t)2 * T_ * 256)
#define XA16(p_) ((bf16_t*)(p_).PROJ + (size_t)2 * T_ * 256 + (size_t)2 * T_ * 1024)
    ph_tcvt<MapEv>(WV, KP.ev_w_in, 3596, 1024, KP.W_evin, 0, 0, 1, smem);
    ph_tcvt<MapId>(WV, KP.ev_w_out, 1024, 1024, KP.W_evout, 0, 0, 1, smem);
    ph_tcvt<MapId>(WV, KP.od_w_in, 2048, 1024, KP.W_odin, 0, 0, 1, smem);
    ph_tcvt<MapId>(WV, KP.od_w_out, 1024, 1024, KP.W_odout, 0, 0, 1, smem);
    ph_tcvt<MapEven>(WV, KP.moe_wg, 256, 1024, KP.W_moe1, (size_t)1024 * 256, (size_t)512 * 1024, 32, smem);
    ph_tcvt<MapOdd>(WV, KP.moe_wu, 256, 1024, KP.W_moe1, (size_t)1024 * 256, (size_t)512 * 1024, 32, smem);
    ph_tcvt<MapId>(WV, KP.moe_wd, 1024, 256, KP.W_moe2, (size_t)256 * 1024, (size_t)1024 * 256, 32, smem);
    ph_tcvt<MapId>(WV, KP.od_wr, 128, 128, KP.W_lr, (size_t)128 * 128, (size_t)128 * 128, 4, smem);
    ph_tcvt<MapId>(WV, KP.od_wi, 128, 128, KP.W_li, (size_t)128 * 128, (size_t)128 * 128, 4, smem);
    { CParams& p = KP; ph_misc(WV, p); }
    { CParams& p = KP; ph_mod(WV, p, smem); }
    if (KP.bar == nullptr) grid.sync();
    GSYNC();
    { CParams& p = KP; ph_norm<false, false>(WV, p, p.x, nullptr, nullptr, nullptr, p.norm1_g, p.mod + 1024, p.mod + 0, p.H, smem); }
    GSYNC();
    { CParams& p = KP; ph_small_gemm(WV, p, smem); }
    run_gemm_dense_bf16(WV, lds, KP.H, KP.W_evin, T_, EVN, 1024, PROJB, EVN, 1 << 20);
    GSYNC();
    { CParams& p = KP; bf16_t* fx = (bf16_t*)p.out; const DnBufs d{p.H, p.H + (size_t)T_ * 512, p.VN, fx + (size_t)3 * T_ * 512, p.DNQK, p.DNGL}; ph_dn_prep(WV, p, (const bf16_t*)p.PROJ, d, smem); }
    { CParams& p = KP; ph_cumsum(WV, p, smem); }
    { CParams& p = KP; bf16_t* fx = (bf16_t*)p.out; ph_foxpre(WV, p, (const bf16_t*)p.PROJ, fx, fx + (size_t)2 * T_ * 512, smem); }
    GSYNC();
    { CParams& p = KP; bf16_t* fx = (bf16_t*)p.out; const DnBufs d{p.H, p.H + (size_t)T_ * 512, p.VN, fx + (size_t)3 * T_ * 512, p.DNQK, p.DNGL}; ph_dn_scan(WV, p, (const bf16_t*)p.PROJ, d, p.OMIX, smem); }
    { CParams& p = KP; const bf16_t* fx = (const bf16_t*)p.out; ph_fox_flash(WV, p, (const bf16_t*)p.PROJ, fx, fx + (size_t)2 * T_ * 512, p.OMIX, smem); }
    GSYNC();
    { CParams& p = KP; run_gemm_dense_res<false>(WV, lds, p.OMIX, p.W_evout, T_, 1024, 1024, p.x, XA16(p), p.mod + 2048); }
    GSYNC();
    { CParams& p = KP; ph_route(WV, p, XA16(p), p.norm2_g, p.mod + 4096, p.mod + 3072, p.H, smem); }
    GSYNC();
    { CParams& p = KP; run_gemm_g1<1>(WV, lds, p, p.H, p.W_moe1, (bf16_t*)p.PROJ); }
    GSYNC();
    { CParams& p = KP; run_gemm_g1<3>(WV, lds, p, p.H, p.W_moe1, (bf16_t*)p.PROJ); }
    { CParams& p = KP; run_gemm_g2(WV, lds, p, (const bf16_t*)p.PROJ, p.W_moe2, (bf16_t*)p.PROJ + (size_t)2 * T_ * 256); }
    GSYNC();
    { CParams& p = KP; ph_norm<true, true>(WV, p, XA16(p), (const bf16_t*)p.PROJ + (size_t)2 * T_ * 256, p.mod + 5120, XA16(p), p.norm1_g + 1024, p.mod + 16 * 6144 + 1024, p.mod + 16 * 6144, p.H, smem);
      { const int t0 = otid(WV); if (blockIdx.x == 0 && t0 < 512) p.cnt[t0] = 0; } }
    GSYNC();
    run_gemm_dense_bf16(WV, lds, KP.H, KP.W_odin, T_, 2048, 1024, PROJB, 2048, 2);
    GSYNC();
    { CParams& p = KP; ph_lru(WV, p, (const bf16_t*)p.PROJ, p.OMIX, smem); }
    { CParams& p = KP; ph_sgu(WV, p, (const bf16_t*)p.PROJ, p.OMIX, smem); }
    GSYNC();
    { CParams& p = KP; run_gemm_dense_res<true>(WV, lds, p.OMIX, p.W_odout, T_, 1024, 1024, XA16(p), XA16(p), p.mod + 16 * 6144 + 2048); }
    GSYNC();
    { CParams& p = KP; ph_route(WV, p, XA16(p), p.norm2_g + 1024, p.mod + 16 * 6144 + 4096, p.mod + 16 * 6144 + 3072, p.H, smem); }
    GSYNC();
    { CParams& p = KP; run_gemm_g1<1>(WV, lds, p, p.H, p.W_moe1 + (size_t)16 * 512 * 1024, (bf16_t*)p.PROJ); }
    GSYNC();
    { CParams& p = KP; run_gemm_g1<3>(WV, lds, p, p.H, p.W_moe1 + (size_t)16 * 512 * 1024, (bf16_t*)p.PROJ); }
    { CParams& p = KP; run_gemm_g2(WV, lds, p, (const bf16_t*)p.PROJ, p.W_moe2 + (size_t)16 * 1024 * 256, (bf16_t*)p.PROJ + (size_t)2 * T_ * 256); }
    GSYNC();
    { CParams& p = KP; ph_norm<true, false>(WV, p, XA16(p), (const bf16_t*)p.PROJ + (size_t)2 * T_ * 256, p.mod + 16 * 6144 + 5120, p.out, nullptr, nullptr, nullptr, nullptr, smem); }
}

static inline size_t al(size_t x) { return (x + 255) & ~(size_t)255; }

extern "C" void kernel_launch(void* const* d_in, const int* in_sizes, int n_in, void* d_out, int out_size, void* d_ws, size_t ws_size, hipStream_t stream) {
    Params p; memset(&p, 0, sizeof(p));
    const float** pin = (const float**)&p;
    for (int i = 0; i < 32; ++i) pin[i] = (const float*)d_in[i];
    p.out = (float*)d_out;
    unsigned char* ws = (unsigned char*)d_ws; size_t off = 0;
    auto take = [&](size_t bytes) { unsigned char* q = ws + off; off += al(bytes); return q; };
    p.W_evin = (bf16_t*)take((size_t)3600 * 1024 * 2);
    p.W_evout = (bf16_t*)take((size_t)1024 * 1024 * 2);
    p.W_odin = (bf16_t*)take((size_t)2048 * 1024 * 2);
    p.W_odout = (bf16_t*)take((size_t)1024 * 1024 * 2);
    p.W_moe1 = (bf16_t*)take((size_t)2 * 16 * 512 * 1024 * 2);
    p.W_moe2 = (bf16_t*)take((size_t)2 * 16 * 1024 * 256 * 2);
    p.W_lr = (bf16_t*)take((size_t)4 * 128 * 128 * 2);
    p.W_li = (bf16_t*)take((size_t)4 * 128 * 128 * 2);
    p.W_sgu = (bf16_t*)take((size_t)4 * 128 * 128 * 2);
    p.mod = (float*)take((size_t)2 * 16 * 6144 * 4);
    p.cnt = (int*)take(2048);
    p.bar = (unsigned*)take(16384);
    p.list = (int*)take((size_t)16 * T_ * 4);
    p.gw = (float*)take((size_t)2 * T_ * 4);
    p.gdec = (float*)take((size_t)T_ * 4 * 4);
    p.beta = (float*)take((size_t)T_ * 4 * 4);
    p.lf = (float*)take((size_t)T_ * 4 * 4);
    p.cum = (float*)take((size_t)T_ * 4 * 4);
    p.H = (bf16_t*)take((size_t)T_ * 1024 * 2);
    p.PROJ = take((size_t)T_ * 3600 * 2);
    p.OMIX = (bf16_t*)take((size_t)T_ * 1024 * 2);
    p.VN = (bf16_t*)take((size_t)T_ * 512 * 2);
    p.DNQK = (bf16_t*)take((size_t)4096 * 1024 * 2);
    p.DNGL = (float*)take((size_t)4096 * 4);
    p.small = (float*)take((size_t)T_ * 16 * 4);
    (void)ws_size; (void)n_in; (void)in_sizes; (void)out_size;

    static int grid_blocks = 0;
    if (!grid_blocks) {
        (void)hipFuncSetAttribute((const void*)k_mega, hipFuncAttributeMaxDynamicSharedMemorySize, LDS_BYTES);
        int dev = 0, cus = 0, per_cu = 0; (void)hipGetDevice(&dev); (void)hipDeviceGetAttribute(&cus, hipDeviceAttributeMultiprocessorCount, dev);
        (void)hipOccupancyMaxActiveBlocksPerMultiprocessor(&per_cu, k_mega, NT, LDS_BYTES);
        if (per_cu > 1) per_cu = 1;
        grid_blocks = cus * per_cu;
    }
    (void)hipMemsetAsync(p.bar, 0, 16384, stream);
    void* args[] = {&p};
    (void)hipLaunchCooperativeKernel((const void*)k_mega, dim3(grid_blocks), dim3(NT), args, LDS_BYTES, stream);
}
```

```cpp
#include <hip/hip_runtime.h>
#include <hip/hip_cooperative_groups.h>
#include <stdint.h>
#include <string.h>
namespace cg = cooperative_groups;

#define PG8_LAS __attribute__((address_space(3)))
typedef unsigned short bf16_t;
constexpr int B_ = 16, S_ = 2048, D_ = 1024, T_ = B_ * S_;
constexpr int EVN = 3584;
constexpr int NT = 512;
constexpr int LDS_BYTES = 139264;

__device__ __forceinline__ float bf2f(bf16_t b) { return __uint_as_float(((unsigned)b) << 16); }
__device__ __forceinline__ bf16_t f2bf(float f) { unsigned u = __float_as_uint(f); u += 0x7FFFu + ((u >> 16) & 1u); return (bf16_t)(u >> 16); }
typedef __bf16 pk_bf16x2_t __attribute__((ext_vector_type(2)));
typedef float pk_f32x2_t __attribute__((ext_vector_type(2)));
__device__ __forceinline__ unsigned pk_bf16(float lo, float hi) { pk_f32x2_t f = {lo, hi}; pk_bf16x2_t b = __builtin_convertvector(f, pk_bf16x2_t); return __builtin_bit_cast(unsigned, b); }
__device__ __forceinline__ float sigm(float x) { return __builtin_amdgcn_rcpf(1.f + __builtin_amdgcn_exp2f(-1.4426950408889634f * x)); }
__device__ __forceinline__ float siluf(float x) { return x * sigm(x); }
__device__ __forceinline__ float softplusf_(float x) { return x > 20.f ? x : log1pf(__expf(x)); }
__device__ __forceinline__ float softplus_fast(float x) { return x > 15.f ? x : __logf(1.f + __expf(x)); }
__device__ __forceinline__ float geluf_(float x) { const float x2 = x * x; const float t = x * fmaf(x2, -0.10294324f, -2.3022082f); return x * __builtin_amdgcn_rcpf(1.f + __builtin_amdgcn_exp2f(t)); }
template <int CTRL> __device__ __forceinline__ float dppf(float v) { return __int_as_float(__builtin_amdgcn_update_dpp(0, __float_as_int(v), CTRL, 0xf, 0xf, false)); }
__device__ __forceinline__ float red8_sum(float v) { v += dppf<0xB1>(v); v += dppf<0x4E>(v); v += dppf<0x141>(v); return v; }
__device__ __forceinline__ float wave_sum(float v) {
    v += dppf<0xB1>(v); v += dppf<0x4E>(v); v += dppf<0x141>(v); v += dppf<0x140>(v);
    { auto r = __builtin_amdgcn_permlane16_swap(__float_as_uint(v), __float_as_uint(v), false, false); v = __uint_as_float(r[0]) + __uint_as_float(r[1]); }
    { auto r = __builtin_amdgcn_permlane32_swap(__float_as_uint(v), __float_as_uint(v), false, false); v = __uint_as_float(r[0]) + __uint_as_float(r[1]); }
    return v;
}
__device__ __forceinline__ float wave_max(float v) {
    v = fmaxf(v, dppf<0xB1>(v)); v = fmaxf(v, dppf<0x4E>(v)); v = fmaxf(v, dppf<0x141>(v)); v = fmaxf(v, dppf<0x140>(v));
    { auto r = __builtin_amdgcn_permlane16_swap(__float_as_uint(v), __float_as_uint(v), false, false); v = fmaxf(__uint_as_float(r[0]), __uint_as_float(r[1])); }
    { auto r = __builtin_amdgcn_permlane32_swap(__float_as_uint(v), __float_as_uint(v), false, false); v = fmaxf(__uint_as_float(r[0]), __uint_as_float(r[1])); }
    return v;
}
__device__ __forceinline__ int otid(const int WV) { int l; asm volatile("v_mbcnt_lo_u32_b32 %0, -1, 0\n\tv_mbcnt_hi_u32_b32 %0, -1, %0" : "=v"(l)); return WV * 64 + l; }

struct Params {
    const float *x, *c, *ada_w, *ada_b, *norm1_g, *norm2_g, *ev_w_in, *ev_conv_w, *ev_a_log, *ev_dt_bias, *ev_onorm_g, *ev_f_bias, *ev_qnorm_g, *ev_knorm_g, *ev_w_out;
    const float *od_w_in, *od_conv_w, *od_conv_b, *od_wr, *od_br, *od_wi, *od_bi, *od_lam, *od_sgu_g, *od_sgu_w, *od_sgu_b, *od_w_out, *router_w, *router_b, *moe_wg, *moe_wu, *moe_wd;
    float* out;
    bf16_t *W_evin, *W_evout, *W_odin, *W_odout, *W_moe1, *W_moe2, *W_lr, *W_li, *W_sgu;
    float* mod; int* cnt; unsigned* bar; int* list; float* gw; float* gdec; float* beta; float* lf; float* cum;
    bf16_t* H; unsigned char* PROJ; bf16_t* OMIX; bf16_t* VN; bf16_t* DNQK; float* DNGL; float* small;
};
static_assert(sizeof(Params) % 8 == 0, "params");
typedef const __attribute__((address_space(4))) Params CParams;

struct MapEv { __device__ int operator()(int j) const { if (j < 2048) return j; if (j < 2056) return 3584 + (j - 2048); if (j < 3592) return j - 8; return j; } };
struct MapId { __device__ int operator()(int j) const { return j; } };
struct MapEven { __device__ int operator()(int j) const { return 2 * j; } };
struct MapOdd { __device__ int operator()(int j) const { return 2 * j + 1; } };
template <class F>
__device__ __forceinline__ void ph_tcvt(const int WV, const float* __restrict__ src0, int nsrc, int K, bf16_t* __restrict__ dst0, size_t sstride, size_t dstride, int nz, unsigned char* smem) {
    const int tix_ = otid(WV);
    float (*tile)[64][65] = (float (*)[64][65])smem; F rowmap;
    const int half = tix_ >> 8, tid = tix_ & 255, tx4 = tid & 15, ty4 = tid >> 4;
    const int nj = (nsrc + 63) >> 6, nk = K >> 6, ntiles = nj * nk * nz;
    float4 v[4];
    auto ldtile = [&](int vt) {
        const int z = vt / (nj * nk), rem = vt % (nj * nk), j0 = (rem % nj) * 64, k0 = (rem / nj) * 64;
        const float* src = src0 + (size_t)z * sstride;
#pragma unroll
        for (int ps = 0; ps < 4; ++ps) { v[ps] = make_float4(0.f, 0.f, 0.f, 0.f); if (j0 + 4 * tx4 < nsrc) v[ps] = *(const float4*)(src + (size_t)(k0 + ty4 + 16 * ps) * nsrc + j0 + 4 * tx4); }
    };
    int base = blockIdx.x * 2;
    if (base + half < ntiles) ldtile(base + half);
    for (; base < ntiles; base += gridDim.x * 2) {
        const int vt = base + half; const bool valid = vt < ntiles;
        const int z = vt / (nj * nk), rem = vt % (nj * nk), j0 = (rem % nj) * 64, k0 = (rem / nj) * 64;
        bf16_t* dst = dst0 + (size_t)z * dstride;
        __syncthreads();
        if (valid) {
#pragma unroll
            for (int ps = 0; ps < 4; ++ps) { const int kk = ty4 + 16 * ps; tile[half][kk][4 * tx4] = v[ps].x; tile[half][kk][4 * tx4 + 1] = v[ps].y; tile[half][kk][4 * tx4 + 2] = v[ps].z; tile[half][kk][4 * tx4 + 3] = v[ps].w; } }
        __syncthreads();
        { const int nvt = vt + gridDim.x * 2; if (nvt < ntiles) ldtile(nvt); }
        if (valid) { const int kq = tid & 15, jr = tid >> 4;
#pragma unroll
            for (int ps = 0; ps < 4; ++ps) { const int jj = jr + 16 * ps; if (j0 + jj < nsrc) { const int r = rowmap(j0 + jj);
                if (r >= 0) { uint2 o; o.x = pk_bf16(tile[half][4 * kq][jj], tile[half][4 * kq + 1][jj]); o.y = pk_bf16(tile[half][4 * kq + 2][jj], tile[half][4 * kq + 3][jj]);
                    *(uint2*)(dst + (size_t)r * K + k0 + 4 * kq) = o; } } } }
    }
    __syncthreads();
}
__device__ __forceinline__ void ph_misc(const int WV, CParams& p) {
    const int tix_ = otid(WV);
    const int gtid = blockIdx.x * NT + tix_, gn = gridDim.x * NT;
    for (int i = gtid; i < 4 * 128 * 128; i += gn) { const int s = i & 127, t = (i >> 7) & 127; p.W_sgu[i] = f2bf(s <= t ? p.od_sgu_w[i] : 0.f); }
    if (gtid < 512) p.cnt[gtid] = 0;
    for (int i = gtid; i < 4 * 1024 / 2; i += gn) ((unsigned*)(p.W_evin + (size_t)3596 * 1024))[i] = 0u;
}

__device__ __forceinline__ void ph_mod(const int WV, CParams& p, unsigned char* smem) {
    const int tix_ = otid(WV);
    const int lane = tix_ & 63, w = tix_ >> 6;
    float* ca = (float*)smem;
    float* red = ca + 16384;
    __syncthreads();
#pragma unroll 8
    for (int i = tix_; i < 16384; i += NT) { const int b = i >> 10, k = i & 1023; ca[k * 16 + b] = siluf(p.c[i]); }
    __syncthreads();
    for (int item = blockIdx.x; item < 256; item += gridDim.x) {
        const int cidx = item * 48 + min(lane, 47), l = cidx / 6144, j = cidx % 6144;
        float acc[16];
#pragma unroll
        for (int b = 0; b < 16; ++b) acc[b] = 0.f;
        const float* wp = p.ada_w + ((size_t)l * 1024 + 128 * w) * 6144 + j;
#pragma unroll 1
        for (int kb = 0; kb < 128; kb += 32) {
            float wv[32];
#pragma unroll
            for (int kk = 0; kk < 32; ++kk) wv[kk] = wp[(size_t)(kb + kk) * 6144];
#pragma unroll
            for (int kk = 0; kk < 32; ++kk) { const float4* cp = (const float4*)(ca + (128 * w + kb + kk) * 16);
                const float4 c0 = cp[0], c1 = cp[1], c2 = cp[2], c3 = cp[3]; const float x = wv[kk];
                acc[0] += c0.x * x; acc[1] += c0.y * x; acc[2] += c0.z * x; acc[3] += c0.w * x; acc[4] += c1.x * x; acc[5] += c1.y * x; acc[6] += c1.z * x; acc[7] += c1.w * x;
                acc[8] += c2.x * x; acc[9] += c2.y * x; acc[10] += c2.z * x; acc[11] += c2.w * x; acc[12] += c3.x * x; acc[13] += c3.y * x; acc[14] += c3.z * x; acc[15] += c3.w * x; }
        }
#pragma unroll
        for (int b = 0; b < 16; ++b) red[(w * 16 + b) * 64 + lane] = acc[b];
        __syncthreads();
#pragma unroll
        for (int i = 0; i < 2; ++i) { const int o = tix_ + i * NT, b = o >> 6, cl = o & 63; float sum = 0.f;
#pragma unroll
            for (int ww = 0; ww < 8; ++ww) sum += red[(ww * 16 + b) * 64 + cl];
            const int ci2 = item * 48 + cl, l2 = ci2 / 6144, j2 = ci2 % 6144;
            if (cl < 48) p.mod[((size_t)l2 * 16 + b) * 6144 + j2] = sum + p.ada_b[l2 * 6144 + j2]; }
        __syncthreads();
    }
}

__device__ __forceinline__ float4 ld_res4(const void* p, size_t idx, bool is16) {
    if (is16) { const uint2 v = *(const uint2*)((const bf16_t*)p + idx); return make_float4(__uint_as_float(v.x << 16), __uint_as_float(v.x & 0xffff0000u), __uint_as_float(v.y << 16), __uint_as_float(v.y & 0xffff0000u)); }
    return *(const float4*)((const float*)p + idx);
}
template <bool XIN16, bool XOUT16>
__device__ __forceinline__ void ph_norm(const int WV, CParams& p, const void* xin, const bf16_t* __restrict__ y, const float* __restrict__ gt2, void* xout,
                        const float* __restrict__ g, const float* __restrict__ sc, const float* __restrict__ sh, bf16_t* __restrict__ hout, unsigned char* smem) {
    const int tix_ = otid(WV);
    const int lane = tix_ & 63, wv = (blockIdx.x * NT + tix_) >> 6, nw = gridDim.x * (NT / 64);
    constexpr int U = 2;
    for (int tb = wv * U; tb < T_; tb += nw * U) {
        const int b = tb >> 11;
        float4 xv[U][4]; float ss[U];
#pragma unroll
        for (int u = 0; u < U; ++u)
#pragma unroll
            for (int i = 0; i < 4; ++i) xv[u][i] = ld_res4(xin, (size_t)(tb + u) * 1024 + i * 256 + lane * 4, XIN16);
        if (y) {
#pragma unroll
            for (int i = 0; i < 4; ++i) { const int col = i * 256 + lane * 4; const float4 gv = *(const float4*)(gt2 + b * 6144 + col);
#pragma unroll
                for (int u = 0; u < U; ++u) { const bf16_t* y0 = y + (size_t)(2 * (tb + u)) * 1024 + col; const uint2 a0 = *(const uint2*)y0, a1 = *(const uint2*)(y0 + 1024);
                    float4 v = xv[u][i];
                    v.x += gv.x * (__uint_as_float(a0.x << 16) + __uint_as_float(a1.x << 16)); v.y += gv.y * (__uint_as_float(a0.x & 0xffff0000u) + __uint_as_float(a1.x & 0xffff0000u));
                    v.z += gv.z * (__uint_as_float(a0.y << 16) + __uint_as_float(a1.y << 16)); v.w += gv.w * (__uint_as_float(a0.y & 0xffff0000u) + __uint_as_float(a1.y & 0xffff0000u));
                    xv[u][i] = v;
                    if (XOUT16) { uint2 o; o.x = pk_bf16(v.x, v.y); o.y = pk_bf16(v.z, v.w); *(uint2*)((bf16_t*)xout + (size_t)(tb + u) * 1024 + col) = o; }
                    else *(float4*)((float*)xout + (size_t)(tb + u) * 1024 + col) = v; } }
        }
        if (!hout) continue;
#pragma unroll
        for (int u = 0; u < U; ++u) { float a = 0.f;
#pragma unroll
            for (int i = 0; i < 4; ++i) a += xv[u][i].x * xv[u][i].x + xv[u][i].y * xv[u][i].y + xv[u][i].z * xv[u][i].z + xv[u][i].w * xv[u][i].w;
            ss[u] = rsqrtf(wave_sum(a) * (1.f / 1024.f) + 1e-6f); }
#pragma unroll
        for (int i = 0; i < 4; ++i) {
            const int col = i * 256 + lane * 4;
            const float4 gv = *(const float4*)(g + col), scv = *(const float4*)(sc + b * 6144 + col), shv = *(const float4*)(sh + b * 6144 + col);
            const float m0 = gv.x * (1.f + scv.x), m1 = gv.y * (1.f + scv.y), m2 = gv.z * (1.f + scv.z), m3 = gv.w * (1.f + scv.w);
#pragma unroll
            for (int u = 0; u < U; ++u) { const float r = ss[u];
                uint2 o; o.x = pk_bf16(xv[u][i].x * r * m0 + shv.x, xv[u][i].y * r * m1 + shv.y); o.y = pk_bf16(xv[u][i].z * r * m2 + shv.z, xv[u][i].w * r * m3 + shv.w);
                *(uint2*)(hout + (size_t)(tb + u) * 1024 + col) = o; }
        }
    }
}

typedef short dn_bf16x8 __attribute__((ext_vector_type(8)));
typedef float dn_f32x4 __attribute__((ext_vector_type(4)));
struct DnBufs { bf16_t* Wp; bf16_t* QDp; bf16_t* KDTp; bf16_t* UTp; bf16_t* QKp; float* GL; };
__device__ __forceinline__ dn_f32x4 dn_mfma(dn_bf16x8 a, dn_bf16x8 b, dn_f32x4 c) { return __builtin_amdgcn_mfma_f32_16x16x32_bf16(a, b, c, 0, 0, 0); }
__device__ __forceinline__ unsigned dn_pk(float lo, float hi) { return pk_bf16(lo, hi); }
#define DN_LFENCE() asm volatile("s_waitcnt lgkmcnt(0)" ::: "memory")

__device__ __forceinline__ void dn_conv_tile(const bf16_t* __restrict__ proj, const float* __restrict__ cw, int t0, int s0, int ten, int hd, int lane, bf16_t* tile) {
    const int col = ten * 512 + hd * 128 + lane * 2;
    const float wa0 = cw[0 * 1536 + col], wa1 = cw[1 * 1536 + col], wa2 = cw[2 * 1536 + col], wa3 = cw[3 * 1536 + col];
    const float wb0 = cw[0 * 1536 + col + 1], wb1 = cw[1 * 1536 + col + 1], wb2 = cw[2 * 1536 + col + 1], wb3 = cw[3 * 1536 + col + 1];
    const bf16_t* src = proj + (size_t)t0 * EVN + col;
    float a0 = 0.f, a1 = 0.f, a2 = 0.f, b0 = 0.f, b1 = 0.f, b2 = 0.f;
    if (s0 > 0) {
        const unsigned p0 = *(const unsigned*)(src - 3 * EVN), p1 = *(const unsigned*)(src - 2 * EVN), p2 = *(const unsigned*)(src - 1 * EVN);
        a0 = __uint_as_float(p0 << 16); b0 = __uint_as_float(p0 & 0xffff0000u); a1 = __uint_as_float(p1 << 16); b1 = __uint_as_float(p1 & 0xffff0000u); a2 = __uint_as_float(p2 << 16); b2 = __uint_as_float(p2 & 0xffff0000u);
    }
#pragma unroll
    for (int rb = 0; rb < 2; ++rb) {
        unsigned pv[16];
#pragma unroll
        for (int r = 0; r < 16; ++r) pv[r] = *(const unsigned*)(src + (size_t)(rb * 16 + r) * EVN);
#pragma unroll
        for (int r = 0; r < 16; ++r) {
            const float a3 = __uint_as_float(pv[r] << 16), b3 = __uint_as_float(pv[r] & 0xffff0000u);
            const float oa = siluf(wa0 * a0 + wa1 * a1 + wa2 * a2 + wa3 * a3), ob = siluf(wb0 * b0 + wb1 * b1 + wb2 * b2 + wb3 * b3);
            *(unsigned*)(tile + (rb * 16 + r) * 136 + lane * 2) = dn_pk(oa, ob);
            a0 = a1; a1 = a2; a2 = a3; b0 = b1; b1 = b2; b2 = b3;
        }
    }
}

__device__ __forceinline__ void ph_dn_prep(const int WV, CParams& p, const bf16_t* __restrict__ proj, const DnBufs d, unsigned char* smem) {
    const int tid = otid(WV), lane = tid & 63, w = tid >> 6, c = lane & 15, g = lane >> 4;
    unsigned char* base = smem + w * 16896;
    bf16_t* tile = (bf16_t*)base; float* Lm = (float*)(base + 8704); bf16_t* Tm = (bf16_t*)(base + 13312); float* tab = (float*)(base + 15872);
    float* t_gc = tab, *t_be = tab + 32, *t_ek = tab + 64, *t_dk = tab + 96, *t_rk = tab + 128, *t_rq = tab + 160;
    const int gw = blockIdx.x * (NT / 64) + w, nw = gridDim.x * (NT / 64);
    for (int ci = gw; ci < 64 * 64; ci += nw) {
        const int bh = ci >> 6, ch = ci & 63, b = bh >> 2, hd = bh & 3, s0 = ch * 32, t0 = b * S_ + s0;
        DN_LFENCE();
        if (lane < 32) { const float* sp = p.small + (size_t)(t0 + lane) * 16; t_gc[lane] = -__expf(p.ev_a_log[hd]) * softplus_fast(sp[hd] + p.ev_dt_bias[hd]); t_be[lane] = sigm(sp[4 + hd]); }
        DN_LFENCE();
        float gcs = 0.f;
        if (lane < 32) { for (int i = 0; i <= lane; ++i) gcs += t_gc[i]; }
        DN_LFENCE();
        if (lane < 32) { t_gc[lane] = gcs; t_ek[lane] = __expf(gcs); }
        DN_LFENCE();
        const float gc31 = t_gc[31];
        if (lane < 32) t_dk[lane] = __expf(gc31 - gcs);
        dn_conv_tile(proj, p.ev_conv_w, t0, s0, 1, hd, lane, tile);
        DN_LFENCE();
        dn_bf16x8 Kr[2][4];
#pragma unroll
        for (int mi = 0; mi < 2; ++mi)
#pragma unroll
            for (int s = 0; s < 4; ++s) Kr[mi][s] = *(const dn_bf16x8*)(tile + (16 * mi + c) * 136 + 32 * s + 8 * g);
        union U8 { dn_bf16x8 v; unsigned short e[8]; unsigned u[4]; };
        U8 KT[8];
#pragma unroll
        for (int mb = 0; mb < 8; ++mb)
#pragma unroll
            for (int jj = 0; jj < 8; ++jj) KT[mb].e[jj] = tile[(16 * (jj >> 2) + 4 * g + (jj & 3)) * 136 + 16 * mb + c];
        dn_f32x4 ak[2][2];
#pragma unroll
        for (int mi = 0; mi < 2; ++mi)
#pragma unroll
            for (int nj = 0; nj < 2; ++nj) { dn_f32x4 a = {0.f, 0.f, 0.f, 0.f};
#pragma unroll
                for (int s = 0; s < 4; ++s) a = dn_mfma(Kr[mi][s], Kr[nj][s], a);
                ak[mi][nj] = a; }
#pragma unroll
        for (int mi = 0; mi < 2; ++mi)
#pragma unroll
            for (int r = 0; r < 4; ++r) if (g == (c >> 2) && (c & 3) == r) t_rk[16 * mi + c] = rsqrtf(ak[mi][mi][r] + 1e-6f);
        DN_LFENCE();
#pragma unroll
        for (int mi = 0; mi < 2; ++mi)
#pragma unroll
            for (int nj = 0; nj < 2; ++nj)
#pragma unroll
                for (int r = 0; r < 4; ++r) { const int i = 16 * mi + 4 * g + r, j = 16 * nj + c;
                    const float v = (i > j) ? t_be[i] * t_rk[i] * t_rk[j] * ak[mi][nj][r] * __expf(t_gc[i] - t_gc[j]) : 0.f;
                    Lm[i * 36 + j] = v; }
        DN_LFENCE();
        {
            const int cc = lane & 31;
            float T[32];
#pragma unroll
            for (int i = 0; i < 32; ++i) {
                float acc = (i == cc) ? 1.f : 0.f;
#pragma unroll
                for (int j4 = 0; j4 < (i + 3) / 4; ++j4) { const dn_f32x4 lv = *(const dn_f32x4*)(Lm + i * 36 + 4 * j4);
#pragma unroll
                    for (int q = 0; q < 4; ++q) if (4 * j4 + q < i) acc -= lv[q] * T[4 * j4 + q]; }
                T[i] = acc;
            }
            if (lane < 32) {
#pragma unroll
                for (int i = 0; i < 32; ++i) Tm[i * 40 + cc] = f2bf(T[i]);
            }
        }
        DN_LFENCE();
        U8 Tr[2];
#pragma unroll
        for (int mi = 0; mi < 2; ++mi) { const uint2 lo = *(const uint2*)(Tm + (16 * mi + c) * 40 + 4 * g), hi = *(const uint2*)(Tm + (16 * mi + c) * 40 + 16 + 4 * g);
            Tr[mi].u[0] = lo.x; Tr[mi].u[1] = lo.y; Tr[mi].u[2] = hi.x; Tr[mi].u[3] = hi.y; }
        dn_conv_tile(proj, p.ev_conv_w, t0, s0, 0, hd, lane, tile);
        DN_LFENCE();
        dn_f32x4 as_[2][2];
        {
            dn_bf16x8 Qr[2][4];
#pragma unroll
            for (int ni = 0; ni < 2; ++ni)
#pragma unroll
                for (int s = 0; s < 4; ++s) Qr[ni][s] = *(const dn_bf16x8*)(tile + (16 * ni + c) * 136 + 32 * s + 8 * g);
#pragma unroll
            for (int mj = 0; mj < 2; ++mj)
#pragma unroll
                for (int ni = 0; ni < 2; ++ni) { dn_f32x4 a = {0.f, 0.f, 0.f, 0.f};
#pragma unroll
                    for (int s = 0; s < 4; ++s) a = dn_mfma(Kr[mj][s], Qr[ni][s], a);
                    as_[mj][ni] = a; }
#pragma unroll
            for (int ni = 0; ni < 2; ++ni) { dn_f32x4 a = {0.f, 0.f, 0.f, 0.f};
#pragma unroll
                for (int s = 0; s < 4; ++s) a = dn_mfma(Qr[ni][s], Qr[ni][s], a);
#pragma unroll
                for (int r = 0; r < 4; ++r) if (g == (c >> 2) && (c & 3) == r) t_rq[16 * ni + c] = rsqrtf(a[r] + 1e-6f) * 0.08838834764831845f; }
        }
        DN_LFENCE();
        { bf16_t* qo = d.QDp + (size_t)ci * 4096;
#pragma unroll
            for (int it = 0; it < 8; ++it) { const int id = it * 64 + lane, i = id >> 4, s = (id >> 2) & 3, gg = id & 3;
                const uint2 lo = *(const uint2*)(tile + i * 136 + 32 * s + 4 * gg), hi = *(const uint2*)(tile + i * 136 + 32 * s + 16 + 4 * gg);
                const float f = t_rq[i] * t_ek[i];
                uint4 o; o.x = dn_pk(__uint_as_float(lo.x << 16) * f, __uint_as_float(lo.x & 0xffff0000u) * f); o.y = dn_pk(__uint_as_float(lo.y << 16) * f, __uint_as_float(lo.y & 0xffff0000u) * f);
                o.z = dn_pk(__uint_as_float(hi.x << 16) * f, __uint_as_float(hi.x & 0xffff0000u) * f); o.w = dn_pk(__uint_as_float(hi.y << 16) * f, __uint_as_float(hi.y & 0xffff0000u) * f);
                *(uint4*)(qo + i * 128 + 32 * s + 8 * gg) = o; } }
        DN_LFENCE();
        dn_conv_tile(proj, p.ev_conv_w, t0, s0, 2, hd, lane, tile);
        DN_LFENCE();
        float bej[8], fwj[8], fkj[8];
#pragma unroll
        for (int jj = 0; jj < 8; ++jj) { const int j = 16 * (jj >> 2) + 4 * g + (jj & 3); const float rk = t_rk[j]; bej[jj] = t_be[j]; fwj[jj] = bej[jj] * rk * t_ek[j]; fkj[jj] = rk * t_dk[j]; }
        U8 VT[8];
#pragma unroll
        for (int nb = 0; nb < 8; ++nb) {
            float tv[8];
#pragma unroll
            for (int jj = 0; jj < 8; ++jj) tv[jj] = bf2f(tile[(16 * (jj >> 2) + 4 * g + (jj & 3)) * 136 + 16 * nb + c]) * bej[jj];
#pragma unroll
            for (int q = 0; q < 4; ++q) VT[nb].u[q] = dn_pk(tv[2 * q], tv[2 * q + 1]);
        }
        { bf16_t* uo = d.UTp + (size_t)ci * 4096;
#pragma unroll
            for (int nb = 0; nb < 8; ++nb)
#pragma unroll
                for (int mi = 0; mi < 2; ++mi) { const dn_f32x4 z4 = {0.f, 0.f, 0.f, 0.f}; const dn_f32x4 a = dn_mfma(Tr[mi].v, VT[nb].v, z4);
                    uint2 o; o.x = dn_pk(a[0], a[1]); o.y = dn_pk(a[2], a[3]); *(uint2*)(uo + (16 * nb + c) * 32 + 16 * mi + 4 * g) = o; } }
        { bf16_t* ko = d.KDTp + (size_t)ci * 4096; bf16_t* wo = d.Wp + (size_t)ci * 4096;
#pragma unroll
            for (int s = 0; s < 4; ++s) {
                U8 kw[2];
#pragma unroll
                for (int hf = 0; hf < 2; ++hf) { const int mb = 2 * s + hf; float kv[8];
#pragma unroll
                    for (int jj = 0; jj < 8; ++jj) kv[jj] = bf2f(KT[mb].e[jj]);
                    uint4 o; o.x = dn_pk(kv[0] * fkj[0], kv[1] * fkj[1]); o.y = dn_pk(kv[2] * fkj[2], kv[3] * fkj[3]); o.z = dn_pk(kv[4] * fkj[4], kv[5] * fkj[5]); o.w = dn_pk(kv[6] * fkj[6], kv[7] * fkj[7]);
                    *(uint4*)(ko + (16 * mb + c) * 32 + 8 * g) = o;
#pragma unroll
                    for (int q = 0; q < 4; ++q) kw[hf].u[q] = dn_pk(kv[2 * q] * fwj[2 * q], kv[2 * q + 1] * fwj[2 * q + 1]); }
#pragma unroll
                for (int ni = 0; ni < 2; ++ni) { const dn_f32x4 z4 = {0.f, 0.f, 0.f, 0.f};
                    const dn_f32x4 c0 = dn_mfma(kw[0].v, Tr[ni].v, z4), c1 = dn_mfma(kw[1].v, Tr[ni].v, z4);
                    uint4 o; o.x = dn_pk(c0[0], c0[1]); o.y = dn_pk(c0[2], c0[3]); o.z = dn_pk(c1[0], c1[1]); o.w = dn_pk(c1[2], c1[3]);
                    *(uint4*)(wo + (16 * ni + c) * 128 + 32 * s + 8 * g) = o; }
            } }
        { bf16_t* qo = d.QKp + (size_t)ci * 1024;
#pragma unroll
            for (int ni = 0; ni < 2; ++ni) { const int i = 16 * ni + c; const float rq = t_rq[i], gi = t_gc[i]; float v[8];
#pragma unroll
                for (int mj = 0; mj < 2; ++mj)
#pragma unroll
                    for (int r = 0; r < 4; ++r) { const int j = 16 * mj + 4 * g + r; v[4 * mj + r] = (i >= j) ? as_[mj][ni][r] * rq * t_rk[j] * __expf(gi - t_gc[j]) : 0.f; }
                uint4 o; o.x = dn_pk(v[0], v[1]); o.y = dn_pk(v[2], v[3]); o.z = dn_pk(v[4], v[5]); o.w = dn_pk(v[6], v[7]);
                *(uint4*)(qo + i * 32 + 8 * g) = o; } }
        if (lane == 0) d.GL[ci] = __expf(gc31);
    }
    __syncthreads();
}

#define DN_DECL(R) uint4 R##w, R##qd, R##kdt, R##ut, R##qk, R##z; float R##gl
#define DN_LOAD(R, ci_, trow_) do { const size_t _ci = (ci_); \
    R##w = *(const uint4*)(d.Wp + _ci * 4096 + tid * 8); R##qd = *(const uint4*)(d.QDp + _ci * 4096 + tid * 8); R##kdt = *(const uint4*)(d.KDTp + _ci * 4096 + tid * 8); \
    R##ut = *(const uint4*)(d.UTp + _ci * 4096 + tid * 8); R##qk = *(const uint4*)(d.QKp + _ci * 1024 + (tid & 127) * 8); R##gl = d.GL[_ci]; \
    R##z = *(const uint4*)(proj + (size_t)(trow_) * EVN + 1536 + hd * 128 + (tid & 15) * 8); } while (0)
#define DN_WRITE(R, bb_) do { unsigned char* _bb = (bb_); \
    *(uint4*)(_bb + (tid >> 4) * 272 + (tid & 15) * 16) = R##w; *(uint4*)(_bb + 8704 + (tid >> 4) * 272 + (tid & 15) * 16) = R##qd; \
    *(uint4*)(_bb + 17408 + tid * 16) = R##kdt; *(uint4*)(_bb + 25600 + tid * 16) = R##ut; if (tid < 128) *(uint4*)(_bb + 33792 + tid * 16) = R##qk; } while (0)
__device__ __forceinline__ void dn_step_compute(dn_f32x4 (&Sf)[8], const unsigned char* bb, float* Ot, float gl, int w, int c, int g) {
    union U8 { dn_bf16x8 v; unsigned u[4]; };
    U8 Sb[4];
#pragma unroll
    for (int s = 0; s < 4; ++s) { Sb[s].u[0] = dn_pk(Sf[2 * s][0], Sf[2 * s][1]); Sb[s].u[1] = dn_pk(Sf[2 * s][2], Sf[2 * s][3]); Sb[s].u[2] = dn_pk(Sf[2 * s + 1][0], Sf[2 * s + 1][1]); Sb[s].u[3] = dn_pk(Sf[2 * s + 1][2], Sf[2 * s + 1][3]); }
    dn_f32x4 vn[2], O[2];
#pragma unroll
    for (int mi = 0; mi < 2; ++mi) {
        dn_f32x4 P = {0.f, 0.f, 0.f, 0.f}, Oa = {0.f, 0.f, 0.f, 0.f};
#pragma unroll
        for (int s = 0; s < 4; ++s) { const dn_bf16x8 wa = *(const dn_bf16x8*)(bb + (16 * mi + c) * 272 + 64 * s + 16 * g); P = dn_mfma(wa, Sb[s].v, P);
            const dn_bf16x8 qa = *(const dn_bf16x8*)(bb + 8704 + (16 * mi + c) * 272 + 64 * s + 16 * g); Oa = dn_mfma(qa, Sb[s].v, Oa); }
        const uint2 uu = *(const uint2*)(bb + 25600 + (16 * w + c) * 64 + (16 * mi + 4 * g) * 2);
        vn[mi][0] = __uint_as_float(uu.x << 16) - P[0]; vn[mi][1] = __uint_as_float(uu.x & 0xffff0000u) - P[1]; vn[mi][2] = __uint_as_float(uu.y << 16) - P[2]; vn[mi][3] = __uint_as_float(uu.y & 0xffff0000u) - P[3];
        O[mi] = Oa;
    }
    U8 Vb; Vb.u[0] = dn_pk(vn[0][0], vn[0][1]); Vb.u[1] = dn_pk(vn[0][2], vn[0][3]); Vb.u[2] = dn_pk(vn[1][0], vn[1][1]); Vb.u[3] = dn_pk(vn[1][2], vn[1][3]);
#pragma unroll
    for (int mi = 0; mi < 2; ++mi) { const dn_bf16x8 qk = *(const dn_bf16x8*)(bb + 33792 + (16 * mi + c) * 64 + 16 * g); O[mi] = dn_mfma(qk, Vb.v, O[mi]);
#pragma unroll
        for (int r = 0; r < 4; ++r) Ot[(16 * mi + 4 * g + r) * 132 + 16 * w + c] = O[mi][r]; }
#pragma unroll
    for (int mb = 0; mb < 8; ++mb) { const dn_bf16x8 ka = *(const dn_bf16x8*)(bb + 17408 + (16 * mb + c) * 64 + 16 * g); Sf[mb] = dn_mfma(ka, Vb.v, Sf[mb] * gl); }
}
__device__ __forceinline__ void dn_step_norm(const float* Ot, uint4 zz, const float4 g0, const float4 g1, bf16_t* __restrict__ omix, size_t t, int hd, int tid) {
    const int row = tid >> 4, sub = tid & 15;
    const dn_f32x4 o0 = *(const dn_f32x4*)(Ot + row * 132 + sub * 8), o1 = *(const dn_f32x4*)(Ot + row * 132 + sub * 8 + 4);
    float ss = o0[0] * o0[0] + o0[1] * o0[1] + o0[2] * o0[2] + o0[3] * o0[3] + o1[0] * o1[0] + o1[1] * o1[1] + o1[2] * o1[2] + o1[3] * o1[3];
    ss += dppf<0xB1>(ss); ss += dppf<0x4E>(ss); ss += dppf<0x141>(ss); ss += dppf<0x140>(ss);
    const float rstd = rsqrtf(ss * (1.f / 128.f) + 1e-6f);
    uint4 ov;
    ov.x = dn_pk(o0[0] * rstd * g0.x * siluf(__uint_as_float(zz.x << 16)), o0[1] * rstd * g0.y * siluf(__uint_as_float(zz.x & 0xffff0000u)));
    ov.y = dn_pk(o0[2] * rstd * g0.z * siluf(__uint_as_float(zz.y << 16)), o0[3] * rstd * g0.w * siluf(__uint_as_float(zz.y & 0xffff0000u)));
    ov.z = dn_pk(o1[0] * rstd * g1.x * siluf(__uint_as_float(zz.z << 16)), o1[1] * rstd * g1.y * siluf(__uint_as_float(zz.z & 0xffff0000u)));
    ov.w = dn_pk(o1[2] * rstd * g1.z * siluf(__uint_as_float(zz.w << 16)), o1[3] * rstd * g1.w * siluf(__uint_as_float(zz.w & 0xffff0000u)));
    *(uint4*)(omix + (t + row) * 1024 + hd * 128 + sub * 8) = ov;
}
__device__ __forceinline__ void ph_dn_scan(const int WV, CParams& p, const bf16_t* __restrict__ proj, const DnBufs d, bf16_t* __restrict__ omix, unsigned char* smem) {
    const int tid = otid(WV), lane = tid & 63, w = tid >> 6, c = lane & 15, g = lane >> 4;
    constexpr int BUF = 35840, OFF_O = 2 * BUF, OSZ = 32 * 132 * 4;
    for (int bh = blockIdx.x; bh < 64; bh += gridDim.x) {
        const int b = bh >> 2, hd = bh & 3; const size_t ci0 = (size_t)bh * 64, tr0 = (size_t)b * S_ + (tid >> 4);
        dn_f32x4 Sf[8];
#pragma unroll
        for (int mb = 0; mb < 8; ++mb) Sf[mb] = (dn_f32x4){0.f, 0.f, 0.f, 0.f};
        const float4 og0 = *(const float4*)(p.ev_onorm_g + (tid & 15) * 8), og1 = *(const float4*)(p.ev_onorm_g + (tid & 15) * 8 + 4);
        DN_DECL(R0); DN_DECL(R1);
        DN_LOAD(R0, ci0, tr0);
        DN_LOAD(R1, ci0 + 1, tr0 + 32);
        __syncthreads();
        DN_WRITE(R0, smem);
        float gl0 = R0gl; uint4 z0 = R0z;
        __syncthreads();
        for (int ch = 0; ch < 64; ch += 2) {
            const int n2 = min(ch + 2, 63), n3 = min(ch + 3, 63);
            DN_LOAD(R0, ci0 + n2, tr0 + (size_t)n2 * 32);
            dn_step_compute(Sf, smem, (float*)(smem + OFF_O), gl0, w, c, g);
            DN_WRITE(R1, smem + BUF);
            const float gl1 = R1gl; const uint4 z1 = R1z;
            __syncthreads();
            dn_step_norm((const float*)(smem + OFF_O), z0, og0, og1, omix, (size_t)b * S_ + ch * 32, hd, tid);
            DN_LOAD(R1, ci0 + n3, tr0 + (size_t)n3 * 32);
            dn_step_compute(Sf, smem + BUF, (float*)(smem + OFF_O + OSZ), gl1, w, c, g);
            DN_WRITE(R0, smem); gl0 = R0gl; z0 = R0z;
            __syncthreads();
            dn_step_norm((const float*)(smem + OFF_O + OSZ), z1, og0, og1, omix, (size_t)b * S_ + (ch + 1) * 32, hd, tid);
        }
        __syncthreads();
    }
}

__device__ __forceinline__ void ph_small_gemm(const int WV, CParams& p, unsigned char* smem) {
    const int tid = otid(WV), lane = tid & 63, c = lane & 15, g4 = lane >> 4;
    constexpr int RP = 1032;
    bf16_t* Ws = (bf16_t*)smem;
    __syncthreads();
    for (int i = tid; i < 16 * 128; i += NT) { const int r = i >> 7, ch = i & 127; *(uint4*)(Ws + r * RP + ch * 8) = *(const uint4*)(p.W_evin + (size_t)(3584 + r) * 1024 + ch * 8); }
    __syncthreads();
    const int gw = blockIdx.x * (NT / 64) + (tid >> 6), nw = gridDim.x * (NT / 64);
    for (int rb = gw; rb < T_ / 16; rb += nw) {
        const bf16_t* ap = p.H + (size_t)(rb * 16 + c) * 1024 + 8 * g4;
        dn_f32x4 acc = {0.f, 0.f, 0.f, 0.f};
#pragma unroll
        for (int kb = 0; kb < 2; ++kb) {
            dn_bf16x8 af[16];
#pragma unroll
            for (int ks = 0; ks < 16; ++ks) af[ks] = *(const dn_bf16x8*)(ap + 32 * (kb * 16 + ks));
#pragma unroll
            for (int ks = 0; ks < 16; ++ks) acc = dn_mfma(af[ks], *(const dn_bf16x8*)(Ws + c * RP + 32 * (kb * 16 + ks) + 8 * g4), acc);
        }
#pragma unroll
        for (int r = 0; r < 4; ++r) p.small[(size_t)(rb * 16 + 4 * g4 + r) * 16 + c] = acc[r];
    }
    __syncthreads();
}
__device__ __forceinline__ uint4 fx_knorm(uint4 v, const float* __restrict__ gp) {
    const float4 ga = *(const float4*)gp, gb = *(const float4*)(gp + 4); const float g[8] = {ga.x, ga.y, ga.z, ga.w, gb.x, gb.y, gb.z, gb.w};
    const unsigned u[4] = {v.x, v.y, v.z, v.w}; float f[8]; float ss = 0.f;
#pragma unroll
    for (int k = 0; k < 4; ++k) { f[2 * k] = __uint_as_float(u[k] << 16); f[2 * k + 1] = __uint_as_float(u[k] & 0xffff0000u); ss += f[2 * k] * f[2 * k] + f[2 * k + 1] * f[2 * k + 1]; }
    ss += dppf<0xB1>(ss); ss += dppf<0x4E>(ss); ss += dppf<0x141>(ss); ss += dppf<0x140>(ss);
    const float r = rsqrtf(ss * (1.f / 128.f) + 1e-6f);
    uint4 o; o.x = pk_bf16(f[0] * r * g[0], f[1] * r * g[1]); o.y = pk_bf16(f[2] * r * g[2], f[3] * r * g[3]); o.z = pk_bf16(f[4] * r * g[4], f[5] * r * g[5]); o.w = pk_bf16(f[6] * r * g[6], f[7] * r * g[7]);
    return o;
}
__device__ __forceinline__ void ph_foxpre(const int WV, CParams& p, const bf16_t* __restrict__ proj, bf16_t* __restrict__ fk, bf16_t* __restrict__ vt, unsigned char* smem) {
    const int tix_ = otid(WV);
    bf16_t* tile = (bf16_t*)smem;
    for (int item = blockIdx.x; item < 64 * 32; item += gridDim.x) {
        const int bh = item >> 5, st = item & 31, bb = bh >> 2, hd = bh & 3, t0 = bb * S_ + st * 64;
        __syncthreads();
#pragma unroll
        for (int i = 0; i < 2; ++i) { const int id = tix_ + i * NT, r = id >> 4, c16 = id & 15;
            const uint4 kv = *(const uint4*)(proj + (size_t)(t0 + r) * EVN + 2560 + hd * 128 + c16 * 8);
            *(uint4*)(fk + ((size_t)bh * S_ + st * 64 + r) * 128 + c16 * 8) = fx_knorm(kv, p.ev_knorm_g + c16 * 8); }
#pragma unroll
        for (int i = 0; i < 2; ++i) { const int id = tix_ + i * NT, r = id >> 4, c16 = id & 15;
            const uint4 v = *(const uint4*)(proj + (size_t)(t0 + r) * EVN + 3072 + hd * 128 + c16 * 8);
            unsigned* d = (unsigned*)(tile + r * 130 + c16 * 8); d[0] = v.x; d[1] = v.y; d[2] = v.z; d[3] = v.w; }
        __syncthreads();
        { const int d = tix_ >> 2, qt = tix_ & 3; unsigned w[8];
#pragma unroll
            for (int i = 0; i < 8; ++i) w[i] = (unsigned)tile[(qt * 16 + 2 * i) * 130 + d] | ((unsigned)tile[(qt * 16 + 2 * i + 1) * 130 + d] << 16);
            uint4* dst = (uint4*)(vt + ((size_t)bh * 128 + d) * S_ + st * 64 + qt * 16);
            dst[0] = make_uint4(w[0], w[1], w[2], w[3]); dst[1] = make_uint4(w[4], w[5], w[6], w[7]); }
    }
    __syncthreads();
}
template <int CTRL, int RM> __device__ __forceinline__ float dppm(float v) { return __int_as_float(__builtin_amdgcn_update_dpp(0, __float_as_int(v), CTRL, RM, 0xf, false)); }
__device__ __forceinline__ float wave_iscan(float v) {
    v += dppm<0x111, 0xf>(v); v += dppm<0x112, 0xf>(v); v += dppm<0x114, 0xf>(v); v += dppm<0x118, 0xf>(v);
    v += dppm<0x142, 0xa>(v); v += dppm<0x143, 0xc>(v);
    return v;
}
__device__ __forceinline__ void ph_cumsum(const int WV, CParams& p, unsigned char* smem) {
    const int tix_ = otid(WV);
    const int lane = tix_ & 63, w = tix_ >> 6;
    float* tot = (float*)smem;
    for (int b = blockIdx.x; b < 16; b += gridDim.x) {
        const float f0 = p.ev_f_bias[0], f1 = p.ev_f_bias[1], f2 = p.ev_f_bias[2], f3 = p.ev_f_bias[3];
        const size_t tb = (size_t)b * S_ + 256 * w + 4 * lane;
        float4 v[4];
#pragma unroll
        for (int i = 0; i < 4; ++i) v[i] = *(const float4*)(p.small + (tb + i) * 16 + 8);
#pragma unroll
        for (int i = 0; i < 4; ++i) { v[i].x = -softplus_fast(-(v[i].x + f0)); v[i].y = -softplus_fast(-(v[i].y + f1)); v[i].z = -softplus_fast(-(v[i].z + f2)); v[i].w = -softplus_fast(-(v[i].w + f3)); }
#pragma unroll
        for (int i = 1; i < 4; ++i) { v[i].x += v[i - 1].x; v[i].y += v[i - 1].y; v[i].z += v[i - 1].z; v[i].w += v[i - 1].w; }
        float4 ex;
        { const float ix = wave_iscan(v[3].x), iy = wave_iscan(v[3].y), iz = wave_iscan(v[3].z), iw = wave_iscan(v[3].w);
          ex.x = ix - v[3].x; ex.y = iy - v[3].y; ex.z = iz - v[3].z; ex.w = iw - v[3].w;
          __syncthreads();
          if (lane == 63) { tot[w * 4] = ix; tot[w * 4 + 1] = iy; tot[w * 4 + 2] = iz; tot[w * 4 + 3] = iw; } }
        __syncthreads();
        for (int ww = 0; ww < w; ++ww) { ex.x += tot[ww * 4]; ex.y += tot[ww * 4 + 1]; ex.z += tot[ww * 4 + 2]; ex.w += tot[ww * 4 + 3]; }
#pragma unroll
        for (int i = 0; i < 4; ++i) *(float4*)(p.cum + (tb + i) * 4) = make_float4(v[i].x + ex.x, v[i].y + ex.y, v[i].z + ex.z, v[i].w + ex.w);
    }
    __syncthreads();
}

typedef short fx_bf16x8 __attribute__((ext_vector_type(8)));
typedef float fx_f32x16 __attribute__((ext_vector_type(16)));
typedef float fx_f32x4 __attribute__((ext_vector_type(4)));
__device__ __forceinline__ unsigned fx_pk(float lo, float hi) { return pk_bf16(lo, hi); }
__device__ __forceinline__ void ph_fox_flash(const int WV, CParams& p, const bf16_t* __restrict__ proj, const bf16_t* __restrict__ fk, const bf16_t* __restrict__ vt, bf16_t* __restrict__ omix, unsigned char* smem) {
    const int tid = otid(WV), lane = tid & 63, w = tid >> 6, c = lane & 31, h5 = lane >> 5;
    constexpr int KB = 16384, VB = 128 * 136, OFF_V = 2 * KB, OFF_B = OFF_V + 2 * VB, OFF_I = OFF_B + 2 * 256;
    constexpr float C2 = 0.08838834764831845f * 1.4426950408889634f, NEG_INV_SCALE = -11.313708498984761f;
    int* itemw = (int*)(smem + OFF_I);
    for (;;) {
        __syncthreads();
        if (tid == 0) itemw[0] = atomicAdd(p.cnt + 32, 1);
        __syncthreads();
        const int idx = itemw[0];
        if (idx >= 512) break;
        const int qb = 7 - (idx >> 6), bh = idx & 63, b = bh >> 2, hd = bh & 3;
        const int q0 = qb * 256 + w * 32, ntiles = 4 * (qb + 1);
        fx_bf16x8 qf[8];
        { const bf16_t* qp = proj + ((size_t)(b * S_ + q0 + c)) * EVN + 2048 + hd * 128 + 8 * h5;
          float ssq = 0.f;
#pragma unroll
          for (int s = 0; s < 8; ++s) { qf[s] = *(const fx_bf16x8*)(qp + 16 * s);
#pragma unroll
              for (int j = 0; j < 8; ++j) { const float v = bf2f((bf16_t)qf[s][j]); ssq += v * v; } }
          { auto rr = __builtin_amdgcn_permlane32_swap(__float_as_uint(ssq), __float_as_uint(ssq), false, false); ssq = __uint_as_float(rr[0]) + __uint_as_float(rr[1]); }
          const float rq = rsqrtf(ssq * (1.f / 128.f) + 1e-6f);
#pragma unroll
          for (int s = 0; s < 8; ++s) { const float4 g0 = *(const float4*)(p.ev_qnorm_g + 16 * s + 8 * h5), g1 = *(const float4*)(p.ev_qnorm_g + 16 * s + 8 * h5 + 4);
              union { fx_bf16x8 v; unsigned u[4]; } t;
              t.u[0] = pk_bf16(bf2f((bf16_t)qf[s][0]) * rq * g0.x, bf2f((bf16_t)qf[s][1]) * rq * g0.y); t.u[1] = pk_bf16(bf2f((bf16_t)qf[s][2]) * rq * g0.z, bf2f((bf16_t)qf[s][3]) * rq * g0.w);
              t.u[2] = pk_bf16(bf2f((bf16_t)qf[s][4]) * rq * g1.x, bf2f((bf16_t)qf[s][5]) * rq * g1.y); t.u[3] = pk_bf16(bf2f((bf16_t)qf[s][6]) * rq * g1.z, bf2f((bf16_t)qf[s][7]) * rq * g1.w);
              qf[s] = t.v; } }
        fx_f32x16 o[4];
#pragma unroll
        for (int mb = 0; mb < 4; ++mb)
#pragma unroll
            for (int r = 0; r < 16; ++r) o[mb][r] = 0.f;
        float m = -1e30f, l = 0.f;
        const float ct2 = p.cum[(size_t)(b * S_ + q0 + c) * 4 + hd] * 1.4426950408889634f;
        const bf16_t* kg = fk + (size_t)bh * S_ * 128;
        const bf16_t* vg = vt + (size_t)bh * 128 * S_;
        uint4 kr0, kr1, vr0, vr1; float br = 0.f;
        const int idA = tid, idB = tid + NT;
        kr0 = *(const uint4*)(kg + (size_t)(idA >> 4) * 128 + (idA & 15) * 8); kr1 = *(const uint4*)(kg + (size_t)(idB >> 4) * 128 + (idB & 15) * 8);
        vr0 = *(const uint4*)(vg + (size_t)(idA >> 3) * S_ + (idA & 7) * 8); vr1 = *(const uint4*)(vg + (size_t)(idB >> 3) * S_ + (idB & 7) * 8);
        if (tid < 64) br = p.cum[(size_t)(b * S_ + tid) * 4 + hd] * NEG_INV_SCALE;
        { const int rA = idA >> 4, chA = idA & 15, rB = idB >> 4, chB = idB & 15;
          *(uint4*)(smem + rA * 256 + ((chA ^ (rA & 15)) << 4)) = kr0; *(uint4*)(smem + rB * 256 + ((chB ^ (rB & 15)) << 4)) = kr1;
          uint2* vd = (uint2*)(smem + OFF_V + (idA >> 3) * 136 + (idA & 7) * 16); vd[0] = make_uint2(vr0.x, vr0.y); vd[1] = make_uint2(vr0.z, vr0.w);
          vd = (uint2*)(smem + OFF_V + (idB >> 3) * 136 + (idB & 7) * 16); vd[0] = make_uint2(vr1.x, vr1.y); vd[1] = make_uint2(vr1.z, vr1.w); }
        if (tid < 64) ((float*)(smem + OFF_B))[tid] = br;
        __syncthreads();
        for (int t = 0; t < ntiles; ++t) {
            const int cur = t & 1;
            if (t + 1 < ntiles) {
                const int k0 = (t + 1) * 64;
                kr0 = *(const uint4*)(kg + (size_t)(k0 + (idA >> 4)) * 128 + (idA & 15) * 8); kr1 = *(const uint4*)(kg + (size_t)(k0 + (idB >> 4)) * 128 + (idB & 15) * 8);
                vr0 = *(const uint4*)(vg + (size_t)(idA >> 3) * S_ + k0 + (idA & 7) * 8); vr1 = *(const uint4*)(vg + (size_t)(idB >> 3) * S_ + k0 + (idB & 7) * 8);
                if (tid < 64) br = p.cum[(size_t)(b * S_ + k0 + tid) * 4 + hd] * NEG_INV_SCALE;
            }
            const int kbase = t * 64;
            if (kbase <= q0) {
                const unsigned char* Kt = smem + cur * KB; const unsigned char* Vt = smem + OFF_V + cur * VB; const float* Bt = (const float*)(smem + OFF_B + cur * 256);
                const bool two = (kbase + 32 <= q0);
                fx_f32x16 sA, sB;
#pragma unroll
                for (int g = 0; g < 4; ++g) { const fx_f32x4 bv = *(const fx_f32x4*)(Bt + 8 * g + 4 * h5);
                    sA[4 * g] = bv[0]; sA[4 * g + 1] = bv[1]; sA[4 * g + 2] = bv[2]; sA[4 * g + 3] = bv[3]; }
#pragma unroll
                for (int s = 0; s < 8; ++s) { const fx_bf16x8 ka = *(const fx_bf16x8*)(Kt + c * 256 + (((2 * s + h5) ^ (c & 15)) << 4));
                    sA = __builtin_amdgcn_mfma_f32_32x32x16_bf16(ka, qf[s], sA, 0, 0, 0); }
                if (two) {
#pragma unroll
                    for (int g = 0; g < 4; ++g) { const fx_f32x4 bv = *(const fx_f32x4*)(Bt + 32 + 8 * g + 4 * h5);
                        sB[4 * g] = bv[0]; sB[4 * g + 1] = bv[1]; sB[4 * g + 2] = bv[2]; sB[4 * g + 3] = bv[3]; }
#pragma unroll
                    for (int s = 0; s < 8; ++s) { const fx_bf16x8 ka = *(const fx_bf16x8*)(Kt + (32 + c) * 256 + (((2 * s + h5) ^ (c & 15)) << 4));
                        sB = __builtin_amdgcn_mfma_f32_32x32x16_bf16(ka, qf[s], sB, 0, 0, 0); }
                } else {
#pragma unroll
                    for (int r = 0; r < 16; ++r) sB[r] = -__builtin_inff();
                }
                if (kbase + 31 > q0) { const int d0 = kbase - q0 + 4 * h5 - c;
#pragma unroll
                    for (int r = 0; r < 16; ++r) if (d0 + (r & 3) + 8 * (r >> 2) > 0) sA[r] = -__builtin_inff(); }
                if (two && kbase + 63 > q0) { const int d0 = kbase + 32 - q0 + 4 * h5 - c;
#pragma unroll
                    for (int r = 0; r < 16; ++r) if (d0 + (r & 3) + 8 * (r >> 2) > 0) sB[r] = -__builtin_inff(); }
                float mx = sA[0];
#pragma unroll
                for (int r = 1; r < 16; ++r) mx = fmaxf(mx, sA[r]);
#pragma unroll
                for (int r = 0; r < 16; ++r) mx = fmaxf(mx, sB[r]);
                { auto rr = __builtin_amdgcn_permlane32_swap(__float_as_uint(mx), __float_as_uint(mx), false, false); mx = fmaxf(__uint_as_float(rr[0]), __uint_as_float(rr[1])); }
                const float mc = fmaf(mx, C2, ct2);
                if (!__all(mc - m <= 8.f)) {
                    const float mn = fmaxf(m, mc); const float alpha = __builtin_amdgcn_exp2f(m - mn); m = mn; l *= alpha;
#pragma unroll
                    for (int mb = 0; mb < 4; ++mb)
#pragma unroll
                        for (int r = 0; r < 16; ++r) o[mb][r] *= alpha;
                }
                const float dm = ct2 - m;
                float ps = 0.f;
#pragma unroll
                for (int r = 0; r < 16; ++r) { sA[r] = __builtin_amdgcn_exp2f(fmaf(sA[r], C2, dm)); ps += sA[r]; }
#pragma unroll
                for (int r = 0; r < 16; ++r) { sB[r] = __builtin_amdgcn_exp2f(fmaf(sB[r], C2, dm)); ps += sB[r]; }
                l += ps;
#pragma unroll
                for (int s2 = 0; s2 < 2; ++s2) {
                    union { fx_bf16x8 v; unsigned u[4]; } pb;
#pragma unroll
                    for (int j = 0; j < 4; ++j) pb.u[j] = fx_pk(sA[8 * s2 + 2 * j], sA[8 * s2 + 2 * j + 1]);
#pragma unroll
                    for (int mb = 0; mb < 4; ++mb) { const unsigned char* vp = Vt + (mb * 32 + c) * 136 + (16 * s2 + 4 * h5) * 2;
                        union { fx_bf16x8 v; uint2 q[2]; } va; va.q[0] = *(const uint2*)vp; va.q[1] = *(const uint2*)(vp + 16);
                        o[mb] = __builtin_amdgcn_mfma_f32_32x32x16_bf16(va.v, pb.v, o[mb], 0, 0, 0); }
                }
                if (two) {
#pragma unroll
                    for (int s2 = 0; s2 < 2; ++s2) {
                        union { fx_bf16x8 v; unsigned u[4]; } pb;
#pragma unroll
                        for (int j = 0; j < 4; ++j) pb.u[j] = fx_pk(sB[8 * s2 + 2 * j], sB[8 * s2 + 2 * j + 1]);
#pragma unroll
                        for (int mb = 0; mb < 4; ++mb) { const unsigned char* vp = Vt + (mb * 32 + c) * 136 + (32 + 16 * s2 + 4 * h5) * 2;
                            union { fx_bf16x8 v; uint2 q[2]; } va; va.q[0] = *(const uint2*)vp; va.q[1] = *(const uint2*)(vp + 16);
                            o[mb] = __builtin_amdgcn_mfma_f32_32x32x16_bf16(va.v, pb.v, o[mb], 0, 0, 0); }
                    }
                }
            }
            if (t + 1 < ntiles) {
                const int nb = cur ^ 1; const int rA = idA >> 4, chA = idA & 15, rB = idB >> 4, chB = idB & 15;
                *(uint4*)(smem + nb * KB + rA * 256 + ((chA ^ (rA & 15)) << 4)) = kr0; *(uint4*)(smem + nb * KB + rB * 256 + ((chB ^ (rB & 15)) << 4)) = kr1;
                uint2* vd = (uint2*)(smem + OFF_V + nb * VB + (idA >> 3) * 136 + (idA & 7) * 16); vd[0] = make_uint2(vr0.x, vr0.y); vd[1] = make_uint2(vr0.z, vr0.w);
                vd = (uint2*)(smem + OFF_V + nb * VB + (idB >> 3) * 136 + (idB & 7) * 16); vd[0] = make_uint2(vr1.x, vr1.y); vd[1] = make_uint2(vr1.z, vr1.w);
                if (tid < 64) ((float*)(smem + OFF_B + nb * 256))[tid] = br;
            }
            __syncthreads();
        }
        { auto rr = __builtin_amdgcn_permlane32_swap(__float_as_uint(l), __float_as_uint(l), false, false); l = __uint_as_float(rr[0]) + __uint_as_float(rr[1]); }
        const float inv = 1.f / l;
        bf16_t* op = omix + (size_t)(b * S_ + q0 + c) * 1024 + 512 + hd * 128 + 4 * h5;
#pragma unroll
        for (int mb = 0; mb < 4; ++mb)
#pragma unroll
            for (int g = 0; g < 4; ++g) { uint2 ov; ov.x = fx_pk(o[mb][4 * g] * inv, o[mb][4 * g + 1] * inv); ov.y = fx_pk(o[mb][4 * g + 2] * inv, o[mb][4 * g + 3] * inv);
                *(uint2*)(op + mb * 32 + 8 * g) = ov; }
    }
}

__device__ __forceinline__ void ph_route(const int WV, CParams& p, const bf16_t* __restrict__ x, const float* __restrict__ g, const float* __restrict__ sc, const float* __restrict__ sh, bf16_t* __restrict__ h2, unsigned char* smem) {
    const int tix_ = otid(WV);
    const int lane = tix_ & 63, w = tix_ >> 6, c = lane & 15, g4 = lane >> 4;
    constexpr int RP = 1032;
    bf16_t* Rhi = (bf16_t*)smem;
    bf16_t* Rlo = Rhi + 16 * RP;
    float* mv = (float*)(smem + 2 * 16 * RP * 2);
    float* sv = mv + 1024;
    float* lgs = sv + 1024;
    int* selE = (int*)(lgs + 128 * 16);
    float* selW = (float*)(selE + 128);
    int* lcnt = (int*)(selW + 256);
    int* lbase = lcnt + 16;
    __syncthreads();
    for (int i = tix_; i < 16384; i += NT) { const int k = i >> 4, e = i & 15; const float r = p.router_w[i]; const bf16_t hi = f2bf(r); Rhi[e * RP + k] = hi; Rlo[e * RP + k] = f2bf(r - bf2f(hi)); }
    for (int chunk = blockIdx.x; chunk < T_ / 128; chunk += gridDim.x) {
        const int b = (chunk * 128) >> 11;
        __syncthreads();
        for (int k = tix_; k < 1024; k += NT) { mv[k] = g[k] * (1.f + sc[b * 6144 + k]); sv[k] = sh[b * 6144 + k]; }
        if (tix_ < 16) lcnt[tix_] = 0;
        __syncthreads();
        const int t = chunk * 128 + w * 16 + c;
        const bf16_t* xr = x + (size_t)t * 1024 + 8 * g4;
        float ss = 0.f;
#pragma unroll 8
        for (int s = 0; s < 32; ++s) { const uint4 xw = *(const uint4*)(xr + 32 * s); const unsigned u[4] = {xw.x, xw.y, xw.z, xw.w};
#pragma unroll
            for (int q = 0; q < 4; ++q) { const float a = __uint_as_float(u[q] << 16), bq = __uint_as_float(u[q] & 0xffff0000u); ss += a * a + bq * bq; } }
        { auto r = __builtin_amdgcn_permlane16_swap(__float_as_uint(ss), __float_as_uint(ss), false, false); ss = __uint_as_float(r[0]) + __uint_as_float(r[1]); }
        { auto r = __builtin_amdgcn_permlane32_swap(__float_as_uint(ss), __float_as_uint(ss), false, false); ss = __uint_as_float(r[0]) + __uint_as_float(r[1]); }
        const float rstd = rsqrtf(ss * (1.f / 1024.f) + 1e-6f);
        dn_f32x4 acc = {0.f, 0.f, 0.f, 0.f};
#pragma unroll 4
        for (int s = 0; s < 32; ++s) {
            const int k0 = 32 * s + 8 * g4;
            const uint4 xw = *(const uint4*)(xr + 32 * s); const unsigned u[4] = {xw.x, xw.y, xw.z, xw.w};
            const float4 m0 = *(const float4*)(mv + k0), m1 = *(const float4*)(mv + k0 + 4), s0 = *(const float4*)(sv + k0), s1 = *(const float4*)(sv + k0 + 4);
            float hv[8];
            hv[0] = __uint_as_float(u[0] << 16) * rstd * m0.x + s0.x; hv[1] = __uint_as_float(u[0] & 0xffff0000u) * rstd * m0.y + s0.y;
            hv[2] = __uint_as_float(u[1] << 16) * rstd * m0.z + s0.z; hv[3] = __uint_as_float(u[1] & 0xffff0000u) * rstd * m0.w + s0.w;
            hv[4] = __uint_as_float(u[2] << 16) * rstd * m1.x + s1.x; hv[5] = __uint_as_float(u[2] & 0xffff0000u) * rstd * m1.y + s1.y;
            hv[6] = __uint_as_float(u[3] << 16) * rstd * m1.z + s1.z; hv[7] = __uint_as_float(u[3] & 0xffff0000u) * rstd * m1.w + s1.w;
            union { dn_bf16x8 v; unsigned q[4]; uint4 w4; } ahi, alo;
#pragma unroll
            for (int q = 0; q < 4; ++q) { ahi.q[q] = pk_bf16(hv[2 * q], hv[2 * q + 1]);
                alo.q[q] = pk_bf16(hv[2 * q] - __uint_as_float(ahi.q[q] << 16), hv[2 * q + 1] - __uint_as_float(ahi.q[q] & 0xffff0000u)); }
            *(uint4*)(h2 + (size_t)t * 1024 + k0) = ahi.w4;
            const dn_bf16x8 bhi = *(const dn_bf16x8*)(Rhi + c * RP + k0), blo = *(const dn_bf16x8*)(Rlo + c * RP + k0);
            acc = dn_mfma(ahi.v, bhi, acc); acc = dn_mfma(ahi.v, blo, acc); acc = dn_mfma(alo.v, bhi, acc);
        }
#pragma unroll
        for (int r = 0; r < 4; ++r) lgs[(w * 16 + 4 * g4 + r) * 16 + c] = acc[r];
        asm volatile("s_waitcnt lgkmcnt(0)" ::: "memory");
        if (lane < 16) {
            const int kt = lane; float lgv[16];
#pragma unroll
            for (int q = 0; q < 4; ++q) { const float4 v = *(const float4*)(lgs + (w * 16 + kt) * 16 + 4 * q); lgv[4 * q] = v.x; lgv[4 * q + 1] = v.y; lgv[4 * q + 2] = v.z; lgv[4 * q + 3] = v.w; }
            float mx = lgv[0];
#pragma unroll
            for (int e = 1; e < 16; ++e) mx = fmaxf(mx, lgv[e]);
            float pr[16]; float den = 0.f;
#pragma unroll
            for (int e = 0; e < 16; ++e) { pr[e] = __expf(lgv[e] - mx); den += pr[e]; }
            const float inv = 1.f / den;
            float sel[16];
#pragma unroll
            for (int e = 0; e < 16; ++e) { pr[e] *= inv; sel[e] = pr[e] + p.router_b[e]; }
            int bg = 0; float bgs = -1e30f;
#pragma unroll
            for (int gi = 0; gi < 4; ++gi) { float m1 = -1e30f, m2 = -1e30f;
#pragma unroll
                for (int q = 0; q < 4; ++q) { const float sv2 = sel[gi * 4 + q]; if (sv2 > m1) { m2 = m1; m1 = sv2; } else if (sv2 > m2) m2 = sv2; }
                const float gs = m1 + m2; if (gs > bgs) { bgs = gs; bg = gi; } }
            int e1 = 0, e2 = 0; float s1 = -1e30f, s2 = -1e30f, p1 = 0.f, p2 = 0.f;
#pragma unroll
            for (int gi = 0; gi < 4; ++gi) if (gi == bg) {
#pragma unroll
                for (int q = 0; q < 4; ++q) { const float sv2 = sel[gi * 4 + q], pv = pr[gi * 4 + q];
                    if (sv2 > s1) { s2 = s1; e2 = e1; p2 = p1; s1 = sv2; e1 = gi * 4 + q; p1 = pv; } else if (sv2 > s2) { s2 = sv2; e2 = gi * 4 + q; p2 = pv; } } }
            const float wn = 1.f / (p1 + p2);
            selE[w * 16 + kt] = e1 | (e2 << 8); selW[2 * (w * 16 + kt)] = p1 * wn; selW[2 * (w * 16 + kt) + 1] = p2 * wn;
        }
        __syncthreads();
        int myE = 0, myR = 0;
        if (tix_ < 256) { const int ee = selE[tix_ >> 1]; myE = (tix_ & 1) ? (ee >> 8) : (ee & 255); myR = atomicAdd(&lcnt[myE], 1); }
        __syncthreads();
        if (tix_ < 16) lbase[tix_] = atomicAdd(&p.cnt[tix_], lcnt[tix_]);
        __syncthreads();
        if (tix_ < 256) { const int pair = chunk * 256 + tix_; p.list[myE * T_ + lbase[myE] + myR] = pair; p.gw[pair] = selW[tix_]; }
    }
    __syncthreads();
}

__device__ __forceinline__ void ph_lru(const int WV, CParams& p, const bf16_t* __restrict__ proj2, bf16_t* __restrict__ omix, unsigned char* smem) {
    const int tid = otid(WV), lane = tid & 63, w = tid >> 6, c = lane & 15, g4 = lane >> 4;
    bf16_t* xcs = (bf16_t*)smem;
    float* AB = (float*)(smem + 34816);
    constexpr int ABSZ = 2 * 128 * 33;
    float* segA = AB + 2 * ABSZ;
    float* segB = segA + 512;
    float* cin = segB + 512;
    for (int item = blockIdx.x; item < 256; item += gridDim.x) {
        const int b = item >> 4, hb = (item >> 2) & 3, q = item & 3;
        dn_bf16x8 wrf[2][4], wif[2][4];
#pragma unroll
        for (int nb = 0; nb < 2; ++nb)
#pragma unroll
            for (int ks = 0; ks < 4; ++ks) { const size_t o = ((size_t)hb * 128 + q * 32 + 16 * nb + c) * 128 + 32 * ks + 8 * g4;
                wrf[nb][ks] = *(const dn_bf16x8*)(p.W_lr + o); wif[nb][ks] = *(const dn_bf16x8*)(p.W_li + o); }
        float brj[2], bij[2], spn[2];
#pragma unroll
        for (int nb = 0; nb < 2; ++nb) { const int ch = hb * 128 + q * 32 + 16 * nb + c; brj[nb] = p.od_br[ch]; bij[nb] = p.od_bi[ch]; spn[nb] = -8.f * softplusf_(-p.od_lam[ch]); }
        const int cp = tid & 63, rg = tid >> 6, cch = hb * 128 + cp * 2;
        const float wa0 = p.od_conv_w[cch], wa1 = p.od_conv_w[512 + cch], wa2 = p.od_conv_w[1024 + cch], wa3 = p.od_conv_w[1536 + cch], ba = p.od_conv_b[cch];
        const float wb0 = p.od_conv_w[cch + 1], wb1 = p.od_conv_w[512 + cch + 1], wb2 = p.od_conv_w[1024 + cch + 1], wb3 = p.od_conv_w[1536 + cch + 1], bb2 = p.od_conv_b[cch + 1];
        float h_in = 0.f;
        unsigned raw[19];
        { const bf16_t* src = proj2 + (size_t)(b * S_ + rg * 16) * 2048 + cch;
#pragma unroll
          for (int r = 0; r < 19; ++r) raw[r] = (rg == 0 && r < 3) ? 0u : *(const unsigned*)(src + (ptrdiff_t)(r - 3) * 2048); }
        const int j = tid & 31, seg = tid >> 5, cg = hb * 128 + q * 32 + j;
        auto conv = [&](const int ti) __attribute__((always_inline)) {
            float a0 = __uint_as_float(raw[0] << 16), b0 = __uint_as_float(raw[0] & 0xffff0000u), a1 = __uint_as_float(raw[1] << 16), b1 = __uint_as_float(raw[1] & 0xffff0000u), a2 = __uint_as_float(raw[2] << 16), b2 = __uint_as_float(raw[2] & 0xffff0000u);
            if (ti == 0 && rg == 0) { a0 = a1 = a2 = b0 = b1 = b2 = 0.f; }
#pragma unroll
            for (int r = 0; r < 16; ++r) { const unsigned pv = raw[3 + r];
                const float a3 = __uint_as_float(pv << 16), b3 = __uint_as_float(pv & 0xffff0000u);
                *(unsigned*)(xcs + (rg * 16 + r) * 136 + cp * 2) = pk_bf16(ba + wa0 * a0 + wa1 * a1 + wa2 * a2 + wa3 * a3, bb2 + wb0 * b0 + wb1 * b1 + wb2 * b2 + wb3 * b3);
                a0 = a1; a1 = a2; a2 = a3; b0 = b1; b1 = b2; b2 = b3; }
            if (ti + 1 < 16) { const bf16_t* src = proj2 + (size_t)(b * S_ + (ti + 1) * 128 + rg * 16) * 2048 + cch;
#pragma unroll
                for (int r = 0; r < 19; ++r) raw[r] = *(const unsigned*)(src + (ptrdiff_t)(r - 3) * 2048); }
        };
        auto gates = [&](float* As, float* Bs) __attribute__((always_inline)) {
            dn_bf16x8 af[4];
#pragma unroll
            for (int ks = 0; ks < 4; ++ks) af[ks] = *(const dn_bf16x8*)(xcs + (16 * w + c) * 136 + 32 * ks + 8 * g4);
#pragma unroll
            for (int nb = 0; nb < 2; ++nb) { dn_f32x4 ar = {0.f, 0.f, 0.f, 0.f}, ai = {0.f, 0.f, 0.f, 0.f};
#pragma unroll
                for (int ks = 0; ks < 4; ++ks) { ar = dn_mfma(af[ks], wrf[nb][ks], ar); ai = dn_mfma(af[ks], wif[nb][ks], ai); }
#pragma unroll
                for (int r = 0; r < 4; ++r) { const int t = 16 * w + 4 * g4 + r, jl = 16 * nb + c;
                    const float rr = sigm(ar[r] + brj[nb]), ig = sigm(ai[r] + bij[nb]);
                    const float log_a = spn[nb] * rr, av = __expf(log_a), x = bf2f(xcs[t * 136 + q * 32 + jl]);
                    As[t * 33 + jl] = av; Bs[t * 33 + jl] = sqrtf(fmaxf(0.f, (1.f - av) * (1.f + av))) * ig * x; } }
        };
        conv(0);
        __syncthreads();
        gates(AB, AB + 128 * 33);
        __syncthreads();
        for (int ti = 0; ti < 16; ++ti) {
            const int t0 = b * S_ + ti * 128;
            float* As = AB + (ti & 1) * ABSZ; float* Bs = As + 128 * 33;
            float* An = AB + ((ti + 1) & 1) * ABSZ; float* Bn = An + 128 * 33;
            { float A = 1.f, Bc = 0.f;
#pragma unroll
                for (int k = 0; k < 8; ++k) { const float av = As[(8 * seg + k) * 33 + j], bv = Bs[(8 * seg + k) * 33 + j]; A = av * A; Bc = av * Bc + bv; }
                segA[seg * 32 + j] = A; segB[seg * 32 + j] = Bc; }
            if (ti + 1 < 16) conv(ti + 1);
            __syncthreads();
            unsigned short gz[8];
#pragma unroll
            for (int k = 0; k < 8; ++k) gz[k] = *(const unsigned short*)(proj2 + (size_t)(t0 + 8 * seg + k) * 2048 + 512 + cg);
            if (tid < 32) { float sa[16], sb[16];
#pragma unroll
                for (int sg = 0; sg < 16; ++sg) { sa[sg] = segA[sg * 32 + tid]; sb[sg] = segB[sg * 32 + tid]; }
                float h = h_in;
#pragma unroll
                for (int sg = 0; sg < 16; ++sg) { cin[sg * 32 + tid] = h; h = sa[sg] * h + sb[sg]; }
                h_in = h; }
            if (ti + 1 < 16) gates(An, Bn);
            __syncthreads();
            { float h = cin[seg * 32 + j];
#pragma unroll
                for (int k = 0; k < 8; ++k) { const int t = 8 * seg + k; h = As[t * 33 + j] * h + Bs[t * 33 + j];
                    omix[(size_t)(t0 + t) * 1024 + cg] = f2bf(h * __uint_as_float((unsigned)gz[k] << 16)); } }
        }
        __syncthreads();
    }
}
typedef unsigned short sg_u16x4 __attribute__((ext_vector_type(4)));
__device__ __forceinline__ unsigned sgu_off(unsigned row, unsigned ch) { return 256u * row + 16u * (ch ^ (((row & 3u) << 2) | ((row >> 2) & 3u))); }
__device__ __forceinline__ void ph_sgu(const int WV, CParams& p, const bf16_t* __restrict__ proj2, bf16_t* __restrict__ omix, unsigned char* smem) {
    const int tid = otid(WV), lane = tid & 63, w = tid >> 6, c = lane & 15, g4 = lane >> 4;
    float* rstd = (float*)(smem + 32768);
    const unsigned ldsb = (unsigned)(size_t)(PG8_LAS unsigned char*)smem;
    const unsigned q4 = (unsigned)(lane & 15) >> 2, p4 = (unsigned)lane & 3u;
    for (int item = blockIdx.x; item < 256; item += gridDim.x) {
        const int t0 = item * 128;
        __syncthreads();
#pragma unroll 4
        for (int rr = 0; rr < 16; ++rr) { const int sI = 16 * w + rr; const uint4 v = *(const uint4*)(proj2 + (size_t)(t0 + sI) * 2048 + 1536 + lane * 8);
            const unsigned u[4] = {v.x, v.y, v.z, v.w}; float ss = 0.f;
#pragma unroll
            for (int k = 0; k < 4; ++k) { const float x0 = __uint_as_float(u[k] << 16), x1 = __uint_as_float(u[k] & 0xffff0000u); ss += x0 * x0 + x1 * x1; }
            ss = wave_sum(ss);
            if (lane == 0) rstd[sI] = rsqrtf(ss * (1.f / 512.f) + 1e-6f); }
        __syncthreads();
        for (int g = 0; g < 4; ++g) {
#pragma unroll
            for (int i = 0; i < 4; ++i) { const int id = tid + i * NT, sI = id >> 4, c16 = id & 15;
                const uint4 v = *(const uint4*)(proj2 + (size_t)(t0 + sI) * 2048 + 1536 + g * 128 + c16 * 8);
                const float rs = rstd[sI]; const float4 g0 = *(const float4*)(p.od_sgu_g + g * 128 + c16 * 8), g1 = *(const float4*)(p.od_sgu_g + g * 128 + c16 * 8 + 4);
                uint4 o;
                o.x = pk_bf16(__uint_as_float(v.x << 16) * rs * g0.x, __uint_as_float(v.x & 0xffff0000u) * rs * g0.y); o.y = pk_bf16(__uint_as_float(v.y << 16) * rs * g0.z, __uint_as_float(v.y & 0xffff0000u) * rs * g0.w);
                o.z = pk_bf16(__uint_as_float(v.z << 16) * rs * g1.x, __uint_as_float(v.z & 0xffff0000u) * rs * g1.y); o.w = pk_bf16(__uint_as_float(v.w << 16) * rs * g1.z, __uint_as_float(v.w & 0xffff0000u) * rs * g1.w);
                *(uint4*)(smem + sgu_off((unsigned)sI, (unsigned)c16)) = o; }
            __syncthreads();
            {
                const int nks = (16 * w + 15) / 32 + 1, t = 16 * w + c;
                dn_bf16x8 wf[4];
#pragma unroll
                for (int ks = 0; ks < 4; ++ks) wf[ks] = *(const dn_bf16x8*)(p.W_sgu + ((size_t)(g * 128 + t)) * 128 + 32 * ks + 8 * g4);
                const float bias = p.od_sgu_b[g * 128 + t];
                uint2 uq[8];
#pragma unroll
                for (int db = 0; db < 8; ++db) uq[db] = *(const uint2*)(proj2 + (size_t)(t0 + t) * 2048 + 1024 + g * 128 + 16 * db + 4 * g4);
#pragma unroll
                for (int db = 0; db < 8; ++db) {
                    union { dn_bf16x8 v; sg_u16x4 h[2]; } va[4];
                    {
                        unsigned ad[8];
#pragma unroll
                        for (int ks = 0; ks < 4; ++ks)
#pragma unroll
                            for (int tt = 0; tt < 2; ++tt) ad[2 * ks + tt] = ldsb + sgu_off(32u * ks + 8u * (unsigned)g4 + 4u * tt + q4, 2u * db + (p4 >> 1)) + 8u * (p4 & 1u);
                        asm volatile("ds_read_b64_tr_b16 %0, %8\n\tds_read_b64_tr_b16 %1, %9\n\tds_read_b64_tr_b16 %2, %10\n\tds_read_b64_tr_b16 %3, %11\n\t"
                                     "ds_read_b64_tr_b16 %4, %12\n\tds_read_b64_tr_b16 %5, %13\n\tds_read_b64_tr_b16 %6, %14\n\tds_read_b64_tr_b16 %7, %15\n\ts_waitcnt lgkmcnt(0)"
                                     : "=&v"(va[0].h[0]), "=&v"(va[0].h[1]), "=&v"(va[1].h[0]), "=&v"(va[1].h[1]), "=&v"(va[2].h[0]), "=&v"(va[2].h[1]), "=&v"(va[3].h[0]), "=&v"(va[3].h[1])
                                     : "v"(ad[0]), "v"(ad[1]), "v"(ad[2]), "v"(ad[3]), "v"(ad[4]), "v"(ad[5]), "v"(ad[6]), "v"(ad[7]) : "memory");
                    }
                    dn_f32x4 acc = {0.f, 0.f, 0.f, 0.f};
#pragma unroll
                    for (int ks = 0; ks < 4; ++ks) if (ks < nks) acc = dn_mfma(va[ks].v, wf[ks], acc);
                    const size_t go = (size_t)(t0 + t);
                    const uint2 uu = uq[db];
                    uint2 o; o.x = pk_bf16(__uint_as_float(uu.x << 16) * (acc[0] + bias), __uint_as_float(uu.x & 0xffff0000u) * (acc[1] + bias));
                    o.y = pk_bf16(__uint_as_float(uu.y << 16) * (acc[2] + bias), __uint_as_float(uu.y & 0xffff0000u) * (acc[3] + bias));
                    *(uint2*)(omix + go * 1024 + 512 + g * 128 + 16 * db + 4 * g4) = o; }
            }
            __syncthreads();
        }
    }
}

namespace pg8 {
typedef short bf16x8 __attribute__((ext_vector_type(8)));
typedef float f32x4 __attribute__((ext_vector_type(4)));
typedef unsigned u32x4 __attribute__((ext_vector_type(4)));
typedef unsigned u32x2 __attribute__((ext_vector_type(2)));
constexpr int BM = 256, BK = 64, HALF = 128, HTB = HALF * BK * 2, STAGE_BYTES = 8 * HTB, NXCD = 8, WGM = 8;
__device__ __forceinline__ int lds_byte(int r, int c) { const int st = (r >> 4) * 2 + (c >> 5), rr = r & 15, cc = c & 31, ob = rr * 64 + cc * 2; return st * 1024 + (ob ^ (((ob >> 9) & 1) << 5)); }
__device__ __forceinline__ void stage_rc(int b, int& R, int& C) { const int st = b / 1024, sb = b % 1024, swz = sb ^ (((sb >> 9) & 1) << 5); R = (st >> 1) * 16 + swz / 64; C = (st & 1) * 32 + (swz % 64) / 2; }
__device__ __forceinline__ int perm32(int rho) { const int n = rho >> 4, i = rho & 15; return 8 * (i >> 2) + 4 * n + (i & 3); }
struct Unit { int pm, pn, e, nvalid, gt; };
struct Gemm { const bf16_t* A; const bf16_t* Bt; size_t wstride; int K; int pad_; };

struct StaticOrder {
    static constexpr bool GATHER = false; static constexpr int SHIFT = 0, SIG = 0;
    int nM, nN, nwg, G, c;
    __device__ __forceinline__ int rowid(const Unit&, int) const { return 0; }
    __device__ void init(int M, int N, int G_, int c_) { nM = M / BM; nN = N / BM; nwg = nM * nN; G = G_; c = c_; }
    __device__ bool next(int i, Unit& u) const {
        const long L = (long)i * G + c; if (L >= nwg) return false;
        int wgid = (int)L; { const int q = nwg / NXCD, r = nwg % NXCD, xcd = wgid % NXCD, off = wgid / NXCD; wgid = (xcd < r ? xcd * (q + 1) : r * (q + 1) + (xcd - r) * q) + off; }
        const int nig = WGM * nN, gid = wgid / nig, fm = gid * WGM, gsz = (nM - fm) < WGM ? (nM - fm) : WGM;
        u.pm = fm + ((wgid % nig) % gsz); u.pn = (wgid % nig) / gsz; u.e = 0; u.nvalid = 256; u.gt = 0; return true;
    }
};
template <int NN, int SHIFT_, int SIG_>
struct MoeOrder {
    static constexpr bool GATHER = true; static constexpr int SHIFT = SHIFT_, SIG = SIG_;
    const int* cnt; const int* list; int G, c; int cntv;
    int* flag; int rounds, extra;
    __device__ __forceinline__ int rowid(const Unit& u, int r) const { return list[u.e * T_ + u.pm * 256 + min(r, u.nvalid - 1)]; }
    __device__ bool next(int i, Unit& u) const {
        int L;
        if constexpr (SIG == 1) { if (i >= rounds) return false; L = i * G + c; }
        else if constexpr (SIG == 3) { if (i > 0 || c >= extra) return false; L = rounds * G + c; }
        else if constexpr (SIG == 2) { constexpr int SK = 3; const int iv = (c < extra) ? i + SK : i; L = iv * G + c - (iv < SK ? iv * extra + min(c, extra) : SK * extra); }
        else L = i * G + c;
        int rt = L / NN; u.pn = L % NN; u.gt = rt;
        int e = 0, cc = 0;
        for (; e < 16; ++e) { cc = __builtin_amdgcn_readlane(cntv, e); const int ntile = (cc + 255) >> 8; if (rt < ntile) break; rt -= ntile; }
        if (e == 16) return false;
        u.e = e; u.pm = rt; u.nvalid = min(256, cc - rt * 256);
        if constexpr (SIG == 2) {
            const int need = (2 * u.gt >= rounds * G ? 1 : 0) + (2 * u.gt + 1 >= rounds * G ? 1 : 0);
            if (need > 0) { while (__hip_atomic_load(flag + u.gt, __ATOMIC_RELAXED, __HIP_MEMORY_SCOPE_AGENT) < need) __builtin_amdgcn_s_sleep(2); __builtin_amdgcn_fence(__ATOMIC_ACQUIRE, "agent"); }
        }
        return true;
    }
};
__device__ __forceinline__ unsigned cvt_pk_bf16(float lo, float hi) { return pk_bf16(lo, hi); }

template <int KC, class Epi, class Sched>
__device__ __forceinline__ void gemm_phase(const int WV, PG8_LAS unsigned char* lds, const Gemm g, const Sched& S, const Epi& E) {
    const int tid = otid(WV), wid = __builtin_amdgcn_readfirstlane(tid >> 6), lane = tid & 63, wr = wid >> 2, wc = wid & 3, fr = lane & 15, fq = lane >> 4;
    constexpr int K = KC, nt = K / BK;
    unsigned voffB[2];
#pragma unroll
    for (int i = 0; i < 2; ++i) { int R, C; stage_rc(tid * 16 + i * 8192, R, C); const int Rb = Epi::PERM ? ((R & ~31) + perm32(R & 31)) : R; voffB[i] = (unsigned)(Rb * K + C) * 2u; }
    constexpr unsigned kstep = BK * 2, hstep = HALF * K * 2, tstep = 2 * hstep;
    const __amdgpu_buffer_rsrc_t rsA = __builtin_amdgcn_make_buffer_rsrc((void*)g.A, 0, 0x7fffffff, 0x00020000);
    const __amdgpu_buffer_rsrc_t rsB = __builtin_amdgcn_make_buffer_rsrc((void*)g.Bt, 0, 0x7fffffff, 0x00020000);
    const unsigned ldsw = (unsigned)wid * 1024u;
    const int aoff = lds_byte(wr * 64 + fr, fq * 8), boff = lds_byte(wc * 32 + fr, fq * 8);
#define PG8_SA(b, h) (((b) * 2 + (h)) * HTB)
#define PG8_SB(b, h) ((4 + (b) * 2 + (h)) * HTB)
#define PG8_STAGE(bufoff, rsrc, soff, voff) do { _Pragma("unroll") for (int _i = 0; _i < 2; ++_i) \
        __builtin_amdgcn_raw_ptr_buffer_load_lds(rsrc, (PG8_LAS unsigned*)(lds + (bufoff) + ldsw + _i * 8192), 16, (voff)[_i], (soff), 0, 0); } while (0)
#define PG8_LDA(dst, b, h) do { _Pragma("unroll") for (int m = 0; m < 4; ++m) _Pragma("unroll") for (int k = 0; k < 2; ++k) dst[m][k] = *(const PG8_LAS bf16x8*)(lds + PG8_SA(b, h) + aoff + m * 2048 + k * 1024); } while (0)
#define PG8_LDB(dst, b, h) do { _Pragma("unroll") for (int n = 0; n < 2; ++n) _Pragma("unroll") for (int k = 0; k < 2; ++k) dst[n][k] = *(const PG8_LAS bf16x8*)(lds + PG8_SB(b, h) + boff + n * 2048 + k * 1024); } while (0)
#define PG8_MMA(ai, bj, At, Bt) do { __builtin_amdgcn_s_setprio(1); _Pragma("unroll") for (int m = 0; m < 4; ++m) _Pragma("unroll") for (int n = 0; n < 2; ++n) _Pragma("unroll") for (int k = 0; k < 2; ++k) \
        acc[ai][bj][m][n] = __builtin_amdgcn_mfma_f32_16x16x32_bf16(Bt[n][k], At[m][k], acc[ai][bj][m][n], 0, 0, 0); __builtin_amdgcn_s_setprio(0); } while (0)
#define PG8_WAIT_V(n) asm volatile("s_waitcnt vmcnt(" #n ")" ::: "memory")
#define PG8_WAIT_L(n) asm volatile("s_waitcnt lgkmcnt(" #n ")" ::: "memory")
#define PG8_BAR __builtin_amdgcn_s_barrier()
#define PG8_SCHED __builtin_amdgcn_sched_barrier(0)
    Unit cur, nxt; int ui = 0;
    if (!S.next(0, cur)) return;
    f32x4 acc[2][2][4][2];
#pragma unroll
    for (int a = 0; a < 2; ++a)
#pragma unroll
        for (int b = 0; b < 2; ++b)
#pragma unroll
            for (int m = 0; m < 4; ++m)
#pragma unroll
                for (int n = 0; n < 2; ++n) acc[a][b][m][n] = (f32x4){0.f, 0.f, 0.f, 0.f};
    bf16x8 At[4][2], B0[2][2], B1[2][2];
    unsigned vA0[2], vA1[2];
    PG8_LAS int* rows = (PG8_LAS int*)(lds + STAGE_BYTES);
    if constexpr (Sched::GATHER) { if (tid < 256) rows[tid] = S.rowid(cur, tid); __syncthreads(); }
#pragma unroll
    for (int i = 0; i < 2; ++i) { int R, C; stage_rc(tid * 16 + i * 8192, R, C);
        const int r0 = Sched::GATHER ? (rows[R] >> Sched::SHIFT) : cur.pm * BM + R, r1 = Sched::GATHER ? (rows[HALF + R] >> Sched::SHIFT) : cur.pm * BM + HALF + R;
        vA0[i] = ((unsigned)r0 * (unsigned)K + (unsigned)C) * 2u; vA1[i] = ((unsigned)r1 * (unsigned)K + (unsigned)C) * 2u; }
    unsigned cB = (unsigned)cur.e * (unsigned)(g.wstride * 2) + (unsigned)cur.pn * tstep;
    PG8_STAGE(PG8_SB(0, 0), rsB, cB, voffB); PG8_STAGE(PG8_SA(0, 0), rsA, 0u, vA0); PG8_STAGE(PG8_SB(0, 1), rsB, cB + hstep, voffB); PG8_STAGE(PG8_SA(0, 1), rsA, 0u, vA1);
    if (wr == 1) PG8_BAR;
    PG8_WAIT_V(4); PG8_BAR;
    PG8_STAGE(PG8_SB(1, 0), rsB, cB + kstep, voffB); PG8_STAGE(PG8_SA(1, 0), rsA, kstep, vA0); PG8_STAGE(PG8_SB(1, 1), rsB, cB + hstep + kstep, voffB);
    PG8_WAIT_V(6); PG8_BAR;
    for (;;) {
        const bool has_next = S.next(ui + 1, nxt);
        if constexpr (Sched::GATHER) { if (has_next) { const int t3 = otid(WV); if (t3 < 256) rows[((ui + 1) % 3) * 256 + t3] = S.rowid(nxt, t3); } }
        const unsigned nB = has_next ? (unsigned)nxt.e * (unsigned)(g.wstride * 2) + (unsigned)nxt.pn * tstep : cB;
        for (int t = 0; t < nt; t += 2) {
            const bool last = (t == nt - 2);
            const unsigned a1 = (unsigned)(t + 1) * kstep;
            const unsigned a2 = last ? 0u : (unsigned)(t + 2) * kstep, b2 = last ? nB : cB + (unsigned)(t + 2) * kstep;
            const unsigned a3 = a2 + kstep, b3 = b2 + kstep;
            PG8_LDB(B0, 0, 0); PG8_SCHED; PG8_LDA(At, 0, 0); PG8_STAGE(PG8_SA(1, 1), rsA, a1, vA1);
            if (last && has_next) {
                const int t3 = otid(WV); PG8_LAS const int* rn = rows + ((ui + 1) % 3) * 256;
#pragma unroll
                for (int i = 0; i < 2; ++i) { int R, C; stage_rc(t3 * 16 + i * 8192, R, C);
                    const int r0 = Sched::GATHER ? (rn[R] >> Sched::SHIFT) : nxt.pm * BM + R, r1 = Sched::GATHER ? (rn[HALF + R] >> Sched::SHIFT) : nxt.pm * BM + HALF + R;
                    vA0[i] = ((unsigned)r0 * (unsigned)K + (unsigned)C) * 2u; vA1[i] = ((unsigned)r1 * (unsigned)K + (unsigned)C) * 2u; }
            }
            PG8_WAIT_L(8); PG8_BAR; PG8_WAIT_L(0); PG8_MMA(0, 0, At, B0); PG8_BAR; PG8_SCHED;
            PG8_LDB(B1, 0, 1); PG8_STAGE(PG8_SB(0, 0), rsB, b2, voffB);
            PG8_BAR; PG8_WAIT_L(0); PG8_MMA(0, 1, At, B1); PG8_BAR;
            PG8_LDA(At, 0, 1); PG8_STAGE(PG8_SA(0, 0), rsA, a2, vA0);
            PG8_BAR; PG8_WAIT_L(0); PG8_MMA(1, 0, At, B0); PG8_BAR; PG8_SCHED;
            PG8_STAGE(PG8_SB(0, 1), rsB, b2 + hstep, voffB);
            PG8_WAIT_V(6); PG8_BAR; PG8_MMA(1, 1, At, B1); PG8_BAR;
            PG8_LDB(B0, 1, 0); PG8_SCHED; PG8_LDA(At, 1, 0); PG8_STAGE(PG8_SA(0, 1), rsA, a2, vA1);
            PG8_WAIT_L(8); PG8_BAR; PG8_WAIT_L(0); PG8_MMA(0, 0, At, B0); PG8_BAR; PG8_SCHED;
            PG8_LDB(B1, 1, 1); PG8_STAGE(PG8_SB(1, 0), rsB, b3, voffB);
            PG8_BAR; PG8_WAIT_L(0); PG8_MMA(0, 1, At, B1); PG8_BAR;
            PG8_LDA(At, 1, 1); PG8_STAGE(PG8_SA(1, 0), rsA, a3, vA0);
            PG8_BAR; PG8_WAIT_L(0); PG8_MMA(1, 0, At, B0); PG8_BAR; PG8_SCHED;
            PG8_STAGE(PG8_SB(1, 1), rsB, b3 + hstep, voffB);
            PG8_WAIT_V(6); PG8_BAR; PG8_MMA(1, 1, At, B1); PG8_BAR;
        }
        { const int t2 = otid(WV), w2 = __builtin_amdgcn_readfirstlane(t2 >> 6), l2 = t2 & 63; E(acc, cur, w2 >> 2, w2 & 3, l2 & 15, l2 >> 4, rows + (ui % 3) * 256); }
        if constexpr (Sched::SIG == 3) {
            PG8_WAIT_V(0); PG8_BAR; PG8_BAR;
            if (otid(WV) == 0) { __builtin_amdgcn_fence(__ATOMIC_RELEASE, "agent"); (void)__hip_atomic_fetch_add(S.flag + cur.gt, 1, __ATOMIC_RELAXED, __HIP_MEMORY_SCOPE_AGENT); }
        }
        if (!has_next) break;
#pragma unroll
        for (int a = 0; a < 2; ++a)
#pragma unroll
            for (int b = 0; b < 2; ++b)
#pragma unroll
                for (int m = 0; m < 4; ++m)
#pragma unroll
                    for (int n = 0; n < 2; ++n) acc[a][b][m][n] = (f32x4){0.f, 0.f, 0.f, 0.f};
        cur = nxt; cB = nB; ++ui;
    }
    PG8_WAIT_V(0);
    if (wr == 0) PG8_BAR;
    PG8_BAR;
#undef PG8_SA
#undef PG8_SB
#undef PG8_STAGE
#undef PG8_LDA
#undef PG8_LDB
#undef PG8_MMA
#undef PG8_WAIT_V
#undef PG8_WAIT_L
#undef PG8_BAR
#undef PG8_SCHED
}

struct EpiBf16 {
    static constexpr bool PERM = true;
    bf16_t* O; int ldo, gelu_from;
    __device__ __forceinline__ void operator()(const f32x4 (&acc)[2][2][4][2], const Unit& u, int wr, int wc, int fr, int fq, PG8_LAS const int* rows) const {
        const int row0 = u.pm * BM + wr * 64 + fr, col0 = u.pn * BM + wc * 32 + 8 * fq; const bool gl = u.pn >= gelu_from;
#pragma unroll
        for (int ai = 0; ai < 2; ++ai)
#pragma unroll
            for (int m = 0; m < 4; ++m) { bf16_t* rowp = O + (size_t)(row0 + ai * HALF + m * 16) * ldo + col0;
#pragma unroll
                for (int bj = 0; bj < 2; ++bj) { f32x4 v0 = acc[ai][bj][m][0], v1 = acc[ai][bj][m][1];
                    if (gl) {
#pragma unroll
                        for (int j = 0; j < 4; ++j) { v0[j] = geluf_(v0[j]); v1[j] = geluf_(v1[j]); } }
                    u32x4 w; w.x = cvt_pk_bf16(v0[0], v0[1]); w.y = cvt_pk_bf16(v0[2], v0[3]); w.z = cvt_pk_bf16(v1[0], v1[1]); w.w = cvt_pk_bf16(v1[2], v1[3]);
                    *(u32x4*)(rowp + bj * HALF) = w; } }
    }
};
struct EpiRes {
    static constexpr bool PERM = false;
    const float* xin; float* xout; const float* gt;
    __device__ __forceinline__ void operator()(const f32x4 (&acc)[2][2][4][2], const Unit& u, int wr, int wc, int fr, int fq, PG8_LAS const int* rows) const {
        const int row0 = u.pm * BM + wr * 64 + fr, col0 = u.pn * BM + wc * 32 + 4 * fq;
#pragma unroll
        for (int ai = 0; ai < 2; ++ai)
#pragma unroll
            for (int m = 0; m < 4; ++m) { const int r = row0 + ai * HALF + m * 16; const float* gp = gt + (r >> 11) * 6144 + col0; const size_t off = (size_t)r * 1024 + col0;
#pragma unroll
                for (int bj = 0; bj < 2; ++bj)
#pragma unroll
                    for (int n = 0; n < 2; ++n) { const int cc = bj * HALF + n * 16; const f32x4 xv = *(const f32x4*)(xin + off + cc); const f32x4 gv = *(const f32x4*)(gp + cc);
                        *(f32x4*)(xout + off + cc) = xv + gv * acc[ai][bj][m][n]; }
                if (m & 1) asm volatile("" ::: "memory"); }
    }
};
template <bool XIN16>
struct EpiRes16 {
    static constexpr bool PERM = true;
    const void* xin; bf16_t* xout; const float* gt;
    __device__ __forceinline__ void operator()(const f32x4 (&acc)[2][2][4][2], const Unit& u, int wr, int wc, int fr, int fq, PG8_LAS const int* rows) const {
        const int row0 = u.pm * BM + wr * 64 + fr, col0 = u.pn * BM + wc * 32 + 8 * fq;
        const float* gp = gt + (row0 >> 11) * 6144 + col0;
        f32x4 gv[2][2];
#pragma unroll
        for (int bj = 0; bj < 2; ++bj) { gv[bj][0] = *(const f32x4*)(gp + bj * HALF); gv[bj][1] = *(const f32x4*)(gp + bj * HALF + 4); }
        u32x4 xb[2][2]; f32x4 xf[2][2][2];
#define ER_LOAD(it_) do { const size_t off_ = (size_t)(row0 + ((it_) >> 2) * HALF + ((it_) & 3) * 16) * 1024 + col0; _Pragma("unroll") for (int bj = 0; bj < 2; ++bj) { \
            if (XIN16) xb[(it_) & 1][bj] = *(const u32x4*)((const bf16_t*)xin + off_ + bj * HALF); \
            else { xf[(it_) & 1][bj][0] = *(const f32x4*)((const float*)xin + off_ + bj * HALF); xf[(it_) & 1][bj][1] = *(const f32x4*)((const float*)xin + off_ + bj * HALF + 4); } } } while (0)
        ER_LOAD(0);
#pragma unroll
        for (int it = 0; it < 8; ++it) { const int ai = it >> 2, m = it & 3;
            if (it + 1 < 8) ER_LOAD(it + 1);
            const size_t off = (size_t)(row0 + ai * HALF + m * 16) * 1024 + col0;
#pragma unroll
            for (int bj = 0; bj < 2; ++bj) { const int cc = bj * HALF;
                f32x4 x0, x1;
                if (XIN16) { const u32x4 q = xb[it & 1][bj];
                    x0 = (f32x4){__uint_as_float(q.x << 16), __uint_as_float(q.x & 0xffff0000u), __uint_as_float(q.y << 16), __uint_as_float(q.y & 0xffff0000u)};
                    x1 = (f32x4){__uint_as_float(q.z << 16), __uint_as_float(q.z & 0xffff0000u), __uint_as_float(q.w << 16), __uint_as_float(q.w & 0xffff0000u)}; }
                else { x0 = xf[it & 1][bj][0]; x1 = xf[it & 1][bj][1]; }
                const f32x4 v0 = x0 + gv[bj][0] * acc[ai][bj][m][0], v1 = x1 + gv[bj][1] * acc[ai][bj][m][1];
                u32x4 w; w.x = cvt_pk_bf16(v0[0], v0[1]); w.y = cvt_pk_bf16(v0[2], v0[3]); w.z = cvt_pk_bf16(v1[0], v1[1]); w.w = cvt_pk_bf16(v1[2], v1[3]);
                *(u32x4*)(xout + off + cc) = w; }
            asm volatile("" ::: "memory"); }
#undef ER_LOAD
    }
};
struct EpiG1 {
    static constexpr bool PERM = true;
    bf16_t* act; const int* list; const float* gw;
    __device__ __forceinline__ void operator()(const f32x4 (&acc)[2][2][4][2], const Unit& u, int wr, int wc, int fr, int fq, PG8_LAS const int* rows) const {
        int pv[8]; float wv[8];
#pragma unroll
        for (int it = 0; it < 8; ++it) pv[it] = rows[(it >> 2) * HALF + wr * 64 + (it & 3) * 16 + fr];
#pragma unroll
        for (int it = 0; it < 8; ++it) wv[it] = gw[pv[it]];
#pragma unroll
        for (int it = 0; it < 8; ++it) { const int ai = it >> 2, m = it & 3; const int rr = ai * HALF + wr * 64 + m * 16 + fr;
                if (rr < u.nvalid) { const int p = pv[it]; const float w = wv[it];
#pragma unroll
                    for (int bj = 0; bj < 2; ++bj) { const int c = u.pn * BM + bj * HALF + wc * 32 + 8 * fq; const f32x4 v0 = acc[ai][bj][m][0], v1 = acc[ai][bj][m][1];
                        u32x2 o; o.x = cvt_pk_bf16(siluf(v0[0]) * v0[1] * w, siluf(v0[2]) * v0[3] * w); o.y = cvt_pk_bf16(siluf(v1[0]) * v1[1] * w, siluf(v1[2]) * v1[3] * w);
                        *(u32x2*)(act + (size_t)p * 256 + (c >> 1)) = o; } }
                asm volatile("" ::: "memory"); }
    }
};
struct EpiG2 {
    static constexpr bool PERM = true;
    bf16_t* y; const int* list;
    __device__ __forceinline__ void operator()(const f32x4 (&acc)[2][2][4][2], const Unit& u, int wr, int wc, int fr, int fq, PG8_LAS const int* rows) const {
#pragma unroll
        for (int ai = 0; ai < 2; ++ai)
#pragma unroll
            for (int m = 0; m < 4; ++m) { const int rr = ai * HALF + wr * 64 + m * 16 + fr;
                if (rr < u.nvalid) { const int p = rows[rr];
#pragma unroll
                    for (int bj = 0; bj < 2; ++bj) { const int c = u.pn * BM + bj * HALF + wc * 32 + 8 * fq; const f32x4 v0 = acc[ai][bj][m][0], v1 = acc[ai][bj][m][1];
                        u32x4 w; w.x = cvt_pk_bf16(v0[0], v0[1]); w.y = cvt_pk_bf16(v0[2], v0[3]); w.z = cvt_pk_bf16(v1[0], v1[1]); w.w = cvt_pk_bf16(v1[2], v1[3]);
                        *(u32x4*)(y + (size_t)p * 1024 + c) = w; } }
                asm volatile("" ::: "memory"); }
    }
};
}

__device__ __forceinline__ void run_gemm_dense_bf16(const int WV, PG8_LAS unsigned char* lds, const bf16_t* A, const bf16_t* Bt, int M, int N, int K, bf16_t* O, int ldo, int gelu_from) {
    pg8::Gemm g; g.A = A; g.Bt = Bt; g.wstride = 0; g.K = K; g.pad_ = 0;
    pg8::StaticOrder S; S.init(M, N, gridDim.x, blockIdx.x); pg8::EpiBf16 E{O, ldo, gelu_from}; pg8::gemm_phase<1024>(WV, lds, g, S, E);
}
template <bool XIN16>
__device__ __forceinline__ void run_gemm_dense_res(const int WV, PG8_LAS unsigned char* lds, const bf16_t* A, const bf16_t* Bt, int M, int N, int K, const void* xin, bf16_t* xout, const float* gt) {
    pg8::Gemm g; g.A = A; g.Bt = Bt; g.wstride = 0; g.K = K; g.pad_ = 0;
    pg8::StaticOrder S; S.init(M, N, gridDim.x, blockIdx.x); pg8::EpiRes16<XIN16> E{xin, xout, gt}; pg8::gemm_phase<1024>(WV, lds, g, S, E);
}
template <int SIG>
__device__ __forceinline__ void run_gemm_g1(const int WV, PG8_LAS unsigned char* lds, CParams& p, const bf16_t* A, const bf16_t* Bt, bf16_t* act) {
    pg8::Gemm g; g.A = A; g.Bt = Bt; g.wstride = (size_t)512 * 1024; g.K = 1024; g.pad_ = 0;
    const int l16 = otid(WV) & 63; const int cv = (l16 < 16) ? __hip_atomic_load(p.cnt + l16, __ATOMIC_RELAXED, __HIP_MEMORY_SCOPE_AGENT) : 0;
    int ntile = 0;
    for (int e = 0; e < 16; ++e) ntile += (__builtin_amdgcn_readlane(cv, e) + 255) >> 8;
    pg8::MoeOrder<2, 1, SIG> S{p.cnt, p.list, (int)gridDim.x, (int)blockIdx.x, cv, p.cnt + 64, (2 * ntile) / (int)gridDim.x, (2 * ntile) % (int)gridDim.x}; pg8::EpiG1 E{act, p.list, p.gw}; pg8::gemm_phase<1024>(WV, lds, g, S, E);
}
__device__ __forceinline__ void run_gemm_g2(const int WV, PG8_LAS unsigned char* lds, CParams& p, const bf16_t* A, const bf16_t* Bt, bf16_t* y) {
    pg8::Gemm g; g.A = A; g.Bt = Bt; g.wstride = (size_t)1024 * 256; g.K = 256; g.pad_ = 0;
    const int l16 = otid(WV) & 63; const int cv = (l16 < 16) ? __hip_atomic_load(p.cnt + l16, __ATOMIC_RELAXED, __HIP_MEMORY_SCOPE_AGENT) : 0;
    int ntile = 0;
    for (int e = 0; e < 16; ++e) ntile += (__builtin_amdgcn_readlane(cv, e) + 255) >> 8;
    pg8::MoeOrder<4, 0, 2> S{p.cnt, p.list, (int)gridDim.x, (int)blockIdx.x, cv, p.cnt + 64, (2 * ntile) / (int)gridDim.x, (2 * ntile) % (int)gridDim.x}; pg8::EpiG2 E{y, p.list}; pg8::gemm_phase<256>(WV, lds, g, S, E);
}

__device__ __forceinline__ CParams* kparams() { CParams* q = (CParams*)__builtin_amdgcn_kernarg_segment_ptr(); asm volatile("" : "+s"(q)); return q; }
#define KP (*kparams())

#define XB_TMO      128
#define XB_XCNT(j)  (256  + 64 * (j))
#define XB_XSUB(j)  (1280 + 64 * (j))
#define XB_XGEN(j)  (2304 + 64 * (j))
#define XB_TOP      3328
#define XB_TOPGEN   3392
#define XCD_BAR_WORDS 3456
#define XB_SPIN_CAP (1u << 22)
__device__ __forceinline__ unsigned xb_ld(unsigned* p)              { return __hip_atomic_load(p, __ATOMIC_RELAXED, __HIP_MEMORY_SCOPE_AGENT); }
__device__ __forceinline__ unsigned xb_add(unsigned* p, unsigned v) { return __hip_atomic_fetch_add(p, v, __ATOMIC_RELAXED, __HIP_MEMORY_SCOPE_AGENT); }
__device__ __forceinline__ unsigned xb_xcc_id() { return (unsigned)__builtin_amdgcn_s_getreg((3 << 11) | 20) & 0xFu; }
#define XB_SPIN(cond, bar) do { unsigned _sp = 0; while (cond) { __builtin_amdgcn_s_sleep(1); \
    if ((++_sp & 255u) == 0u) { if (xb_ld(&(bar)[XB_TMO])) break; if (_sp > XB_SPIN_CAP) { atomicAdd(&(bar)[XB_TMO], 1u); break; } } } } while (0)
__device__ __forceinline__ void xcd_barrier_complete(unsigned* bar, unsigned x, unsigned& nloc, unsigned& nx) {
    const unsigned G = gridDim.x;
    unsigned sum, cnt, mine, sp = 0u;
    for (;;) {
        sum = 0u; cnt = 0u; mine = 0u;
#pragma unroll
        for (unsigned j = 0; j < 16; ++j) { const unsigned c = xb_ld(&bar[XB_XCNT(j)]); sum += c; cnt += (c > 0u) ? 1u : 0u; mine = (j == x) ? c : mine; }
        if (sum == G) break;
        __builtin_amdgcn_s_sleep(1);
        if ((++sp & 255u) == 0u) { if (xb_ld(&bar[XB_TMO])) break; if (sp > XB_SPIN_CAP) { atomicAdd(&bar[XB_TMO], 1u); break; } }
    }
    nloc = mine > 0u ? mine : 1u; nx = cnt > 0u ? cnt : 1u;
}
__device__ __forceinline__ void xcd_barrier(const int WV, unsigned* bar, volatile PG8_LAS unsigned* st) {
    asm volatile("s_waitcnt vmcnt(0)" ::: "memory");
    __syncthreads();
    if (otid(WV) == 0) {
        __builtin_amdgcn_s_waitcnt(0);
        const unsigned x = xb_xcc_id();
        unsigned nloc = st[0], nx = st[1];
        if (nloc == 0u) { xcd_barrier_complete(bar, x, nloc, nx); st[0] = nloc; st[1] = nx; }
        const unsigned old = xb_add(&bar[XB_XSUB(x)], 1u);
        const unsigned gen = old / nloc;
        if (old + 1u == (gen + 1u) * nloc) {
            __builtin_amdgcn_fence(__ATOMIC_RELEASE, "agent");
            asm volatile("s_waitcnt vmcnt(0)" ::: "memory");
            const unsigned og = xb_add(&bar[XB_TOP], 1u);
            const unsigned tg = og / nx;
            if (og + 1u == (tg + 1u) * nx) xb_add(&bar[XB_TOPGEN], 1u);
            else XB_SPIN(xb_ld(&bar[XB_TOPGEN]) == tg, bar);
            __builtin_amdgcn_fence(__ATOMIC_ACQUIRE, "agent");
            xb_add(&bar[XB_XGEN(x)], 1u);
            asm volatile("s_waitcnt vmcnt(0)" ::: "memory");
        } else {
            XB_SPIN(xb_ld(&bar[XB_XGEN(x)]) == gen, bar);
            __builtin_amdgcn_fence(__ATOMIC_ACQUIRE, "agent");
            asm volatile("s_waitcnt vmcnt(0)" ::: "memory");
        }
    }
    __syncthreads();
}
__global__ __launch_bounds__(512) void k_mega(Params p_unused) {
    extern __shared__ __attribute__((aligned(16))) unsigned char smem[];
    PG8_LAS unsigned char* lds = (PG8_LAS unsigned char*)smem;
    cg::grid_group grid = cg::this_grid();
    const int WV = __builtin_amdgcn_readfirstlane(threadIdx.x >> 6);
    volatile PG8_LAS unsigned* xb_st = (volatile PG8_LAS unsigned*)(lds + (LDS_BYTES - 16));
    { unsigned* bar0 = KP.bar; if (threadIdx.x == 0) { xb_st[0] = 0u; xb_st[1] = 0u; (void)xb_add(&bar0[XB_XCNT(xb_xcc_id())], 1u); } }
    __syncthreads();
#define GSYNC() xcd_barrier(WV, KP.bar, xb_st)
#define MOD0 (KP.mod)
#define MOD1 (KP.mod + 16 * 6144)
#define PROJB ((bf16_t*)KP.PROJ)
#define ACTB ((bf16_t*)KP.PROJ)
#define YB ((bf16_t*)KP.PROJ + (size_t)2 * T_ * 256)
#define XA16(p_) ((bf16_t*)(p_).PROJ + (size_t)2 * T_ * 256 + (size_t)2 * T_ * 1024)
    ph_tcvt<MapEv>(WV, KP.ev_w_in, 3596, 1024, KP.W_evin, 0, 0, 1, smem);
    ph_tcvt<MapId>(WV, KP.ev_w_out, 1024, 1024, KP.W_evout, 0, 0, 1, smem);
    ph_tcvt<MapId>(WV, KP.od_w_in, 2048, 1024, KP.W_odin, 0, 0, 1, smem);
    ph_tcvt<MapId>(WV, KP.od_w_out, 1024, 1024, KP.W_odout, 0, 0, 1, smem);
    ph_tcvt<MapEven>(WV, KP.moe_wg, 256, 1024, KP.W_moe1, (size_t)1024 * 256, (size_t)512 * 1024, 32, smem);
    ph_tcvt<MapOdd>(WV, KP.moe_wu, 256, 1024, KP.W_moe1, (size_t)1024 * 256, (size_t)512 * 1024, 32, smem);
    ph_tcvt<MapId>(WV, KP.moe_wd, 1024, 256, KP.W_moe2, (size_t)256 * 1024, (size_t)1024 * 256, 32, smem);
    ph_tcvt<MapId>(WV, KP.od_wr, 128, 128, KP.W_lr, (size_t)128 * 128, (size_t)128 * 128, 4, smem);
    ph_tcvt<MapId>(WV, KP.od_wi, 128, 128, KP.W_li, (size_t)128 * 128, (size_t)128 * 128, 4, smem);
    { CParams& p = KP; ph_misc(WV, p); }
    { CParams& p = KP; ph_mod(WV, p, smem); }
    if (KP.bar == nullptr) grid.sync();
    GSYNC();
    { CParams& p = KP; ph_norm<false, false>(WV, p, p.x, nullptr, nullptr, nullptr, p.norm1_g, p.mod + 1024, p.mod + 0, p.H, smem); }
    GSYNC();
    { CParams& p = KP; ph_small_gemm(WV, p, smem); }
    run_gemm_dense_bf16(WV, lds, KP.H, KP.W_evin, T_, EVN, 1024, PROJB, EVN, 1 << 20);
    GSYNC();
    { CParams& p = KP; bf16_t* fx = (bf16_t*)p.out; const DnBufs d{p.H, p.H + (size_t)T_ * 512, p.VN, fx + (size_t)3 * T_ * 512, p.DNQK, p.DNGL}; ph_dn_prep(WV, p, (const bf16_t*)p.PROJ, d, smem); }
    { CParams& p = KP; ph_cumsum(WV, p, smem); }
    { CParams& p = KP; bf16_t* fx = (bf16_t*)p.out; ph_foxpre(WV, p, (const bf16_t*)p.PROJ, fx, fx + (size_t)2 * T_ * 512, smem); }
    GSYNC();
    { CParams& p = KP; bf16_t* fx = (bf16_t*)p.out; const DnBufs d{p.H, p.H + (size_t)T_ * 512, p.VN, fx + (size_t)3 * T_ * 512, p.DNQK, p.DNGL}; ph_dn_scan(WV, p, (const bf16_t*)p.PROJ, d, p.OMIX, smem); }
    { CParams& p = KP; const bf16_t* fx = (const bf16_t*)p.out; ph_fox_flash(WV, p, (const bf16_t*)p.PROJ, fx, fx + (size_t)2 * T_ * 512, p.OMIX, smem); }
    GSYNC();
    { CParams& p = KP; run_gemm_dense_res<false>(WV, lds, p.OMIX, p.W_evout, T_, 1024, 1024, p.x, XA16(p), p.mod + 2048); }
    GSYNC();
    { CParams& p = KP; ph_route(WV, p, XA16(p), p.norm2_g, p.mod + 4096, p.mod + 3072, p.H, smem); }
    GSYNC();
    { CParams& p = KP; run_gemm_g1<1>(WV, lds, p, p.H, p.W_moe1, (bf16_t*)p.PROJ); }
    GSYNC();
    { CParams& p = KP; run_gemm_g1<3>(WV, lds, p, p.H, p.W_moe1, (bf16_t*)p.PROJ); }
    { CParams& p = KP; run_gemm_g2(WV, lds, p, (const bf16_t*)p.PROJ, p.W_moe2, (bf16_t*)p.PROJ + (size_t)2 * T_ * 256); }
    GSYNC();
    { CParams& p = KP; ph_norm<true, true>(WV, p, XA16(p), (const bf16_t*)p.PROJ + (size_t)2 * T_ * 256, p.mod + 5120, XA16(p), p.norm1_g + 1024, p.mod + 16 * 6144 + 1024, p.mod + 16 * 6144, p.H, smem);
      { const int t0 = otid(WV); if (blockIdx.x == 0 && t0 < 512) p.cnt[t0] = 0; } }
    GSYNC();
    run_gemm_dense_bf16(WV, lds, KP.H, KP.W_odin, T_, 2048, 1024, PROJB, 2048, 2);
    GSYNC();
    { CParams& p = KP; ph_lru(WV, p, (const bf16_t*)p.PROJ, p.OMIX, smem); }
    { CParams& p = KP; ph_sgu(WV, p, (const bf16_t*)p.PROJ, p.OMIX, smem); }
    GSYNC();
    { CParams& p = KP; run_gemm_dense_res<true>(WV, lds, p.OMIX, p.W_odout, T_, 1024, 1024, XA16(p), XA16(p), p.mod + 16 * 6144 + 2048); }
    GSYNC();
    { CParams& p = KP; ph_route(WV, p, XA16(p), p.norm2_g + 1024, p.mod + 16 * 6144 + 4096, p.mod + 16 * 6144 + 3072, p.H, smem); }
    GSYNC();
    { CParams& p = KP; run_gemm_g1<1>(WV, lds, p, p.H, p.W_moe1 + (size_t)16 * 512 * 1024, (bf16_t*)p.PROJ); }
    GSYNC();
    { CParams& p = KP; run_gemm_g1<3>(WV, lds, p, p.H, p.W_moe1 + (size_t)16 * 512 * 1024, (bf16_t*)p.PROJ); }
    { CParams& p = KP; run_gemm_g2(WV, lds, p, (const bf16_t*)p.PROJ, p.W_moe2 + (size_t)16 * 1024 * 256, (bf16_t*)p.PROJ + (size_t)2 * T_ * 256); }
    GSYNC();
    { CParams& p = KP; ph_norm<true, false>(WV, p, XA16(p), (const bf16_t*)p.PROJ + (size_t)2 * T_ * 256, p.mod + 16 * 6144 + 5120, p.out, nullptr, nullptr, nullptr, nullptr, smem); }
}

static inline size_t al(size_t x) { return (x + 255) & ~(size_t)255; }

extern "C" void kernel_launch(void* const* d_in, const int* in_sizes, int n_in, void* d_out, int out_size, void* d_ws, size_t ws_size, hipStream_t stream) {
    Params p; memset(&p, 0, sizeof(p));
    const float** pin = (const float**)&p;
    for (int i = 0; i < 32; ++i) pin[i] = (const float*)d_in[i];
    p.out = (float*)d_out;
    unsigned char* ws = (unsigned char*)d_ws; size_t off = 0;
    auto take = [&](size_t bytes) { unsigned char* q = ws + off; off += al(bytes); return q; };
    p.W_evin = (bf16_t*)take((size_t)3600 * 1024 * 2);
    p.W_evout = (bf16_t*)take((size_t)1024 * 1024 * 2);
    p.W_odin = (bf16_t*)take((size_t)2048 * 1024 * 2);
    p.W_odout = (bf16_t*)take((size_t)1024 * 1024 * 2);
    p.W_moe1 = (bf16_t*)take((size_t)2 * 16 * 512 * 1024 * 2);
    p.W_moe2 = (bf16_t*)take((size_t)2 * 16 * 1024 * 256 * 2);
    p.W_lr = (bf16_t*)take((size_t)4 * 128 * 128 * 2);
    p.W_li = (bf16_t*)take((size_t)4 * 128 * 128 * 2);
    p.W_sgu = (bf16_t*)take((size_t)4 * 128 * 128 * 2);
    p.mod = (float*)take((size_t)2 * 16 * 6144 * 4);
    p.cnt = (int*)take(2048);
    p.bar = (unsigned*)take(16384);
    p.list = (int*)take((size_t)16 * T_ * 4);
    p.gw = (float*)take((size_t)2 * T_ * 4);
    p.gdec = (float*)take((size_t)T_ * 4 * 4);
    p.beta = (float*)take((size_t)T_ * 4 * 4);
    p.lf = (float*)take((size_t)T_ * 4 * 4);
    p.cum = (float*)take((size_t)T_ * 4 * 4);
    p.H = (bf16_t*)take((size_t)T_ * 1024 * 2);
    p.PROJ = take((size_t)T_ * 3600 * 2);
    p.OMIX = (bf16_t*)take((size_t)T_ * 1024 * 2);
    p.VN = (bf16_t*)take((size_t)T_ * 512 * 2);
    p.DNQK = (bf16_t*)take((size_t)4096 * 1024 * 2);
    p.DNGL = (float*)take((size_t)4096 * 4);
    p.small = (float*)take((size_t)T_ * 16 * 4);
    (void)ws_size; (void)n_in; (void)in_sizes; (void)out_size;

    static int grid_blocks = 0;
    if (!grid_blocks) {
        (void)hipFuncSetAttribute((const void*)k_mega, hipFuncAttributeMaxDynamicSharedMemorySize, LDS_BYTES);
        int dev = 0, cus = 0, per_cu = 0; (void)hipGetDevice(&dev); (void)hipDeviceGetAttribute(&cus, hipDeviceAttributeMultiprocessorCount, dev);
        (void)hipOccupancyMaxActiveBlocksPerMultiprocessor(&per_cu, k_mega, NT, LDS_BYTES);
        if (per_cu > 1) per_cu = 1;
        grid_blocks = cus * per_cu;
    }
    (void)hipMemsetAsync(p.bar, 0, 16384, stream);
    void* args[] = {&p};
    (void)hipLaunchCooperativeKernel((const void*)k_mega, dim3(grid_blocks), dim3(NT), args, LDS_BYTES, stream);
}
```
